# Optimizing an MI355X kernel written in HIP

```python
import math
import jax, jax.numpy as jnp
from jax import lax
import numpy as np


D_MODEL = 1024
BATCH = 8
SEQ = 2048
DEPTH = 4

CHUNK = 64
N_META = 16
HEAD_DIM = 64
D_CONV = 256
CONV_WIDTH = 31
RWKV_HEADS = 6
D_RWKV = RWKV_HEADS * HEAD_DIM
DECAY_LORA = 64
AAA_LORA = 64
GATE_LORA = 128
SB_HEADS = 6
D_SB = SB_HEADS * HEAD_DIM
SB_BLOCK = 128
D_MIX = D_CONV + D_RWKV + D_SB
D_RWKV_IN = 3 * D_RWKV + DECAY_LORA + AAA_LORA + GATE_LORA
D_IN = 2 * D_CONV + D_RWKV_IN + 3 * D_SB
D_FF = 2816
RMS_EPS = 1e-6
LN_EPS = 1e-5
GN_EPS = 64e-5

kernel_name = 'hymba_conformer_rwkv7_stickbreak_macaron'


def rms_norm(x, g):
    xf = x.astype(jnp.float32)
    y = xf * lax.rsqrt(jnp.mean(xf * xf, axis=-1, keepdims=True) + RMS_EPS)
    return (y * g.astype(jnp.float32)).astype(x.dtype)


def swiglu_ffn(h, w13, w2):
    gate, up = jnp.split(h @ w13, 2, axis=-1)
    return (jax.nn.silu(gate) * up) @ w2


def conv_group(p_val, p_gate, conv_w, conv_b, ln_g, ln_b):
    c = p_val * jax.nn.sigmoid(p_gate)
    y = lax.conv_general_dilated(
        c, conv_w[:, None, :], window_strides=(1,), padding=[(CONV_WIDTH - 1, 0)],
        dimension_numbers=('NWC', 'WIO', 'NWC'), feature_group_count=D_CONV) + conv_b
    yf = y.astype(jnp.float32)
    mu = jnp.mean(yf, axis=-1, keepdims=True)
    var = jnp.mean(jnp.square(yf - mu), axis=-1, keepdims=True)
    yn = (yf - mu) * lax.rsqrt(var + LN_EPS) * ln_g.astype(jnp.float32) + ln_b.astype(jnp.float32)
    return jax.nn.silu(yn).astype(p_val.dtype)


def rwkv7_group(p, mu, w0, wB, a0, aB, gB, k_k, k_a, r_k, ln_g, ln_b):
    f32 = jnp.float32
    out_dtype = p.dtype
    p = p.astype(f32)
    B, L, _ = p.shape
    prev = jnp.pad(p[:, :-1], ((0, 0), (1, 0), (0, 0)))
    xs = p + mu.astype(f32) * (prev - p)
    r, k, v, wd, ad, gd = jnp.split(
        xs, [D_RWKV, 2 * D_RWKV, 3 * D_RWKV, 3 * D_RWKV + DECAY_LORA,
             3 * D_RWKV + DECAY_LORA + AAA_LORA], axis=-1)
    w_log = -jax.nn.softplus(-(w0.astype(f32) + jnp.tanh(wd) @ wB.astype(f32))) - 0.5
    decay = jnp.exp(-jnp.exp(w_log))
    a = jax.nn.sigmoid(a0.astype(f32) + ad @ aB.astype(f32))
    g = jax.nn.sigmoid(gd) @ gB.astype(f32)

    def heads(t):
        return t.reshape(B, L, RWKV_HEADS, HEAD_DIM)

    kk = heads(k * k_k.astype(f32))
    kk = kk / jnp.maximum(jnp.sqrt(jnp.sum(kk * kk, axis=-1, keepdims=True)), 1e-12)
    k = k * (1.0 + (a - 1.0) * k_a.astype(f32))
    rh, kh, vh, wh, ah = heads(r), heads(k), heads(v), heads(decay), heads(a)

    def step(S, inp):
        r_t, w_t, k_t, v_t, na_t, b_t = inp
        sa = jnp.einsum('bhvk,bhk->bhv', S, na_t)
        S = S * w_t[:, :, None, :] + sa[..., None] * b_t[:, :, None, :] + v_t[..., None] * k_t[:, :, None, :]
        return S, jnp.einsum('bhvk,bhk->bhv', S, r_t)

    seq_in = tuple(t.transpose(1, 0, 2, 3) for t in (rh, wh, kh, vh, -kk, kk * ah))
    S0 = jnp.zeros((B, RWKV_HEADS, HEAD_DIM, HEAD_DIM), f32)
    _, o = lax.scan(step, S0, seq_in)
    o = o.transpose(1, 0, 2, 3)
    m = jnp.mean(o, axis=-1, keepdims=True)
    var = jnp.mean(jnp.square(o - m), axis=-1, keepdims=True)
    o = ((o - m) * lax.rsqrt(var + GN_EPS)).reshape(B, L, D_RWKV)
    o = o * ln_g.astype(f32) + ln_b.astype(f32)
    bonus = jnp.sum(rh * kh * r_k.astype(f32), axis=-1, keepdims=True) * vh
    o = (o + bonus.reshape(B, L, D_RWKV)) * g
    return o.astype(out_dtype)


def stick_breaking_group(q, k, v, norm_g):
    f32 = jnp.float32
    B, L, _ = q.shape
    n_blk = -(-L // SB_BLOCK)
    Lp = n_blk * SB_BLOCK

    def heads(t):
        t = jnp.pad(t, ((0, 0), (0, Lp - L), (0, 0)))
        return t.reshape(B, Lp, SB_HEADS, HEAD_DIM).transpose(0, 2, 1, 3)

    qh, kh, vh = heads(q), heads(k), heads(v)
    scale = HEAD_DIM ** -0.5
    outs = []
    for i in range(n_blk):
        q0 = i * SB_BLOCK
        kend = q0 + SB_BLOCK
        qb = qh[:, :, q0:kend].astype(f32)
        kb = kh[:, :, :kend].astype(f32)
        z = jnp.einsum('bhqd,bhkd->bhqk', qb, kb) * scale
        t_idx = q0 + jnp.arange(SB_BLOCK)
        s_idx = jnp.arange(kend)
        causal = s_idx[None, :] < t_idx[:, None]
        log_rest = jnp.where(causal, jax.nn.log_sigmoid(-z), 0.0)
        after = lax.cumsum(log_rest, axis=3, reverse=True) - log_rest
        log_a = jnp.where(causal, jax.nn.log_sigmoid(z) + after, -jnp.inf)
        outs.append(jnp.einsum('bhqk,bhkd->bhqd', jnp.exp(log_a), vh[:, :, :kend].astype(f32)))
    o = jnp.concatenate(outs, axis=2)[:, :, :L].transpose(0, 2, 1, 3)
    o = o * lax.rsqrt(jnp.mean(o * o, axis=-1, keepdims=True) + RMS_EPS)
    o = o * norm_g.astype(f32).reshape(SB_HEADS, HEAD_DIM)
    return o.reshape(B, L, D_SB).astype(q.dtype)


def setup_inputs(seed: int = 0) -> dict:
    key = jax.random.key(seed)
    ks = iter(jax.random.split(key, 40))
    f32 = jnp.float32

    def nrm(shape, scale):
        return scale * jax.random.normal(next(ks), shape, f32)

    def gain(shape):
        return 1.0 + 0.02 * jax.random.normal(next(ks), shape, f32)

    def unif(shape, lo, hi):
        return jax.random.uniform(next(ks), shape, f32, lo, hi)

    return {
        'x': nrm((BATCH, SEQ, D_MODEL), 1.0),
        'meta': nrm((N_META, D_MODEL), 1.0),
        'ffn1_norm': gain((DEPTH, D_MODEL)),
        'ffn1_w13': nrm((DEPTH, D_MODEL, 2 * D_FF), D_MODEL ** -0.5),
        'ffn1_w2': nrm((DEPTH, D_FF, D_MODEL), D_FF ** -0.5),
        'mix_norm': gain((DEPTH, D_MODEL)),
        'w_in': nrm((DEPTH, D_MODEL, D_IN), D_MODEL ** -0.5),
        'conv_w': nrm((DEPTH, CONV_WIDTH, D_CONV), CONV_WIDTH ** -0.5),
        'conv_b': nrm((DEPTH, D_CONV), 0.02),
        'conv_ln_g': gain((DEPTH, D_CONV)),
        'conv_ln_b': nrm((DEPTH, D_CONV), 0.02),
        'rwkv_mu': unif((DEPTH, D_RWKV_IN), 0.0, 1.0),
        'rwkv_w0': unif((DEPTH, D_RWKV), -5.0, 1.0),
        'rwkv_wB': nrm((DEPTH, DECAY_LORA, D_RWKV), 0.1),
        'rwkv_a0': nrm((DEPTH, D_RWKV), 0.5),
        'rwkv_aB': nrm((DEPTH, AAA_LORA, D_RWKV), AAA_LORA ** -0.5),
        'rwkv_gB': nrm((DEPTH, GATE_LORA, D_RWKV), GATE_LORA ** -0.5),
        'rwkv_kk': 0.85 + nrm((DEPTH, D_RWKV), 0.05),
        'rwkv_ka': 1.0 + nrm((DEPTH, D_RWKV), 0.05),
        'rwkv_rk': nrm((DEPTH, RWKV_HEADS, HEAD_DIM), 0.1),
        'rwkv_ln_g': gain((DEPTH, D_RWKV)),
        'rwkv_ln_b': nrm((DEPTH, D_RWKV), 0.02),
        'sb_norm': gain((DEPTH, D_SB)),
        'w_out': nrm((DEPTH, D_MIX, D_MODEL), D_MIX ** -0.5),
        'ffn2_norm': gain((DEPTH, D_MODEL)),
        'ffn2_w13': nrm((DEPTH, D_MODEL, 2 * D_FF), D_MODEL ** -0.5),
        'ffn2_w2': nrm((DEPTH, D_FF, D_MODEL), D_FF ** -0.5),
        'final_norm': gain((D_MODEL,)),
    }


def reference(x, meta, ffn1_norm, ffn1_w13, ffn1_w2, mix_norm, w_in, conv_w, conv_b,
              conv_ln_g, conv_ln_b, rwkv_mu, rwkv_w0, rwkv_wB, rwkv_a0, rwkv_aB, rwkv_gB,
              rwkv_kk, rwkv_ka, rwkv_rk, rwkv_ln_g, rwkv_ln_b, sb_norm, w_out,
              ffn2_norm, ffn2_w13, ffn2_w2, final_norm):
    B = x.shape[0]
    meta_b = jnp.broadcast_to(meta.astype(x.dtype)[None], (B, N_META, D_MODEL))
    h = jnp.concatenate([meta_b, x], axis=1)
    split_pts = [D_CONV, 2 * D_CONV, 2 * D_CONV + D_RWKV_IN,
                 2 * D_CONV + D_RWKV_IN + D_SB, 2 * D_CONV + D_RWKV_IN + 2 * D_SB]
    for l in range(DEPTH):
        h = h + 0.5 * swiglu_ffn(rms_norm(h, ffn1_norm[l]), ffn1_w13[l], ffn1_w2[l])
        p = rms_norm(h, mix_norm[l]) @ w_in[l]
        pc_val, pc_gate, p_rwkv, q_sb, k_sb, v_sb = jnp.split(p, split_pts, axis=-1)
        y_conv = conv_group(pc_val, pc_gate, conv_w[l], conv_b[l], conv_ln_g[l], conv_ln_b[l])
        y_rwkv = rwkv7_group(p_rwkv, rwkv_mu[l], rwkv_w0[l], rwkv_wB[l], rwkv_a0[l], rwkv_aB[l],
                             rwkv_gB[l], rwkv_kk[l], rwkv_ka[l], rwkv_rk[l], rwkv_ln_g[l], rwkv_ln_b[l])
        y_sb = stick_breaking_group(q_sb, k_sb, v_sb, sb_norm[l])
        y = jnp.concatenate([y_conv, y_rwkv, y_sb], axis=-1)
        h = h + y @ w_out[l]
        h = h + 0.5 * swiglu_ffn(rms_norm(h, ffn2_norm[l]), ffn2_w13[l], ffn2_w2[l])
    h = rms_norm(h, final_norm)
    return h[:, N_META:]
```

```cpp
#include <hip/hip_runtime.h>
#include <hip/hip_cooperative_groups.h>
#include <stdint.h>
#include <stdio.h>

typedef unsigned short bf16_t;
typedef short bf16x8 __attribute__((ext_vector_type(8)));
typedef float f32x4 __attribute__((ext_vector_type(4)));
typedef unsigned u32x4 __attribute__((ext_vector_type(4)));
typedef unsigned u32x2 __attribute__((ext_vector_type(2)));

#define DEV __device__ __forceinline__

constexpr int NB = 8, SEQ = 2048, NMETA = 16, LT = 2064, DM = 1024, DFF = 2816, DIN = 3072;
constexpr int MMAIN = 16384, MTOK = 16512, MP = 16640;
constexpr int DRW = 384, LPV = 2080;
constexpr int C_RW = 512, C_Q = 1920, C_K = 2304, C_V = 2688;

struct P {
    const float *x, *meta, *ffn1_norm, *ffn1_w13, *ffn1_w2, *mix_norm, *w_in, *conv_w, *conv_b, *conv_ln_g, *conv_ln_b,
        *rwkv_mu, *rwkv_w0, *rwkv_wB, *rwkv_a0, *rwkv_aB, *rwkv_gB, *rwkv_kk, *rwkv_ka, *rwkv_rk, *rwkv_ln_g, *rwkv_ln_b,
        *sb_norm, *w_out, *ffn2_norm, *ffn2_w13, *ffn2_w2, *final_norm;
    float* out;
    bf16_t *W13a, *W2a, *Win, *Wout, *W13b, *W2b;
    float* h; bf16_t* hb; bf16_t* big; bf16_t* y; bf16_t* vt; float* part;
    float *lw, *aa, *gg;
};

DEV float bf2f(bf16_t v) { return __uint_as_float(((unsigned)v) << 16); }
DEV bf16_t f2bf(float f) { unsigned u = __float_as_uint(f); u += 0x7FFFu + ((u >> 16) & 1u); return (bf16_t)(u >> 16); }
DEV unsigned pack2(float a, float b) { return (unsigned)f2bf(a) | ((unsigned)f2bf(b) << 16); }
DEV float wave_sum(float v) {
#pragma unroll
    for (int o = 32; o; o >>= 1) v += __shfl_xor(v, o);
    return v;
}
DEV float sigm(float x) { return 1.f / (1.f + expf(-x)); }
DEV int row_of(int b, int pos) { return pos < NMETA ? MMAIN + b * NMETA + pos : b * SEQ + pos - NMETA; }
DEV float row_rstd(const float* part, int row) {
    const f32x4* pp = (const f32x4*)(part + (size_t)row * 16);
    f32x4 a = pp[0], b = pp[1], c = pp[2], d = pp[3];
    float ss = ((a[0] + a[1]) + (a[2] + a[3])) + ((b[0] + b[1]) + (b[2] + b[3])) + ((c[0] + c[1]) + (c[2] + c[3])) + ((d[0] + d[1]) + (d[2] + d[3]));
    return rsqrtf(ss * (1.0f / 1024.0f) + 1e-6f);
}

DEV void phase_init(const P& p, int bid, int nblk) {
    const int lane = threadIdx.x & 63, wave = threadIdx.x >> 6;
    for (int r = bid * 8 + wave; r < MP; r += nblk * 8) {
        const float* src = nullptr;
        if (r < MMAIN) src = p.x + (size_t)r * DM;
        else if (r < MTOK) src = p.meta + (size_t)((r - MMAIN) & 15) * DM;
        float ss = 0.f;
#pragma unroll
        for (int i = 0; i < 4; ++i) {
            const int c = (i * 64 + lane) * 4;
            f32x4 v = src ? *(const f32x4*)(src + c) : (f32x4){0.f, 0.f, 0.f, 0.f};
            *(f32x4*)(p.h + (size_t)r * DM + c) = v;
            u32x2 w; w.x = pack2(v[0], v[1]); w.y = pack2(v[2], v[3]);
            *(u32x2*)(p.hb + (size_t)r * DM + c) = w;
            ss += v[0] * v[0] + v[1] * v[1] + v[2] * v[2] + v[3] * v[3];
        }
        ss = wave_sum(ss);
        if (lane < 16) p.part[(size_t)r * 16 + lane] = lane == 0 ? ss : 0.f;
    }
}

DEV void convert_tile(const float* __restrict__ W, int K, int N, const float* __restrict__ g, bf16_t* __restrict__ dst, int swz, int kt, int nt, float* tile) {
    const int tid = threadIdx.x, k0 = kt * 64, n0 = nt * 64;
#pragma unroll
    for (int i = 0; i < 8; ++i) {
        const int idx = tid + i * 512, kk = idx >> 6, nn = idx & 63;
        float v = W[(size_t)(k0 + kk) * N + n0 + nn];
        if (g) v *= g[k0 + kk];
        tile[kk * 65 + nn] = v;
    }
    __syncthreads();
#pragma unroll
    for (int i = 0; i < 4; ++i) {
        const int idx = tid + i * 512, nn = idx >> 5, kp = (idx & 31) * 2;
        const int s = n0 + nn;
        int nd = s;
        if (swz) { const int bj = s >= DFF ? 1 : 0; const int j = s - bj * DFF; nd = (j >> 7) * 256 + bj * 128 + (j & 127); }
        *(unsigned*)(dst + (size_t)nd * K + k0 + kp) = pack2(tile[kp * 65 + nn], tile[(kp + 1) * 65 + nn]);
    }
    __syncthreads();
}
DEV void phase_convert(const P& p, int l, int bid, int nblk, float* lds) {
    for (int it = bid; it < 5248; it += nblk) {
        int t = it;
        if (t < 1408) { convert_tile(p.ffn1_w13 + (size_t)l * DM * 2 * DFF, DM, 2 * DFF, p.ffn1_norm + l * DM, p.W13a, 1, t / 88, t % 88, lds); continue; }
        t -= 1408;
        if (t < 704) { convert_tile(p.ffn1_w2 + (size_t)l * DFF * DM, DFF, DM, nullptr, p.W2a, 0, t / 16, t % 16, lds); continue; }
        t -= 704;
        if (t < 768) { convert_tile(p.w_in + (size_t)l * DM * DIN, DM, DIN, p.mix_norm + l * DM, p.Win, 0, t / 48, t % 48, lds); continue; }
        t -= 768;
        if (t < 256) { convert_tile(p.w_out + (size_t)l * DM * DM, DM, DM, nullptr, p.Wout, 0, t / 16, t % 16, lds); continue; }
        t -= 256;
        if (t < 1408) { convert_tile(p.ffn2_w13 + (size_t)l * DM * 2 * DFF, DM, 2 * DFF, p.ffn2_norm + l * DM, p.W13b, 1, t / 88, t % 88, lds); continue; }
        t -= 1408;
        convert_tile(p.ffn2_w2 + (size_t)l * DFF * DM, DFF, DM, nullptr, p.W2b, 0, t / 16, t % 16, lds);
    }
}

enum { EPI_SWIGLU = 0, EPI_RESID = 1, EPI_P = 2 };

DEV void epi_swiglu(const P& p, int row, int colh, f32x4 g, f32x4 u, float rs) {
    float o[4];
#pragma unroll
    for (int e = 0; e < 4; ++e) { const float gg = g[e] * rs, uu = u[e] * rs; o[e] = gg * sigm(gg) * uu; }
    u32x2 w; w.x = pack2(o[0], o[1]); w.y = pack2(o[2], o[3]);
    *(u32x2*)(p.big + (size_t)row * DFF + colh) = w;
}
DEV float epi_resid(const P& p, int row, int col, f32x4 a, float scale) {
    float* hp = p.h + (size_t)row * DM + col;
    f32x4 hv = *(const f32x4*)hp;
    hv += a * scale;
    *(f32x4*)hp = hv;
    u32x2 w; w.x = pack2(hv[0], hv[1]); w.y = pack2(hv[2], hv[3]);
    *(u32x2*)(p.hb + (size_t)row * DM + col) = w;
    return hv[0] * hv[0] + hv[1] * hv[1] + hv[2] * hv[2] + hv[3] * hv[3];
}
DEV void epi_p(const P& p, int row, int col, f32x4 a, float rs) {
    a *= rs;
    u32x2 w; w.x = pack2(a[0], a[1]); w.y = pack2(a[2], a[3]);
    *(u32x2*)(p.big + (size_t)row * DIN + col) = w;
    if (col >= C_V && row < MTOK) {
        const int hh = (col - C_V) >> 6, d = (col - C_V) & 63;
        int b, pos;
        if (row < MMAIN) { b = row >> 11; pos = (row & 2047) + NMETA; } else { b = (row - MMAIN) >> 4; pos = (row - MMAIN) & 15; }
        bf16_t* vp = p.vt + ((size_t)((b * 6 + hh) * 64 + d)) * LPV + pos;
#pragma unroll
        for (int e = 0; e < 4; ++e) vp[(size_t)e * LPV] = f2bf(a[e]);
    }
}

template <int EPI>
DEV void gemm_v0(const P& p, const bf16_t* __restrict__ A, const bf16_t* __restrict__ Bt, int row_begin, int row_end, int N, int K, float scale, int bid, int nblk) {
    const int lane = threadIdx.x & 63, wave = threadIdx.x >> 6, fr = lane & 15, fq = lane >> 4;
    const int nt = N / 64, total = ((row_end - row_begin) / 32) * nt;
    for (int u = bid * 8 + wave; u < total; u += nblk * 8) {
        const int mu = u / nt, nu = u % nt, row0 = row_begin + mu * 32;
        const int cb = (EPI == EPI_SWIGLU) ? ((nu >> 2) * 256 + (nu & 3) * 32) : nu * 64;
        f32x4 acc[2][4];
#pragma unroll
        for (int i = 0; i < 2; ++i)
#pragma unroll
            for (int j = 0; j < 4; ++j) acc[i][j] = (f32x4){0.f, 0.f, 0.f, 0.f};
        const bf16_t* ap = A + (size_t)(row0 + fr) * K + fq * 8;
        const bf16_t* bp = Bt + (size_t)(cb + fr) * K + fq * 8;
#pragma unroll 2
        for (int k0 = 0; k0 < K; k0 += 32) {
            const bf16x8 a0 = *(const bf16x8*)(ap + k0), a1 = *(const bf16x8*)(ap + (size_t)16 * K + k0);
#pragma unroll
            for (int j = 0; j < 4; ++j) {
                const int co = (EPI == EPI_SWIGLU) ? ((j & 1) * 16 + (j >> 1) * 128) : j * 16;
                const bf16x8 b = *(const bf16x8*)(bp + (size_t)co * K + k0);
                acc[0][j] = __builtin_amdgcn_mfma_f32_16x16x32_bf16(b, a0, acc[0][j], 0, 0, 0);
                acc[1][j] = __builtin_amdgcn_mfma_f32_16x16x32_bf16(b, a1, acc[1][j], 0, 0, 0);
            }
        }
#pragma unroll
        for (int i = 0; i < 2; ++i) {
            const int row = row0 + 16 * i + fr;
            if (EPI == EPI_SWIGLU) {
                const float rs = row_rstd(p.part, row);
                const int colh = (nu >> 2) * 128 + (nu & 3) * 32 + 4 * fq;
                epi_swiglu(p, row, colh, acc[i][0], acc[i][2], rs);
                epi_swiglu(p, row, colh + 16, acc[i][1], acc[i][3], rs);
            } else if (EPI == EPI_RESID) {
                float ss = 0.f;
#pragma unroll
                for (int j = 0; j < 4; ++j) ss += epi_resid(p, row, cb + 16 * j + 4 * fq, acc[i][j], scale);
                ss += __shfl_xor(ss, 16); ss += __shfl_xor(ss, 32);
                if (fq == 0) p.part[(size_t)row * 16 + nu] = ss;
            } else {
                const float rs = row_rstd(p.part, row);
#pragma unroll
                for (int j = 0; j < 4; ++j) epi_p(p, row, cb + 16 * j + 4 * fq, acc[i][j], rs);
            }
        }
    }
}

DEV void phase_conv(const P& p, int l, int bid, int nblk, float* lds) {
    float* cS = lds;
    float* yS = lds + 46 * 256;
    const int tid = threadIdx.x, ch = tid & 255, half = tid >> 8, lane = tid & 63, wave = tid >> 6;
    float wreg[31];
#pragma unroll
    for (int j = 0; j < 31; ++j) wreg[j] = p.conv_w[(size_t)l * 31 * 256 + j * 256 + ch];
    const float cb = p.conv_b[l * 256 + ch];
    for (int it = bid; it < NB * 129; it += nblk) {
        const int b = it / 129, p0 = (it % 129) * 16;
        __syncthreads();
        for (int e = tid; e < 46 * 256; e += 512) {
            const int pp = e >> 8, c = e & 255, pos = p0 - 30 + pp;
            float v = 0.f;
            if (pos >= 0) { const size_t ro = (size_t)row_of(b, pos) * DIN; v = bf2f(p.big[ro + c]) * sigm(bf2f(p.big[ro + 256 + c])); }
            cS[e] = v;
        }
        __syncthreads();
#pragma unroll
        for (int i = 0; i < 8; ++i) {
            const int ii = half * 8 + i;
            float acc = cb;
#pragma unroll
            for (int j = 0; j < 31; ++j) acc += wreg[j] * cS[(ii + j) * 256 + ch];
            yS[ii * 256 + ch] = acc;
        }
        __syncthreads();
#pragma unroll
        for (int q = 0; q < 2; ++q) {
            const int ii = wave * 2 + q;
            const f32x4 v = *(const f32x4*)(yS + ii * 256 + lane * 4);
            const float mu = wave_sum((v[0] + v[1]) + (v[2] + v[3])) * (1.f / 256.f);
            const f32x4 d = v - mu;
            const float var = wave_sum(d[0] * d[0] + d[1] * d[1] + d[2] * d[2] + d[3] * d[3]) * (1.f / 256.f);
            const float rs = rsqrtf(var + 1e-5f);
            const f32x4 g = *(const f32x4*)(p.conv_ln_g + l * 256 + lane * 4), bb = *(const f32x4*)(p.conv_ln_b + l * 256 + lane * 4);
            float o[4];
#pragma unroll
            for (int e = 0; e < 4; ++e) { const float yn = d[e] * rs * g[e] + bb[e]; o[e] = yn * sigm(yn); }
            u32x2 w; w.x = pack2(o[0], o[1]); w.y = pack2(o[2], o[3]);
            *(u32x2*)(p.y + (size_t)row_of(b, p0 + ii) * DM + lane * 4) = w;
        }
    }
}

DEV void phase_rwkv_prep(const P& p, int l, int bid, int nblk, float* lds) {
    float* xin = lds;
    const int tid = threadIdx.x;
    const float* mu = p.rwkv_mu + (size_t)l * 1408;
    for (int it = bid; it < NB * 258; it += nblk) {
        const int b = it / 258, p0 = (it % 258) * 8;
        __syncthreads();
        for (int e = tid; e < 8 * 256; e += 512) {
            const int tk = e >> 8, c = e & 255, pos = p0 + tk;
            const float cur = bf2f(p.big[(size_t)row_of(b, pos) * DIN + C_RW + 1152 + c]);
            const float prv = pos > 0 ? bf2f(p.big[(size_t)row_of(b, pos - 1) * DIN + C_RW + 1152 + c]) : 0.f;
            float xs = cur + mu[1152 + c] * (prv - cur);
            if (c < 64) xs = tanhf(xs); else if (c >= 128) xs = sigm(xs);
            xin[e] = xs;
        }
        __syncthreads();
        if (tid < DRW) {
            const int c = tid;
            float aw[8], aa[8], ag[8];
#pragma unroll
            for (int t = 0; t < 8; ++t) { aw[t] = 0.f; aa[t] = 0.f; ag[t] = 0.f; }
            const float* wB = p.rwkv_wB + (size_t)l * 64 * DRW + c;
            const float* aB = p.rwkv_aB + (size_t)l * 64 * DRW + c;
            const float* gB = p.rwkv_gB + (size_t)l * 128 * DRW + c;
            for (int i = 0; i < 64; ++i) {
                const float w1 = wB[(size_t)i * DRW], w2 = aB[(size_t)i * DRW];
#pragma unroll
                for (int t = 0; t < 8; ++t) { aw[t] += xin[t * 256 + i] * w1; aa[t] += xin[t * 256 + 64 + i] * w2; }
            }
            for (int i = 0; i < 128; ++i) {
                const float w3 = gB[(size_t)i * DRW];
#pragma unroll
                for (int t = 0; t < 8; ++t) ag[t] += xin[t * 256 + 128 + i] * w3;
            }
            const float w0 = p.rwkv_w0[l * DRW + c], a0 = p.rwkv_a0[l * DRW + c];
#pragma unroll
            for (int t = 0; t < 8; ++t) {
                const size_t o = (size_t)row_of(b, p0 + t) * DRW + c;
                const float xw = -(w0 + aw[t]);
                const float sp = fmaxf(xw, 0.f) + log1pf(expf(-fabsf(xw)));
                p.lw[o] = -expf(-sp - 0.5f);
                p.aa[o] = sigm(a0 + aa[t]);
                p.gg[o] = ag[t];
            }
        }
    }
}

DEV void phase_rwkv_scan(const P& p, int l, int bid, int nblk, float* lds) {
    float* rS = lds;
    float* wS = rS + 1024;
    float* kS = wS + 1024;
    float* vS = kS + 1024;
    float* nS = vS + 1024;
    float* bS = nS + 1024;
    float* gS = bS + 1024;
    float* oS = gS + 1024;
    float* cS = oS + 1024;
    const int tid = threadIdx.x, lane = tid & 63, wave = tid >> 6;
    const int vi = tid >> 3, ks = tid & 7;
    const float* mu = p.rwkv_mu + (size_t)l * 1408;
    for (int it = bid; it < NB * 6; it += nblk) {
        const int b = it / 6, hh = it % 6;
        float S[8];
#pragma unroll
        for (int i = 0; i < 8; ++i) S[i] = 0.f;
        const int hc = hh * 64 + lane;
        const float mr = mu[hc], mk = mu[384 + hc], mv = mu[768 + hc];
        const float kkw = p.rwkv_kk[l * DRW + hc], kaw = p.rwkv_ka[l * DRW + hc], rkw = p.rwkv_rk[l * DRW + hc];
        const float lng = p.rwkv_ln_g[l * DRW + hc], lnb = p.rwkv_ln_b[l * DRW + hc];
        for (int ck = 0; ck < 129; ++ck) {
            const int p0 = ck * 16;
            __syncthreads();
#pragma unroll
            for (int q = 0; q < 2; ++q) {
                const int tk = wave * 2 + q, pos = p0 + tk;
                const int row = row_of(b, pos);
                const bf16_t* cur = p.big + (size_t)row * DIN + C_RW + hc;
                float r = bf2f(cur[0]), k = bf2f(cur[384]), v = bf2f(cur[768]);
                float pr = 0.f, pk = 0.f, pv = 0.f;
                if (pos > 0) { const bf16_t* prv = p.big + (size_t)row_of(b, pos - 1) * DIN + C_RW + hc; pr = bf2f(prv[0]); pk = bf2f(prv[384]); pv = bf2f(prv[768]); }
                r += mr * (pr - r); k += mk * (pk - k); v += mv * (pv - v);
                const size_t o = (size_t)row * DRW + hc;
                const float a = p.aa[o], w = expf(p.lw[o]), g = p.gg[o];
                const float kkr = k * kkw;
                const float nrm = fmaxf(sqrtf(wave_sum(kkr * kkr)), 1e-12f);
                const float kk = kkr / nrm;
                const float kp = k * (1.f + (a - 1.f) * kaw);
                const float ct = wave_sum(r * kp * rkw);
                const int e = tk * 64 + lane;
                rS[e] = r; wS[e] = w; kS[e] = kp; vS[e] = v; nS[e] = kk; bS[e] = kk * a; gS[e] = g;
                if (lane == 0) cS[tk] = ct;
            }
            __syncthreads();
            for (int tk = 0; tk < 16; ++tk) {
                const int e = tk * 64 + ks * 8;
                const f32x4 n0 = *(const f32x4*)(nS + e), n1 = *(const f32x4*)(nS + e + 4);
                float sa = 0.f;
#pragma unroll
                for (int i = 0; i < 4; ++i) { sa -= S[i] * n0[i]; sa -= S[4 + i] * n1[i]; }
                sa += __shfl_xor(sa, 1); sa += __shfl_xor(sa, 2); sa += __shfl_xor(sa, 4);
                const f32x4 w0 = *(const f32x4*)(wS + e), w1 = *(const f32x4*)(wS + e + 4);
                const f32x4 b0 = *(const f32x4*)(bS + e), b1 = *(const f32x4*)(bS + e + 4);
                const f32x4 k0 = *(const f32x4*)(kS + e), k1 = *(const f32x4*)(kS + e + 4);
                const f32x4 r0 = *(const f32x4*)(rS + e), r1 = *(const f32x4*)(rS + e + 4);
                const float vv = vS[tk * 64 + vi];
                float o = 0.f;
#pragma unroll
                for (int i = 0; i < 4; ++i) {
                    S[i] = S[i] * w0[i] + sa * b0[i] + vv * k0[i];
                    S[4 + i] = S[4 + i] * w1[i] + sa * b1[i] + vv * k1[i];
                    o += S[i] * r0[i]; o += S[4 + i] * r1[i];
                }
                o += __shfl_xor(o, 1); o += __shfl_xor(o, 2); o += __shfl_xor(o, 4);
                if (ks == 0) oS[tk * 64 + vi] = o;
            }
            __syncthreads();
#pragma unroll
            for (int q = 0; q < 2; ++q) {
                const int tk = wave * 2 + q, e = tk * 64 + lane;
                const float o = oS[e];
                const float m = wave_sum(o) * (1.f / 64.f);
                const float d = o - m;
                const float var = wave_sum(d * d) * (1.f / 64.f);
                float yv = d * rsqrtf(var + 64e-5f) * lng + lnb;
                yv = (yv + cS[tk] * vS[e]) * gS[e];
                p.y[(size_t)row_of(b, p0 + tk) * DM + 256 + hc] = f2bf(yv);
            }
        }
    }
}

DEV void phase_sb(const P& p, int l, int bid, int nblk, float* lds) {
    float* Ks = lds;
    float* Vs = lds + 2048;
    const int tid = threadIdx.x;
    for (int it = bid; it < NB * 6 * 5; it += nblk) {
        const int qt = it % 5, bh = it / 5, b = bh / 6, hh = bh % 6;
        const int t = qt * 512 + tid;
        const bool valid = t < LT;
        const int myrow = row_of(b, valid ? t : 0);
        float q[64], acc[64];
        {
            const bf16_t* qp = p.big + (size_t)myrow * DIN + C_Q + hh * 64;
#pragma unroll
            for (int i = 0; i < 8; ++i) {
                const u32x4 w = *(const u32x4*)(qp + i * 8);
#pragma unroll
                for (int e = 0; e < 4; ++e) { q[i * 8 + 2 * e] = __uint_as_float(w[e] << 16) * 0.125f; q[i * 8 + 2 * e + 1] = __uint_as_float(w[e] & 0xFFFF0000u) * 0.125f; }
            }
        }
#pragma unroll
        for (int d = 0; d < 64; ++d) acc[d] = 0.f;
        float carry = 0.f;
        int thi = qt * 512 + 510; if (thi > LT - 2) thi = LT - 2;
        for (int kt = thi >> 5; kt >= 0; --kt) {
            __syncthreads();
            {
                const int which = tid >> 8, key = (tid & 255) >> 3, part = tid & 7, s = kt * 32 + key;
                float f[8];
#pragma unroll
                for (int e = 0; e < 8; ++e) f[e] = 0.f;
                if (s < LT) {
                    const u32x4 w = *(const u32x4*)(p.big + (size_t)row_of(b, s) * DIN + (which ? C_V : C_K) + hh * 64 + part * 8);
#pragma unroll
                    for (int e = 0; e < 4; ++e) { f[2 * e] = __uint_as_float(w[e] << 16); f[2 * e + 1] = __uint_as_float(w[e] & 0xFFFF0000u); }
                }
                float* dst = (which ? Vs : Ks) + key * 64 + part * 8;
                *(f32x4*)dst = (f32x4){f[0], f[1], f[2], f[3]};
                *(f32x4*)(dst + 4) = (f32x4){f[4], f[5], f[6], f[7]};
            }
            __syncthreads();
            for (int kk = 31; kk >= 0; --kk) {
                const int s = kt * 32 + kk;
                if (valid && s < t) {
                    float z0 = 0.f, z1 = 0.f;
#pragma unroll
                    for (int i = 0; i < 16; ++i) {
                        const f32x4 kv = *(const f32x4*)(Ks + kk * 64 + i * 4);
                        z0 += q[i * 4] * kv[0]; z1 += q[i * 4 + 1] * kv[1]; z0 += q[i * 4 + 2] * kv[2]; z1 += q[i * 4 + 3] * kv[3];
                    }
                    const float z = z0 + z1;
                    const float ls = fminf(z, 0.f) - log1pf(expf(-fabsf(z)));
                    const float a = expf(ls + carry);
                    carry += ls - z;
#pragma unroll
                    for (int i = 0; i < 16; ++i) {
                        const f32x4 vv = *(const f32x4*)(Vs + kk * 64 + i * 4);
                        acc[i * 4] += a * vv[0]; acc[i * 4 + 1] += a * vv[1]; acc[i * 4 + 2] += a * vv[2]; acc[i * 4 + 3] += a * vv[3];
                    }
                }
            }
            if (__syncthreads_and((!valid || carry < -110.f) ? 1 : 0)) break;
        }
        if (valid) {
            float ms = 0.f;
#pragma unroll
            for (int d = 0; d < 64; ++d) ms += acc[d] * acc[d];
            const float rs = rsqrtf(ms * (1.f / 64.f) + 1e-6f);
            const float* g = p.sb_norm + l * 384 + hh * 64;
            bf16_t* yp = p.y + (size_t)myrow * DM + 640 + hh * 64;
#pragma unroll
            for (int i = 0; i < 8; ++i) {
                u32x4 w;
#pragma unroll
                for (int e = 0; e < 4; ++e) w[e] = pack2(acc[i * 8 + 2 * e] * rs * g[i * 8 + 2 * e], acc[i * 8 + 2 * e + 1] * rs * g[i * 8 + 2 * e + 1]);
                *(u32x4*)(yp + i * 8) = w;
            }
        }
    }
}

DEV void phase_final(const P& p, int bid, int nblk) {
    const int lane = threadIdx.x & 63, wave = threadIdx.x >> 6;
    for (int r = bid * 8 + wave; r < MMAIN; r += nblk * 8) {
        const float rs = row_rstd(p.part, r);
#pragma unroll
        for (int i = 0; i < 4; ++i) {
            const int c = (i * 64 + lane) * 4;
            const f32x4 v = *(const f32x4*)(p.h + (size_t)r * DM + c), g = *(const f32x4*)(p.final_norm + c);
            *(f32x4*)(p.out + (size_t)r * DM + c) = v * rs * g;
        }
    }
}

enum { PH_INIT = 0, PH_CONVERT, PH_G1A, PH_G2A, PH_G3, PH_CONV, PH_PREP, PH_SCAN, PH_SB, PH_G4, PH_G1B, PH_G2B, PH_FINAL };

DEV void run_phase(const P& p, int ph, int l, int bid, int nblk, float* lds) {
    switch (ph) {
    case PH_INIT: phase_init(p, bid, nblk); break;
    case PH_CONVERT: phase_convert(p, l, bid, nblk, lds); break;
    case PH_G1A: gemm_v0<EPI_SWIGLU>(p, p.hb, p.W13a, 0, MP, 2 * DFF, DM, 0.f, bid, nblk); break;
    case PH_G2A: gemm_v0<EPI_RESID>(p, p.big, p.W2a, 0, MP, DM, DFF, 0.5f, bid, nblk); break;
    case PH_G3: gemm_v0<EPI_P>(p, p.hb, p.Win, 0, MP, DIN, DM, 0.f, bid, nblk); break;
    case PH_CONV: phase_conv(p, l, bid, nblk, lds); break;
    case PH_PREP: phase_rwkv_prep(p, l, bid, nblk, lds); break;
    case PH_SCAN: phase_rwkv_scan(p, l, bid, nblk, lds); break;
    case PH_SB: phase_sb(p, l, bid, nblk, lds); break;
    case PH_G4: gemm_v0<EPI_RESID>(p, p.y, p.Wout, 0, MP, DM, DM, 1.0f, bid, nblk); break;
    case PH_G1B: gemm_v0<EPI_SWIGLU>(p, p.hb, p.W13b, 0, MP, 2 * DFF, DM, 0.f, bid, nblk); break;
    case PH_G2B: gemm_v0<EPI_RESID>(p, p.big, p.W2b, 0, MP, DM, DFF, 0.5f, bid, nblk); break;
    case PH_FINAL: phase_final(p, bid, nblk); break;
    }
}

__global__ void __launch_bounds__(512) k_phase(P p, int ph, int l) {
    extern __shared__ __attribute__((aligned(16))) unsigned char smem[];
    run_phase(p, ph, l, blockIdx.x, gridDim.x, (float*)smem);
}

extern "C" void kernel_launch(void* const* d_in, const int* in_sizes, int n_in, void* d_out, int out_size, void* d_ws, size_t ws_size, hipStream_t stream) {
    P p{};
    const float** f = (const float**)&p;
    for (int i = 0; i < 28; ++i) f[i] = (const float*)d_in[i];
    p.out = (float*)d_out;
    size_t off = 0;
    auto take = [&](size_t bytes) { void* r = (char*)d_ws + off; off += (bytes + 255) & ~(size_t)255; return r; };
    p.W13a = (bf16_t*)take((size_t)2 * DFF * DM * 2);
    p.W2a = (bf16_t*)take((size_t)DM * DFF * 2);
    p.Win = (bf16_t*)take((size_t)DIN * DM * 2);
    p.Wout = (bf16_t*)take((size_t)DM * DM * 2);
    p.W13b = (bf16_t*)take((size_t)2 * DFF * DM * 2);
    p.W2b = (bf16_t*)take((size_t)DM * DFF * 2);
    p.h = (float*)take((size_t)MP * DM * 4);
    p.hb = (bf16_t*)take((size_t)MP * DM * 2);
    p.big = (bf16_t*)take((size_t)MP * DIN * 2);
    p.y = (bf16_t*)take((size_t)MP * DM * 2);
    p.vt = (bf16_t*)take((size_t)NB * 6 * 64 * LPV * 2);
    p.part = (float*)take((size_t)MP * 16 * 4);
    p.lw = (float*)take((size_t)MP * DRW * 4);
    p.aa = (float*)take((size_t)MP * DRW * 4);
    p.gg = (float*)take((size_t)MP * DRW * 4);
    if (off > ws_size) { fprintf(stderr, "workspace too small: need %zu have %zu\n", off, ws_size); return; }
    const int G = 2048; const size_t LDSB = 65536;
    auto run = [&](int ph, int l, int grid) { hipLaunchKernelGGL(k_phase, dim3(grid), dim3(512), LDSB, stream, p, ph, l); };
    run(PH_INIT, 0, G);
    for (int l = 0; l < 4; ++l) {
        run(PH_CONVERT, l, G);
        run(PH_G1A, l, G); run(PH_G2A, l, G); run(PH_G3, l, G);
        run(PH_CONV, l, 1032); run(PH_PREP, l, 2064); run(PH_SB, l, 240); run(PH_SCAN, l, 48);
        run(PH_G4, l, G); run(PH_G1B, l, G); run(PH_G2B, l, G);
    }
    run(PH_FINAL, 0, G);
}
```

```cpp
#include <hip/hip_runtime.h>
#include <hip/hip_cooperative_groups.h>
#include <stdint.h>
#include <stdio.h>

typedef unsigned short bf16_t;
typedef short bf16x8 __attribute__((ext_vector_type(8)));
typedef float f32x4 __attribute__((ext_vector_type(4)));
typedef unsigned u32x4 __attribute__((ext_vector_type(4)));
typedef unsigned u32x2 __attribute__((ext_vector_type(2)));

#define DEV __device__ __forceinline__

constexpr int NB = 8, SEQ = 2048, NMETA = 16, LT = 2064, DM = 1024, DFF = 2816, DIN = 3072;
constexpr int MMAIN = 16384, MTOK = 16512, MP = 16640;
constexpr int DRW = 384, LPV = 2080;
constexpr int C_RW = 512, C_Q = 1920, C_K = 2304, C_V = 2688;

struct P {
    const float *x, *meta, *ffn1_norm, *ffn1_w13, *ffn1_w2, *mix_norm, *w_in, *conv_w, *conv_b, *conv_ln_g, *conv_ln_b,
        *rwkv_mu, *rwkv_w0, *rwkv_wB, *rwkv_a0, *rwkv_aB, *rwkv_gB, *rwkv_kk, *rwkv_ka, *rwkv_rk, *rwkv_ln_g, *rwkv_ln_b,
        *sb_norm, *w_out, *ffn2_norm, *ffn2_w13, *ffn2_w2, *final_norm;
    float* out;
    bf16_t *W13a, *W2a, *Win, *Wout, *W13b, *W2b;
    float* h; bf16_t* hb; bf16_t* big; bf16_t* y; bf16_t* vt; float* part;
    float *lw, *aa, *gg;
};

DEV int tid_() { int t = threadIdx.x; asm volatile("" : "+v"(t)); return t; }
DEV float bf2f(bf16_t v) { return __uint_as_float(((unsigned)v) << 16); }
DEV bf16_t f2bf(float f) { unsigned u = __float_as_uint(f); u += 0x7FFFu + ((u >> 16) & 1u); return (bf16_t)(u >> 16); }
DEV unsigned pack2(float a, float b) { return (unsigned)f2bf(a) | ((unsigned)f2bf(b) << 16); }
DEV float wave_sum(float v) {
#pragma unroll
    for (int o = 32; o; o >>= 1) v += __shfl_xor(v, o);
    return v;
}
DEV float sigm(float x) { return 1.f / (1.f + expf(-x)); }
DEV int row_of(int b, int pos) { return pos < NMETA ? MMAIN + b * NMETA + pos : b * SEQ + pos - NMETA; }
DEV float row_rstd(const float* part, int row) {
    const f32x4* pp = (const f32x4*)(part + (size_t)row * 16);
    f32x4 a = pp[0], b = pp[1], c = pp[2], d = pp[3];
    float ss = ((a[0] + a[1]) + (a[2] + a[3])) + ((b[0] + b[1]) + (b[2] + b[3])) + ((c[0] + c[1]) + (c[2] + c[3])) + ((d[0] + d[1]) + (d[2] + d[3]));
    return rsqrtf(ss * (1.0f / 1024.0f) + 1e-6f);
}

DEV void phase_init(const P& p, int bid, int nblk) {
    const int lane = tid_() & 63, wave = tid_() >> 6;
    for (int r = bid * 8 + wave; r < MP; r += nblk * 8) {
        const float* src = nullptr;
        if (r < MMAIN) src = p.x + (size_t)r * DM;
        else if (r < MTOK) src = p.meta + (size_t)((r - MMAIN) & 15) * DM;
        float ss = 0.f;
#pragma unroll
        for (int i = 0; i < 4; ++i) {
            const int c = (i * 64 + lane) * 4;
            f32x4 v = src ? *(const f32x4*)(src + c) : (f32x4){0.f, 0.f, 0.f, 0.f};
            *(f32x4*)(p.h + (size_t)r * DM + c) = v;
            u32x2 w; w.x = pack2(v[0], v[1]); w.y = pack2(v[2], v[3]);
            *(u32x2*)(p.hb + (size_t)r * DM + c) = w;
            ss += v[0] * v[0] + v[1] * v[1] + v[2] * v[2] + v[3] * v[3];
        }
        ss = wave_sum(ss);
        if (lane < 16) p.part[(size_t)r * 16 + lane] = lane == 0 ? ss : 0.f;
    }
}

DEV void convert_tile(const float* __restrict__ W, int K, int N, const float* __restrict__ g, bf16_t* __restrict__ dst, int swz, int kt, int nt, float* tile) {
    const int tid = tid_(), k0 = kt * 64, n0 = nt * 64;
#pragma unroll
    for (int i = 0; i < 8; ++i) {
        const int idx = tid + i * 512, kk = idx >> 6, nn = idx & 63;
        float v = W[(size_t)(k0 + kk) * N + n0 + nn];
        if (g) v *= g[k0 + kk];
        tile[kk * 65 + nn] = v;
    }
    __syncthreads();
#pragma unroll
    for (int i = 0; i < 4; ++i) {
        const int idx = tid + i * 512, nn = idx >> 5, kp = (idx & 31) * 2;
        const int s = n0 + nn;
        int nd = s;
        if (swz) { const int bj = s >= DFF ? 1 : 0; const int j = s - bj * DFF; nd = (j >> 7) * 256 + bj * 128 + (j & 127); }
        *(unsigned*)(dst + (size_t)nd * K + k0 + kp) = pack2(tile[kp * 65 + nn], tile[(kp + 1) * 65 + nn]);
    }
    __syncthreads();
}
DEV void phase_convert(const P& p, int l, int bid, int nblk, float* lds) {
    for (int it = bid; it < 5248; it += nblk) {
        int t = it;
        if (t < 1408) { convert_tile(p.ffn1_w13 + (size_t)l * DM * 2 * DFF, DM, 2 * DFF, p.ffn1_norm + l * DM, p.W13a, 1, t / 88, t % 88, lds); continue; }
        t -= 1408;
        if (t < 704) { convert_tile(p.ffn1_w2 + (size_t)l * DFF * DM, DFF, DM, nullptr, p.W2a, 0, t / 16, t % 16, lds); continue; }
        t -= 704;
        if (t < 768) { convert_tile(p.w_in + (size_t)l * DM * DIN, DM, DIN, p.mix_norm + l * DM, p.Win, 0, t / 48, t % 48, lds); continue; }
        t -= 768;
        if (t < 256) { convert_tile(p.w_out + (size_t)l * DM * DM, DM, DM, nullptr, p.Wout, 0, t / 16, t % 16, lds); continue; }
        t -= 256;
        if (t < 1408) { convert_tile(p.ffn2_w13 + (size_t)l * DM * 2 * DFF, DM, 2 * DFF, p.ffn2_norm + l * DM, p.W13b, 1, t / 88, t % 88, lds); continue; }
        t -= 1408;
        convert_tile(p.ffn2_w2 + (size_t)l * DFF * DM, DFF, DM, nullptr, p.W2b, 0, t / 16, t % 16, lds);
    }
}

enum { EPI_SWIGLU = 0, EPI_RESID = 1, EPI_P = 2 };

DEV void epi_swiglu(const P& p, int row, int colh, f32x4 g, f32x4 u, float rs) {
    float o[4];
#pragma unroll
    for (int e = 0; e < 4; ++e) { const float gg = g[e] * rs, uu = u[e] * rs; o[e] = gg * sigm(gg) * uu; }
    u32x2 w; w.x = pack2(o[0], o[1]); w.y = pack2(o[2], o[3]);
    *(u32x2*)(p.big + (size_t)row * DFF + colh) = w;
}
DEV float epi_resid(const P& p, int row, int col, f32x4 a, float scale) {
    float* hp = p.h + (size_t)row * DM + col;
    f32x4 hv = *(const f32x4*)hp;
    hv += a * scale;
    *(f32x4*)hp = hv;
    u32x2 w; w.x = pack2(hv[0], hv[1]); w.y = pack2(hv[2], hv[3]);
    *(u32x2*)(p.hb + (size_t)row * DM + col) = w;
    return hv[0] * hv[0] + hv[1] * hv[1] + hv[2] * hv[2] + hv[3] * hv[3];
}
DEV void epi_p(const P& p, int row, int col, f32x4 a, float rs) {
    a *= rs;
    u32x2 w; w.x = pack2(a[0], a[1]); w.y = pack2(a[2], a[3]);
    *(u32x2*)(p.big + (size_t)row * DIN + col) = w;
    if (col >= C_V && row < MTOK) {
        const int hh = (col - C_V) >> 6, d = (col - C_V) & 63;
        int b, pos;
        if (row < MMAIN) { b = row >> 11; pos = (row & 2047) + NMETA; } else { b = (row - MMAIN) >> 4; pos = (row - MMAIN) & 15; }
        bf16_t* vp = p.vt + ((size_t)((b * 6 + hh) * 64 + d)) * LPV + pos;
#pragma unroll
        for (int e = 0; e < 4; ++e) vp[(size_t)e * LPV] = f2bf(a[e]);
    }
}

template <int EPI>
DEV void gemm_v0(const P& p, const bf16_t* __restrict__ A, const bf16_t* __restrict__ Bt, int row_begin, int row_end, int N, int K, float scale, int bid, int nblk) {
    const int lane = tid_() & 63, wave = tid_() >> 6, fr = lane & 15, fq = lane >> 4;
    const int nt = N / 64, total = ((row_end - row_begin) / 32) * nt;
    for (int u = bid * 8 + wave; u < total; u += nblk * 8) {
        const int mu = u / nt, nu = u % nt, row0 = row_begin + mu * 32;
        const int cb = (EPI == EPI_SWIGLU) ? ((nu >> 2) * 256 + (nu & 3) * 32) : nu * 64;
        f32x4 acc[2][4];
#pragma unroll
        for (int i = 0; i < 2; ++i)
#pragma unroll
            for (int j = 0; j < 4; ++j) acc[i][j] = (f32x4){0.f, 0.f, 0.f, 0.f};
        const bf16_t* ap = A + (size_t)(row0 + fr) * K + fq * 8;
        const bf16_t* bp = Bt + (size_t)(cb + fr) * K + fq * 8;
#pragma unroll 2
        for (int k0 = 0; k0 < K; k0 += 32) {
            const bf16x8 a0 = *(const bf16x8*)(ap + k0), a1 = *(const bf16x8*)(ap + (size_t)16 * K + k0);
#pragma unroll
            for (int j = 0; j < 4; ++j) {
                const int co = (EPI == EPI_SWIGLU) ? ((j & 1) * 16 + (j >> 1) * 128) : j * 16;
                const bf16x8 b = *(const bf16x8*)(bp + (size_t)co * K + k0);
                acc[0][j] = __builtin_amdgcn_mfma_f32_16x16x32_bf16(b, a0, acc[0][j], 0, 0, 0);
                acc[1][j] = __builtin_amdgcn_mfma_f32_16x16x32_bf16(b, a1, acc[1][j], 0, 0, 0);
            }
        }
#pragma unroll
        for (int i = 0; i < 2; ++i) {
            const int row = row0 + 16 * i + fr;
            if (EPI == EPI_SWIGLU) {
                const float rs = row_rstd(p.part, row);
                const int colh = (nu >> 2) * 128 + (nu & 3) * 32 + 4 * fq;
                epi_swiglu(p, row, colh, acc[i][0], acc[i][2], rs);
                epi_swiglu(p, row, colh + 16, acc[i][1], acc[i][3], rs);
            } else if (EPI == EPI_RESID) {
                float ss = 0.f;
#pragma unroll
                for (int j = 0; j < 4; ++j) ss += epi_resid(p, row, cb + 16 * j + 4 * fq, acc[i][j], scale);
                ss += __shfl_xor(ss, 16); ss += __shfl_xor(ss, 32);
                if (fq == 0) p.part[(size_t)row * 16 + nu] = ss;
            } else {
                const float rs = row_rstd(p.part, row);
#pragma unroll
                for (int j = 0; j < 4; ++j) epi_p(p, row, cb + 16 * j + 4 * fq, acc[i][j], rs);
            }
        }
    }
}

DEV void phase_conv(const P& p, int l, int bid, int nblk, float* lds) {
    float* cS = lds;
    float* yS = lds + 46 * 256;
    const int tid = tid_(), ch = tid & 255, half = tid >> 8, lane = tid & 63, wave = tid >> 6;
    float wreg[31];
#pragma unroll
    for (int j = 0; j < 31; ++j) wreg[j] = p.conv_w[(size_t)l * 31 * 256 + j * 256 + ch];
    const float cb = p.conv_b[l * 256 + ch];
    for (int it = bid; it < NB * 129; it += nblk) {
        const int b = it / 129, p0 = (it % 129) * 16;
        __syncthreads();
        for (int e = tid; e < 46 * 256; e += 512) {
            const int pp = e >> 8, c = e & 255, pos = p0 - 30 + pp;
            float v = 0.f;
            if (pos >= 0) { const size_t ro = (size_t)row_of(b, pos) * DIN; v = bf2f(p.big[ro + c]) * sigm(bf2f(p.big[ro + 256 + c])); }
            cS[e] = v;
        }
        __syncthreads();
#pragma unroll
        for (int i = 0; i < 8; ++i) {
            const int ii = half * 8 + i;
            float acc = cb;
#pragma unroll
            for (int j = 0; j < 31; ++j) acc += wreg[j] * cS[(ii + j) * 256 + ch];
            yS[ii * 256 + ch] = acc;
        }
        __syncthreads();
#pragma unroll
        for (int q = 0; q < 2; ++q) {
            const int ii = wave * 2 + q;
            const f32x4 v = *(const f32x4*)(yS + ii * 256 + lane * 4);
            const float mu = wave_sum((v[0] + v[1]) + (v[2] + v[3])) * (1.f / 256.f);
            const f32x4 d = v - mu;
            const float var = wave_sum(d[0] * d[0] + d[1] * d[1] + d[2] * d[2] + d[3] * d[3]) * (1.f / 256.f);
            const float rs = rsqrtf(var + 1e-5f);
            const f32x4 g = *(const f32x4*)(p.conv_ln_g + l * 256 + lane * 4), bb = *(const f32x4*)(p.conv_ln_b + l * 256 + lane * 4);
            float o[4];
#pragma unroll
            for (int e = 0; e < 4; ++e) { const float yn = d[e] * rs * g[e] + bb[e]; o[e] = yn * sigm(yn); }
            u32x2 w; w.x = pack2(o[0], o[1]); w.y = pack2(o[2], o[3]);
            *(u32x2*)(p.y + (size_t)row_of(b, p0 + ii) * DM + lane * 4) = w;
        }
    }
}

DEV void phase_rwkv_prep(const P& p, int l, int bid, int nblk, float* lds) {
    float* xin = lds;
    const int tid = tid_();
    const float* mu = p.rwkv_mu + (size_t)l * 1408;
    for (int it = bid; it < NB * 258; it += nblk) {
        const int b = it / 258, p0 = (it % 258) * 8;
        __syncthreads();
        for (int e = tid; e < 8 * 256; e += 512) {
            const int tk = e >> 8, c = e & 255, pos = p0 + tk;
            const float cur = bf2f(p.big[(size_t)row_of(b, pos) * DIN + C_RW + 1152 + c]);
            const float prv = pos > 0 ? bf2f(p.big[(size_t)row_of(b, pos - 1) * DIN + C_RW + 1152 + c]) : 0.f;
            float xs = cur + mu[1152 + c] * (prv - cur);
            if (c < 64) xs = tanhf(xs); else if (c >= 128) xs = sigm(xs);
            xin[e] = xs;
        }
        __syncthreads();
        if (tid < DRW) {
            const int c = tid;
            float aw[8], aa[8], ag[8];
#pragma unroll
            for (int t = 0; t < 8; ++t) { aw[t] = 0.f; aa[t] = 0.f; ag[t] = 0.f; }
            const float* wB = p.rwkv_wB + (size_t)l * 64 * DRW + c;
            const float* aB = p.rwkv_aB + (size_t)l * 64 * DRW + c;
            const float* gB = p.rwkv_gB + (size_t)l * 128 * DRW + c;
            for (int i = 0; i < 64; ++i) {
                const float w1 = wB[(size_t)i * DRW], w2 = aB[(size_t)i * DRW];
#pragma unroll
                for (int t = 0; t < 8; ++t) { aw[t] += xin[t * 256 + i] * w1; aa[t] += xin[t * 256 + 64 + i] * w2; }
            }
            for (int i = 0; i < 128; ++i) {
                const float w3 = gB[(size_t)i * DRW];
#pragma unroll
                for (int t = 0; t < 8; ++t) ag[t] += xin[t * 256 + 128 + i] * w3;
            }
            const float w0 = p.rwkv_w0[l * DRW + c], a0 = p.rwkv_a0[l * DRW + c];
#pragma unroll
            for (int t = 0; t < 8; ++t) {
                const size_t o = (size_t)row_of(b, p0 + t) * DRW + c;
                const float xw = -(w0 + aw[t]);
                const float sp = fmaxf(xw, 0.f) + log1pf(expf(-fabsf(xw)));
                p.lw[o] = -expf(-sp - 0.5f);
                p.aa[o] = sigm(a0 + aa[t]);
                p.gg[o] = ag[t];
            }
        }
    }
}

DEV void phase_rwkv_scan(const P& p, int l, int bid, int nblk, float* lds) {
    float* rS = lds;
    float* wS = rS + 1024;
    float* kS = wS + 1024;
    float* vS = kS + 1024;
    float* nS = vS + 1024;
    float* bS = nS + 1024;
    float* gS = bS + 1024;
    float* oS = gS + 1024;
    float* cS = oS + 1024;
    const int tid = tid_(), lane = tid & 63, wave = tid >> 6;
    const int vi = tid >> 3, ks = tid & 7;
    const float* mu = p.rwkv_mu + (size_t)l * 1408;
    for (int it = bid; it < NB * 6; it += nblk) {
        const int b = it / 6, hh = it % 6;
        float S[8];
#pragma unroll
        for (int i = 0; i < 8; ++i) S[i] = 0.f;
        const int hc = hh * 64 + lane;
        const float mr = mu[hc], mk = mu[384 + hc], mv = mu[768 + hc];
        const float kkw = p.rwkv_kk[l * DRW + hc], kaw = p.rwkv_ka[l * DRW + hc], rkw = p.rwkv_rk[l * DRW + hc];
        const float lng = p.rwkv_ln_g[l * DRW + hc], lnb = p.rwkv_ln_b[l * DRW + hc];
        for (int ck = 0; ck < 129; ++ck) {
            const int p0 = ck * 16;
            __syncthreads();
#pragma unroll
            for (int q = 0; q < 2; ++q) {
                const int tk = wave * 2 + q, pos = p0 + tk;
                const int row = row_of(b, pos);
                const bf16_t* cur = p.big + (size_t)row * DIN + C_RW + hc;
                float r = bf2f(cur[0]), k = bf2f(cur[384]), v = bf2f(cur[768]);
                float pr = 0.f, pk = 0.f, pv = 0.f;
                if (pos > 0) { const bf16_t* prv = p.big + (size_t)row_of(b, pos - 1) * DIN + C_RW + hc; pr = bf2f(prv[0]); pk = bf2f(prv[384]); pv = bf2f(prv[768]); }
                r += mr * (pr - r); k += mk * (pk - k); v += mv * (pv - v);
                const size_t o = (size_t)row * DRW + hc;
                const float a = p.aa[o], w = expf(p.lw[o]), g = p.gg[o];
                const float kkr = k * kkw;
                const float nrm = fmaxf(sqrtf(wave_sum(kkr * kkr)), 1e-12f);
                const float kk = kkr / nrm;
                const float kp = k * (1.f + (a - 1.f) * kaw);
                const float ct = wave_sum(r * kp * rkw);
                const int e = tk * 64 + lane;
                rS[e] = r; wS[e] = w; kS[e] = kp; vS[e] = v; nS[e] = kk; bS[e] = kk * a; gS[e] = g;
                if (lane == 0) cS[tk] = ct;
            }
            __syncthreads();
            for (int tk = 0; tk < 16; ++tk) {
                const int e = tk * 64 + ks * 8;
                const f32x4 n0 = *(const f32x4*)(nS + e), n1 = *(const f32x4*)(nS + e + 4);
                float sa = 0.f;
#pragma unroll
                for (int i = 0; i < 4; ++i) { sa -= S[i] * n0[i]; sa -= S[4 + i] * n1[i]; }
                sa += __shfl_xor(sa, 1); sa += __shfl_xor(sa, 2); sa += __shfl_xor(sa, 4);
                const f32x4 w0 = *(const f32x4*)(wS + e), w1 = *(const f32x4*)(wS + e + 4);
                const f32x4 b0 = *(const f32x4*)(bS + e), b1 = *(const f32x4*)(bS + e + 4);
                const f32x4 k0 = *(const f32x4*)(kS + e), k1 = *(const f32x4*)(kS + e + 4);
                const f32x4 r0 = *(const f32x4*)(rS + e), r1 = *(const f32x4*)(rS + e + 4);
                const float vv = vS[tk * 64 + vi];
                float o = 0.f;
#pragma unroll
                for (int i = 0; i < 4; ++i) {
                    S[i] = S[i] * w0[i] + sa * b0[i] + vv * k0[i];
                    S[4 + i] = S[4 + i] * w1[i] + sa * b1[i] + vv * k1[i];
                    o += S[i] * r0[i]; o += S[4 + i] * r1[i];
                }
                o += __shfl_xor(o, 1); o += __shfl_xor(o, 2); o += __shfl_xor(o, 4);
                if (ks == 0) oS[tk * 64 + vi] = o;
            }
            __syncthreads();
#pragma unroll
            for (int q = 0; q < 2; ++q) {
                const int tk = wave * 2 + q, e = tk * 64 + lane;
                const float o = oS[e];
                const float m = wave_sum(o) * (1.f / 64.f);
                const float d = o - m;
                const float var = wave_sum(d * d) * (1.f / 64.f);
                float yv = d * rsqrtf(var + 64e-5f) * lng + lnb;
                yv = (yv + cS[tk] * vS[e]) * gS[e];
                p.y[(size_t)row_of(b, p0 + tk) * DM + 256 + hc] = f2bf(yv);
            }
        }
    }
}

DEV void phase_sb(const P& p, int l, int bid, int nblk, float* lds) {
    float* Ks = lds;
    float* Vs = lds + 2048;
    const int tid = tid_(), qi = tid >> 1, hf = tid & 1;
    for (int it = bid; it < NB * 6 * 9; it += nblk) {
        const int qt = it % 9, bh = it / 9, b = bh / 6, hh = bh % 6;
        const int t = qt * 256 + qi;
        const bool valid = t < LT;
        const int myrow = row_of(b, valid ? t : 0);
        float q[64], acc[32];
        {
            const bf16_t* qp = p.big + (size_t)myrow * DIN + C_Q + hh * 64;
#pragma unroll
            for (int i = 0; i < 8; ++i) {
                const u32x4 w = *(const u32x4*)(qp + i * 8);
#pragma unroll
                for (int e = 0; e < 4; ++e) { q[i * 8 + 2 * e] = __uint_as_float(w[e] << 16) * 0.125f; q[i * 8 + 2 * e + 1] = __uint_as_float(w[e] & 0xFFFF0000u) * 0.125f; }
            }
        }
#pragma unroll
        for (int d = 0; d < 32; ++d) acc[d] = 0.f;
        float carry = 0.f;
        int thi = qt * 256 + 254; if (thi > LT - 2) thi = LT - 2;
        for (int kt = thi >> 5; kt >= 0; --kt) {
            __syncthreads();
            {
                const int which = tid >> 8, key = (tid & 255) >> 3, part = tid & 7, s = kt * 32 + key;
                float f[8];
#pragma unroll
                for (int e = 0; e < 8; ++e) f[e] = 0.f;
                if (s < LT) {
                    const u32x4 w = *(const u32x4*)(p.big + (size_t)row_of(b, s) * DIN + (which ? C_V : C_K) + hh * 64 + part * 8);
#pragma unroll
                    for (int e = 0; e < 4; ++e) { f[2 * e] = __uint_as_float(w[e] << 16); f[2 * e + 1] = __uint_as_float(w[e] & 0xFFFF0000u); }
                }
                float* dst = (which ? Vs : Ks) + key * 64 + part * 8;
                *(f32x4*)dst = (f32x4){f[0], f[1], f[2], f[3]};
                *(f32x4*)(dst + 4) = (f32x4){f[4], f[5], f[6], f[7]};
            }
            __syncthreads();
            for (int kk = 31; kk >= 0; --kk) {
                const int s = kt * 32 + kk;
                if (valid && s < t) {
                    float z0 = 0.f, z1 = 0.f;
#pragma unroll
                    for (int i = 0; i < 16; ++i) {
                        const f32x4 kv = *(const f32x4*)(Ks + kk * 64 + i * 4);
                        z0 += q[i * 4] * kv[0]; z1 += q[i * 4 + 1] * kv[1]; z0 += q[i * 4 + 2] * kv[2]; z1 += q[i * 4 + 3] * kv[3];
                    }
                    const float z = z0 + z1;
                    const float ls = fminf(z, 0.f) - log1pf(expf(-fabsf(z)));
                    const float a = expf(ls + carry);
                    carry += ls - z;
#pragma unroll
                    for (int i = 0; i < 8; ++i) {
                        const f32x4 vv = *(const f32x4*)(Vs + kk * 64 + hf * 32 + i * 4);
                        acc[i * 4] += a * vv[0]; acc[i * 4 + 1] += a * vv[1]; acc[i * 4 + 2] += a * vv[2]; acc[i * 4 + 3] += a * vv[3];
                    }
                }
            }
            if (__syncthreads_and((!valid || carry < -110.f) ? 1 : 0)) break;
        }
        float ms = 0.f;
#pragma unroll
        for (int d = 0; d < 32; ++d) ms += acc[d] * acc[d];
        ms += __shfl_xor(ms, 1);
        if (valid) {
            const float rs = rsqrtf(ms * (1.f / 64.f) + 1e-6f);
            const float* g = p.sb_norm + l * 384 + hh * 64 + hf * 32;
            bf16_t* yp = p.y + (size_t)myrow * DM + 640 + hh * 64 + hf * 32;
#pragma unroll
            for (int i = 0; i < 4; ++i) {
                u32x4 w;
#pragma unroll
                for (int e = 0; e < 4; ++e) w[e] = pack2(acc[i * 8 + 2 * e] * rs * g[i * 8 + 2 * e], acc[i * 8 + 2 * e + 1] * rs * g[i * 8 + 2 * e + 1]);
                *(u32x4*)(yp + i * 8) = w;
            }
        }
    }
}

DEV void phase_final(const P& p, int bid, int nblk) {
    const int lane = tid_() & 63, wave = tid_() >> 6;
    for (int r = bid * 8 + wave; r < MMAIN; r += nblk * 8) {
        const float rs = row_rstd(p.part, r);
#pragma unroll
        for (int i = 0; i < 4; ++i) {
            const int c = (i * 64 + lane) * 4;
            const f32x4 v = *(const f32x4*)(p.h + (size_t)r * DM + c), g = *(const f32x4*)(p.final_norm + c);
            *(f32x4*)(p.out + (size_t)r * DM + c) = v * rs * g;
        }
    }
}

enum { PH_INIT = 0, PH_CONVERT, PH_G1A, PH_G2A, PH_G3, PH_CONV, PH_PREP, PH_SCAN, PH_SB, PH_G4, PH_G1B, PH_G2B, PH_FINAL };

DEV void run_phase(const P& p, int ph, int l, int bid, int nblk, float* lds) {
    switch (ph) {
    case PH_INIT: phase_init(p, bid, nblk); break;
    case PH_CONVERT: phase_convert(p, l, bid, nblk, lds); break;
    case PH_G1A: gemm_v0<EPI_SWIGLU>(p, p.hb, p.W13a, 0, MP, 2 * DFF, DM, 0.f, bid, nblk); break;
    case PH_G2A: gemm_v0<EPI_RESID>(p, p.big, p.W2a, 0, MP, DM, DFF, 0.5f, bid, nblk); break;
    case PH_G3: gemm_v0<EPI_P>(p, p.hb, p.Win, 0, MP, DIN, DM, 0.f, bid, nblk); break;
    case PH_CONV: phase_conv(p, l, bid, nblk, lds); break;
    case PH_PREP: phase_rwkv_prep(p, l, bid, nblk, lds); break;
    case PH_SCAN: phase_rwkv_scan(p, l, bid, nblk, lds); break;
    case PH_SB: phase_sb(p, l, bid, nblk, lds); break;
    case PH_G4: gemm_v0<EPI_RESID>(p, p.y, p.Wout, 0, MP, DM, DM, 1.0f, bid, nblk); break;
    case PH_G1B: gemm_v0<EPI_SWIGLU>(p, p.hb, p.W13b, 0, MP, 2 * DFF, DM, 0.f, bid, nblk); break;
    case PH_G2B: gemm_v0<EPI_RESID>(p, p.big, p.W2b, 0, MP, DM, DFF, 0.5f, bid, nblk); break;
    case PH_FINAL: phase_final(p, bid, nblk); break;
    }
}

namespace cg = cooperative_groups;
constexpr int LDS_BYTES = 131072;

__global__ void __launch_bounds__(512) k_mega(P p) {
    extern __shared__ __attribute__((aligned(16))) unsigned char smem[];
    float* lds = (float*)smem;
    cg::grid_group grid = cg::this_grid();
    const int bid = blockIdx.x, nblk = gridDim.x;
    phase_init(p, bid, nblk);
    for (int l = 0; l < 4; ++l) {
        phase_convert(p, l, bid, nblk, lds);
        grid.sync();
        run_phase(p, PH_G1A, l, bid, nblk, lds); grid.sync();
        run_phase(p, PH_G2A, l, bid, nblk, lds); grid.sync();
        run_phase(p, PH_G3, l, bid, nblk, lds); grid.sync();
        run_phase(p, PH_SB, l, bid, nblk, lds);
        run_phase(p, PH_CONV, l, bid, nblk, lds);
        run_phase(p, PH_PREP, l, bid, nblk, lds);
        grid.sync();
        run_phase(p, PH_SCAN, l, bid, nblk, lds); grid.sync();
        run_phase(p, PH_G4, l, bid, nblk, lds); grid.sync();
        run_phase(p, PH_G1B, l, bid, nblk, lds); grid.sync();
        run_phase(p, PH_G2B, l, bid, nblk, lds); grid.sync();
    }
    phase_final(p, bid, nblk);
}

extern "C" void kernel_launch(void* const* d_in, const int* in_sizes, int n_in, void* d_out, int out_size, void* d_ws, size_t ws_size, hipStream_t stream) {
    static int grid_blocks = 0;
    if (grid_blocks == 0) {
        int dev = 0, cus = 0, per_cu = 0;
        hipGetDevice(&dev);
        hipDeviceGetAttribute(&cus, hipDeviceAttributeMultiprocessorCount, dev);
        if (hipFuncSetAttribute((const void*)k_mega, hipFuncAttributeMaxDynamicSharedMemorySize, LDS_BYTES) != hipSuccess) { fprintf(stderr, "hipFuncSetAttribute failed\n"); grid_blocks = -1; return; }
        if (hipOccupancyMaxActiveBlocksPerMultiprocessor(&per_cu, (const void*)k_mega, 512, LDS_BYTES) != hipSuccess || per_cu < 1) { fprintf(stderr, "occupancy query failed (%d)\n", per_cu); per_cu = 1; }
        (void)hipGetLastError();
        grid_blocks = cus * per_cu;
    }
    if (grid_blocks < 0) return;
    P p{};
    const float** f = (const float**)&p;
    for (int i = 0; i < 28; ++i) f[i] = (const float*)d_in[i];
    p.out = (float*)d_out;
    size_t off = 0;
    auto take = [&](size_t bytes) { void* r = (char*)d_ws + off; off += (bytes + 255) & ~(size_t)255; return r; };
    p.W13a = (bf16_t*)take((size_t)2 * DFF * DM * 2);
    p.W2a = (bf16_t*)take((size_t)DM * DFF * 2);
    p.Win = (bf16_t*)take((size_t)DIN * DM * 2);
    p.Wout = (bf16_t*)take((size_t)DM * DM * 2);
    p.W13b = (bf16_t*)take((size_t)2 * DFF * DM * 2);
    p.W2b = (bf16_t*)take((size_t)DM * DFF * 2);
    p.h = (float*)take((size_t)MP * DM * 4);
    p.hb = (bf16_t*)take((size_t)MP * DM * 2);
    p.big = (bf16_t*)take((size_t)MP * DIN * 2);
    p.y = (bf16_t*)take((size_t)MP * DM * 2);
    p.vt = (bf16_t*)take((size_t)NB * 6 * 64 * LPV * 2);
    p.part = (float*)take((size_t)MP * 16 * 4);
    p.lw = (float*)take((size_t)MP * DRW * 4);
    p.aa = (float*)take((size_t)MP * DRW * 4);
    p.gg = (float*)take((size_t)MP * DRW * 4);
    if (off > ws_size) { fprintf(stderr, "workspace too small: need %zu have %zu\n", off, ws_size); return; }
    void* args[] = {&p};
    hipError_t e = hipLaunchCooperativeKernel((const void*)k_mega, dim3(grid_blocks), dim3(512), args, LDS_BYTES, stream);
    if (e != hipSuccess) fprintf(stderr, "cooperative launch failed: %s (grid %d)\n", hipGetErrorString(e), grid_blocks);
}
```

```cpp
#include <hip/hip_runtime.h>
#include <hip/hip_cooperative_groups.h>
#include <stdint.h>
#include <stdio.h>

typedef unsigned short bf16_t;
typedef short bf16x8 __attribute__((ext_vector_type(8)));
typedef float f32x4 __attribute__((ext_vector_type(4)));
typedef unsigned u32x4 __attribute__((ext_vector_type(4)));
typedef unsigned u32x2 __attribute__((ext_vector_type(2)));

#define DEV __device__ __forceinline__

constexpr int NB = 8, SEQ = 2048, NMETA = 16, LT = 2064, DM = 1024, DFF = 2816, DIN = 3072;
constexpr int MMAIN = 16384, MTOK = 16512, MP = 16640;
constexpr int DRW = 384, LPV = 2080;
constexpr int C_RW = 512, C_Q = 1920, C_K = 2304, C_V = 2688;

struct P {
    const float *x, *meta, *ffn1_norm, *ffn1_w13, *ffn1_w2, *mix_norm, *w_in, *conv_w, *conv_b, *conv_ln_g, *conv_ln_b,
        *rwkv_mu, *rwkv_w0, *rwkv_wB, *rwkv_a0, *rwkv_aB, *rwkv_gB, *rwkv_kk, *rwkv_ka, *rwkv_rk, *rwkv_ln_g, *rwkv_ln_b,
        *sb_norm, *w_out, *ffn2_norm, *ffn2_w13, *ffn2_w2, *final_norm;
    float* out;
    bf16_t *W13a, *W2a, *Win, *Wout, *W13b, *W2b;
    float* h; bf16_t* hb; bf16_t* big; bf16_t* y; bf16_t* vt; float* part;
    float *lw, *aa, *gg, *oraw, *ct;
};

typedef const __attribute__((address_space(4))) P CP;
DEV CP* kargs() { CP* k = (CP*)__builtin_amdgcn_kernarg_segment_ptr(); asm volatile("" : "+s"(k)); return k; }
DEV int tid_() { int t = threadIdx.x; asm volatile("" : "+v"(t)); return t; }
DEV float bf2f(bf16_t v) { return __uint_as_float(((unsigned)v) << 16); }
DEV bf16_t f2bf(float f) { unsigned u = __float_as_uint(f); u += 0x7FFFu + ((u >> 16) & 1u); return (bf16_t)(u >> 16); }
DEV unsigned pack2(float a, float b) { return (unsigned)f2bf(a) | ((unsigned)f2bf(b) << 16); }
DEV float wave_sum(float v) {
#pragma unroll
    for (int o = 32; o; o >>= 1) v += __shfl_xor(v, o);
    return v;
}
DEV float sigm(float x) { return 1.f / (1.f + expf(-x)); }
DEV int row_of(int b, int pos) { return pos < NMETA ? MMAIN + b * NMETA + pos : b * SEQ + pos - NMETA; }
DEV float row_rstd(const float* part, int row) {
    const f32x4* pp = (const f32x4*)(part + (size_t)row * 16);
    f32x4 a = pp[0], b = pp[1], c = pp[2], d = pp[3];
    float ss = ((a[0] + a[1]) + (a[2] + a[3])) + ((b[0] + b[1]) + (b[2] + b[3])) + ((c[0] + c[1]) + (c[2] + c[3])) + ((d[0] + d[1]) + (d[2] + d[3]));
    return rsqrtf(ss * (1.0f / 1024.0f) + 1e-6f);
}

DEV void phase_init(CP& p, int bid, int nblk) {
    const int lane = tid_() & 63, wave = tid_() >> 6;
    for (int r = bid * 8 + wave; r < MP; r += nblk * 8) {
        const float* src = nullptr;
        if (r < MMAIN) src = p.x + (size_t)r * DM;
        else if (r < MTOK) src = p.meta + (size_t)((r - MMAIN) & 15) * DM;
        float ss = 0.f;
#pragma unroll
        for (int i = 0; i < 4; ++i) {
            const int c = (i * 64 + lane) * 4;
            f32x4 v = src ? *(const f32x4*)(src + c) : (f32x4){0.f, 0.f, 0.f, 0.f};
            *(f32x4*)(p.h + (size_t)r * DM + c) = v;
            u32x2 w; w.x = pack2(v[0], v[1]); w.y = pack2(v[2], v[3]);
            *(u32x2*)(p.hb + (size_t)r * DM + c) = w;
            ss += v[0] * v[0] + v[1] * v[1] + v[2] * v[2] + v[3] * v[3];
        }
        ss = wave_sum(ss);
        if (lane < 16) p.part[(size_t)r * 16 + lane] = lane == 0 ? ss : 0.f;
    }
    for (int i = bid * 512 + tid_(); i < NB * 6 * 64 * (LPV - LT); i += nblk * 512) p.vt[(size_t)(i >> 4) * LPV + LT + (i & 15)] = 0;
}

DEV void convert_tile(const float* __restrict__ W, int K, int N, const float* __restrict__ g, bf16_t* __restrict__ dst, int swz, int kt, int nt, float* tile) {
    const int tid = tid_(), k0 = kt * 64, n0 = nt * 64;
#pragma unroll
    for (int i = 0; i < 8; ++i) {
        const int idx = tid + i * 512, kk = idx >> 6, nn = idx & 63;
        float v = W[(size_t)(k0 + kk) * N + n0 + nn];
        if (g) v *= g[k0 + kk];
        tile[kk * 65 + nn] = v;
    }
    __syncthreads();
#pragma unroll
    for (int i = 0; i < 4; ++i) {
        const int idx = tid + i * 512, nn = idx >> 5, kp = (idx & 31) * 2;
        const int s = n0 + nn;
        int nd = s;
        if (swz) { const int bj = s >= DFF ? 1 : 0; const int j = s - bj * DFF; nd = (j >> 7) * 256 + bj * 128 + (j & 127); }
        *(unsigned*)(dst + (size_t)nd * K + k0 + kp) = pack2(tile[kp * 65 + nn], tile[(kp + 1) * 65 + nn]);
    }
    __syncthreads();
}
DEV void phase_convert(CP& p, int l, int bid, int nblk, float* lds) {
    for (int it = bid; it < 5248; it += nblk) {
        int t = it;
        if (t < 1408) { convert_tile(p.ffn1_w13 + (size_t)l * DM * 2 * DFF, DM, 2 * DFF, p.ffn1_norm + l * DM, p.W13a, 1, t / 88, t % 88, lds); continue; }
        t -= 1408;
        if (t < 704) { convert_tile(p.ffn1_w2 + (size_t)l * DFF * DM, DFF, DM, nullptr, p.W2a, 0, t / 16, t % 16, lds); continue; }
        t -= 704;
        if (t < 768) { convert_tile(p.w_in + (size_t)l * DM * DIN, DM, DIN, p.mix_norm + l * DM, p.Win, 0, t / 48, t % 48, lds); continue; }
        t -= 768;
        if (t < 256) { convert_tile(p.w_out + (size_t)l * DM * DM, DM, DM, nullptr, p.Wout, 0, t / 16, t % 16, lds); continue; }
        t -= 256;
        if (t < 1408) { convert_tile(p.ffn2_w13 + (size_t)l * DM * 2 * DFF, DM, 2 * DFF, p.ffn2_norm + l * DM, p.W13b, 1, t / 88, t % 88, lds); continue; }
        t -= 1408;
        convert_tile(p.ffn2_w2 + (size_t)l * DFF * DM, DFF, DM, nullptr, p.W2b, 0, t / 16, t % 16, lds);
    }
}

enum { EPI_SWIGLU = 0, EPI_RESID = 1, EPI_P = 2 };

DEV void epi_swiglu(CP& p, int row, int colh, f32x4 g, f32x4 u, float rs) {
    float o[4];
#pragma unroll
    for (int e = 0; e < 4; ++e) { const float gg = g[e] * rs, uu = u[e] * rs; o[e] = gg * sigm(gg) * uu; }
    u32x2 w; w.x = pack2(o[0], o[1]); w.y = pack2(o[2], o[3]);
    *(u32x2*)(p.big + (size_t)row * DFF + colh) = w;
}
DEV float epi_resid(CP& p, int row, int col, f32x4 a, float scale) {
    float* hp = p.h + (size_t)row * DM + col;
    f32x4 hv = *(const f32x4*)hp;
    hv += a * scale;
    *(f32x4*)hp = hv;
    u32x2 w; w.x = pack2(hv[0], hv[1]); w.y = pack2(hv[2], hv[3]);
    *(u32x2*)(p.hb + (size_t)row * DM + col) = w;
    return hv[0] * hv[0] + hv[1] * hv[1] + hv[2] * hv[2] + hv[3] * hv[3];
}
DEV void epi_p(CP& p, int row, int col, f32x4 a, float rs) {
    a *= rs;
    u32x2 w; w.x = pack2(a[0], a[1]); w.y = pack2(a[2], a[3]);
    *(u32x2*)(p.big + (size_t)row * DIN + col) = w;
    if (col >= C_V && row < MTOK) {
        const int hh = (col - C_V) >> 6, d = (col - C_V) & 63;
        int b, pos;
        if (row < MMAIN) { b = row >> 11; pos = (row & 2047) + NMETA; } else { b = (row - MMAIN) >> 4; pos = (row - MMAIN) & 15; }
        bf16_t* vp = p.vt + ((size_t)((b * 6 + hh) * 64 + d)) * LPV + pos;
#pragma unroll
        for (int e = 0; e < 4; ++e) vp[(size_t)e * LPV] = f2bf(a[e]);
    }
}

template <int EPI>
DEV void gemm_v0(CP& p, const bf16_t* __restrict__ A, const bf16_t* __restrict__ Bt, int row_begin, int row_end, int N, int K, float scale, int bid, int nblk) {
    const int lane = tid_() & 63, wave = tid_() >> 6, fr = lane & 15, fq = lane >> 4;
    const int nt = N / 64, total = ((row_end - row_begin) / 32) * nt;
    for (int u = bid * 8 + wave; u < total; u += nblk * 8) {
        const int mu = u / nt, nu = u % nt, row0 = row_begin + mu * 32;
        const int cb = (EPI == EPI_SWIGLU) ? ((nu >> 2) * 256 + (nu & 3) * 32) : nu * 64;
        f32x4 acc[2][4];
#pragma unroll
        for (int i = 0; i < 2; ++i)
#pragma unroll
            for (int j = 0; j < 4; ++j) acc[i][j] = (f32x4){0.f, 0.f, 0.f, 0.f};
        const bf16_t* ap = A + (size_t)(row0 + fr) * K + fq * 8;
        const bf16_t* bp = Bt + (size_t)(cb + fr) * K + fq * 8;
#pragma unroll 2
        for (int k0 = 0; k0 < K; k0 += 32) {
            const bf16x8 a0 = *(const bf16x8*)(ap + k0), a1 = *(const bf16x8*)(ap + (size_t)16 * K + k0);
#pragma unroll
            for (int j = 0; j < 4; ++j) {
                const int co = (EPI == EPI_SWIGLU) ? ((j & 1) * 16 + (j >> 1) * 128) : j * 16;
                const bf16x8 b = *(const bf16x8*)(bp + (size_t)co * K + k0);
                acc[0][j] = __builtin_amdgcn_mfma_f32_16x16x32_bf16(b, a0, acc[0][j], 0, 0, 0);
                acc[1][j] = __builtin_amdgcn_mfma_f32_16x16x32_bf16(b, a1, acc[1][j], 0, 0, 0);
            }
        }
#pragma unroll
        for (int i = 0; i < 2; ++i) {
            const int row = row0 + 16 * i + fr;
            if (EPI == EPI_SWIGLU) {
                const float rs = row_rstd(p.part, row);
                const int colh = (nu >> 2) * 128 + (nu & 3) * 32 + 4 * fq;
                epi_swiglu(p, row, colh, acc[i][0], acc[i][2], rs);
                epi_swiglu(p, row, colh + 16, acc[i][1], acc[i][3], rs);
            } else if (EPI == EPI_RESID) {
                float ss = 0.f;
#pragma unroll
                for (int j = 0; j < 4; ++j) ss += epi_resid(p, row, cb + 16 * j + 4 * fq, acc[i][j], scale);
                ss += __shfl_xor(ss, 16); ss += __shfl_xor(ss, 32);
                if (fq == 0) p.part[(size_t)row * 16 + nu] = ss;
            } else {
                const float rs = row_rstd(p.part, row);
#pragma unroll
                for (int j = 0; j < 4; ++j) epi_p(p, row, cb + 16 * j + 4 * fq, acc[i][j], rs);
            }
        }
    }
}

template <int EPI>
DEV void gemm_meta(CP& p, const bf16_t* __restrict__ A, const bf16_t* __restrict__ Bt, int N, int K, float scale, int bid, int nblk, float* lds) {
    const int tid = tid_(), lane = tid & 63, wave = tid >> 6, fr = lane & 15, fq = lane >> 4;
    const int nt = N / 64, total = 4 * nt, kw = K / 8;
    float* red = lds + 8 * 8 * 64 * 4;
    for (int u = bid; u < total; u += nblk) {
        const int mu = u / nt, nu = u % nt, row0 = MMAIN + mu * 32;
        const int cb = (EPI == EPI_SWIGLU) ? ((nu >> 2) * 256 + (nu & 3) * 32) : nu * 64;
        f32x4 acc[2][4];
#pragma unroll
        for (int i = 0; i < 2; ++i)
#pragma unroll
            for (int j = 0; j < 4; ++j) acc[i][j] = (f32x4){0.f, 0.f, 0.f, 0.f};
        const bf16_t* ap = A + (size_t)(row0 + fr) * K + wave * kw + fq * 8;
        const bf16_t* bp = Bt + (size_t)(cb + fr) * K + wave * kw + fq * 8;
        for (int k0 = 0; k0 < kw; k0 += 32) {
            const bf16x8 a0 = *(const bf16x8*)(ap + k0), a1 = *(const bf16x8*)(ap + (size_t)16 * K + k0);
#pragma unroll
            for (int j = 0; j < 4; ++j) {
                const int co = (EPI == EPI_SWIGLU) ? ((j & 1) * 16 + (j >> 1) * 128) : j * 16;
                const bf16x8 bv = *(const bf16x8*)(bp + (size_t)co * K + k0);
                acc[0][j] = __builtin_amdgcn_mfma_f32_16x16x32_bf16(bv, a0, acc[0][j], 0, 0, 0);
                acc[1][j] = __builtin_amdgcn_mfma_f32_16x16x32_bf16(bv, a1, acc[1][j], 0, 0, 0);
            }
        }
#pragma unroll
        for (int i = 0; i < 2; ++i)
#pragma unroll
            for (int j = 0; j < 4; ++j) *(f32x4*)(lds + ((wave * 8 + i * 4 + j) * 64 + lane) * 4) = acc[i][j];
        __syncthreads();
        {
            f32x4 sum = (f32x4){0.f, 0.f, 0.f, 0.f};
#pragma unroll
            for (int w = 0; w < 8; ++w) sum += *(const f32x4*)(lds + ((w * 8 + wave) * 64 + lane) * 4);
            *(f32x4*)(red + (wave * 64 + lane) * 4) = sum;
        }
        __syncthreads();
        if (wave < 2) {
            const int i = wave, row = row0 + 16 * i + fr;
            f32x4 a[4];
#pragma unroll
            for (int j = 0; j < 4; ++j) a[j] = *(const f32x4*)(red + ((i * 4 + j) * 64 + lane) * 4);
            if (EPI == EPI_SWIGLU) {
                const float rs = row_rstd(p.part, row);
                const int colh = (nu >> 2) * 128 + (nu & 3) * 32 + 4 * fq;
                epi_swiglu(p, row, colh, a[0], a[2], rs);
                epi_swiglu(p, row, colh + 16, a[1], a[3], rs);
            } else if (EPI == EPI_RESID) {
                float ss = 0.f;
#pragma unroll
                for (int j = 0; j < 4; ++j) ss += epi_resid(p, row, cb + 16 * j + 4 * fq, a[j], scale);
                ss += __shfl_xor(ss, 16); ss += __shfl_xor(ss, 32);
                if (fq == 0) p.part[(size_t)row * 16 + nu] = ss;
            } else {
                const float rs = row_rstd(p.part, row);
#pragma unroll
                for (int j = 0; j < 4; ++j) epi_p(p, row, cb + 16 * j + 4 * fq, a[j], rs);
            }
        }
        __syncthreads();
    }
}

namespace pg8 {
#define PG8_LAS __attribute__((address_space(3)))
typedef unsigned short bf16_t;
typedef short bf16x8 __attribute__((ext_vector_type(8)));
typedef float f32x4 __attribute__((ext_vector_type(4)));
typedef unsigned u32x4 __attribute__((ext_vector_type(4)));
constexpr int BM = 256, BK = 64, HALF = 128, HTB = HALF * BK * 2  , STAGE_BYTES = 8 * HTB, NXCD = 8, WGM = 8;

__host__ __device__ __forceinline__ int lds_byte(int r, int c) { const int st = (r >> 4) * 2 + (c >> 5), rr = r & 15, cc = c & 31, ob = rr * 64 + cc * 2; return st * 1024 + (ob ^ (((ob >> 9) & 1) << 5)); }
__host__ __device__ __forceinline__ void stage_rc(int b, int& R, int& C) { const int st = b / 1024, sb = b % 1024, swz = sb ^ (((sb >> 9) & 1) << 5); R = (st >> 1) * 16 + swz / 64; C = (st & 1) * 32 + (swz % 64) / 2; }
__host__ __device__ __forceinline__ int perm32(int rho) { const int n = rho >> 4, i = rho & 15; return 8 * (i >> 2) + 4 * n + (i & 3); }

struct Unit { int pm, pn; };
struct Gemm { const bf16_t* A; const bf16_t* Bt; int M, N, K; };

struct StaticOrder {
    int nM, nN, nwg, G, c;
    __host__ __device__ void init(int M, int N, int G_, int c_) { nM = M / BM; nN = N / BM; nwg = nM * nN; G = G_; c = c_; }
    __host__ __device__ bool next(int i, Unit& u) const {
        const long L = (long)i * G + c; if (L >= nwg) return false;
        int wgid = (int)L; { const int q = nwg / NXCD, r = nwg % NXCD, xcd = wgid % NXCD, off = wgid / NXCD; wgid = (xcd < r ? xcd * (q + 1) : r * (q + 1) + (xcd - r) * q) + off; }
        const int nig = WGM * nN, gid = wgid / nig, fm = gid * WGM, gsz = (nM - fm) < WGM ? (nM - fm) : WGM;
        u.pm = fm + ((wgid % nig) % gsz); u.pn = (wgid % nig) / gsz; return true;
    }
    __device__ __forceinline__ void a_ready(const Unit&) const {}
    __device__ __forceinline__ void done(const Unit&) const {}
};
__device__ __forceinline__ unsigned cvt_pk_bf16(float lo, float hi) { unsigned r; asm volatile("v_cvt_pk_bf16_f32 %0, %1, %2" : "=v"(r) : "v"(lo), "v"(hi)); return r; }
template <class Epi, class Sched, bool STAMP = false>
__device__ __forceinline__ void gemm_phase(PG8_LAS unsigned char* lds, const Gemm g, const Sched& S, const Epi& E, unsigned long long* stamps) {
    const int tid = tid_(), wid = __builtin_amdgcn_readfirstlane(tid >> 6), lane = tid & 63, wr = wid >> 2, wc = wid & 3, fr = lane & 15, fq = lane >> 4;
    const int K = g.K, nt = K / BK;
    int ts_lo = 0, ts_hi = 0, nts = 0; const unsigned long long rt_entry = STAMP ? (unsigned long long)wall_clock64() : 0ull;
#define PG8_STAMP() do { if (STAMP && wid == 0 && nts < 64) { const unsigned long long _c = (unsigned long long)clock64(); \
        ts_lo = (lane == nts) ? (int)(unsigned)_c : ts_lo; ts_hi = (lane == nts) ? (int)(unsigned)(_c >> 32) : ts_hi; ++nts; } } while (0)
    PG8_STAMP();
    unsigned voffA[2], voffB[2];
#pragma unroll
    for (int i = 0; i < 2; ++i) { int R, C; stage_rc(tid * 16 + i * 8192, R, C); const int Rb = Epi::PERM ? ((R & ~31) + perm32(R & 31)) : R;
        voffA[i] = (unsigned)(R * K + C) * 2u; voffB[i] = (unsigned)(Rb * K + C) * 2u; }
    const size_t kstep = (size_t)(BK * 2);
    const size_t hstep = (size_t)HALF * K * 2;
    const size_t tstep = 2 * hstep;
    const unsigned ldsw = (unsigned)wid * 1024u;
    const int aoff = lds_byte(wr * 64 + fr, fq * 8), boff = lds_byte(wc * 32 + fr, fq * 8);
#define PG8_SA(b, h) (((b) * 2 + (h)) * HTB)
#define PG8_SB(b, h) ((4 + (b) * 2 + (h)) * HTB)
#define PG8_STAGE(bufoff, gbase, voff) do { _Pragma("unroll") for (int _i = 0; _i < 2; ++_i) \
        __builtin_amdgcn_global_load_lds((const unsigned*)((const char*)(gbase) + (voff)[_i]), (PG8_LAS unsigned*)(lds + (bufoff) + ldsw + _i * 8192), 16, 0, 0); } while (0)
#define PG8_LDA(dst, b, h) do { _Pragma("unroll") for (int m = 0; m < 4; ++m) _Pragma("unroll") for (int k = 0; k < 2; ++k) dst[m][k] = *(const PG8_LAS bf16x8*)(lds + PG8_SA(b, h) + aoff + m * 2048 + k * 1024); } while (0)
#define PG8_LDB(dst, b, h) do { _Pragma("unroll") for (int n = 0; n < 2; ++n) _Pragma("unroll") for (int k = 0; k < 2; ++k) dst[n][k] = *(const PG8_LAS bf16x8*)(lds + PG8_SB(b, h) + boff + n * 2048 + k * 1024); } while (0)
#define PG8_MMA(ai, bj, At, Bt) do { __builtin_amdgcn_s_setprio(1); _Pragma("unroll") for (int m = 0; m < 4; ++m) _Pragma("unroll") for (int n = 0; n < 2; ++n) _Pragma("unroll") for (int k = 0; k < 2; ++k) \
        acc[ai][bj][m][n] = __builtin_amdgcn_mfma_f32_16x16x32_bf16(Bt[n][k], At[m][k], acc[ai][bj][m][n], 0, 0, 0); __builtin_amdgcn_s_setprio(0); } while (0)
#define PG8_WAIT_V(n) asm volatile("s_waitcnt vmcnt(" #n ")" ::: "memory")
#define PG8_WAIT_L(n) asm volatile("s_waitcnt lgkmcnt(" #n ")" ::: "memory")
#define PG8_BAR __builtin_amdgcn_s_barrier()
#define PG8_SCHED __builtin_amdgcn_sched_barrier(0)
    Unit cur, nxt; int ui = 0;
    if (!S.next(0, cur)) return;
    f32x4 acc[2][2][4][2];
#pragma unroll
    for (int a = 0; a < 2; ++a)
#pragma unroll
        for (int b = 0; b < 2; ++b)
#pragma unroll
            for (int m = 0; m < 4; ++m)
#pragma unroll
                for (int n = 0; n < 2; ++n) acc[a][b][m][n] = (f32x4){0.f, 0.f, 0.f, 0.f};
    bf16x8 At[4][2], B0[2][2], B1[2][2];
    const char* cA = (const char*)g.A + (size_t)cur.pm * tstep; const char* cB = (const char*)g.Bt + (size_t)cur.pn * tstep;
    S.a_ready(cur);
    PG8_STAGE(PG8_SB(0, 0), cB, voffB); PG8_STAGE(PG8_SA(0, 0), cA, voffA); PG8_STAGE(PG8_SB(0, 1), cB + hstep, voffB); PG8_STAGE(PG8_SA(0, 1), cA + hstep, voffA);
    if (wr == 1) PG8_BAR;
    PG8_WAIT_V(4); PG8_BAR;
    PG8_STAGE(PG8_SB(1, 0), cB + kstep, voffB); PG8_STAGE(PG8_SA(1, 0), cA + kstep, voffA); PG8_STAGE(PG8_SB(1, 1), cB + hstep + kstep, voffB);
    PG8_WAIT_V(6); PG8_BAR;
    PG8_STAMP();
    for (;;) {
        const bool has_next = S.next(ui + 1, nxt);
        const char* nA = has_next ? (const char*)g.A + (size_t)nxt.pm * tstep : cA; const char* nB = has_next ? (const char*)g.Bt + (size_t)nxt.pn * tstep : cB;
        for (int t = 0; t < nt; t += 2) {
            const bool last = (t == nt - 2);
            const char* a1 = cA + (size_t)(t + 1) * kstep;
            const char* a2 = last ? nA : cA + (size_t)(t + 2) * kstep; const char* b2 = last ? nB : cB + (size_t)(t + 2) * kstep;
            const char* a3 = a2 + kstep; const char* b3 = b2 + kstep;
            if (last && has_next) S.a_ready(nxt);
            PG8_LDB(B0, 0, 0); PG8_SCHED; PG8_LDA(At, 0, 0); PG8_STAGE(PG8_SA(1, 1), a1 + hstep, voffA);
            PG8_WAIT_L(8); PG8_BAR; PG8_WAIT_L(0); PG8_MMA(0, 0, At, B0); PG8_BAR; PG8_SCHED;
            PG8_LDB(B1, 0, 1); PG8_STAGE(PG8_SB(0, 0), b2, voffB);
            PG8_BAR; PG8_WAIT_L(0); PG8_MMA(0, 1, At, B1); PG8_BAR;
            PG8_LDA(At, 0, 1); PG8_STAGE(PG8_SA(0, 0), a2, voffA);
            PG8_BAR; PG8_WAIT_L(0); PG8_MMA(1, 0, At, B0); PG8_BAR; PG8_SCHED;
            PG8_STAGE(PG8_SB(0, 1), b2 + hstep, voffB);
            PG8_WAIT_V(6); PG8_BAR; PG8_MMA(1, 1, At, B1); PG8_BAR;
            PG8_LDB(B0, 1, 0); PG8_SCHED; PG8_LDA(At, 1, 0); PG8_STAGE(PG8_SA(0, 1), a2 + hstep, voffA);
            PG8_WAIT_L(8); PG8_BAR; PG8_WAIT_L(0); PG8_MMA(0, 0, At, B0); PG8_BAR; PG8_SCHED;
            PG8_LDB(B1, 1, 1); PG8_STAGE(PG8_SB(1, 0), b3, voffB);
            PG8_BAR; PG8_WAIT_L(0); PG8_MMA(0, 1, At, B1); PG8_BAR;
            PG8_LDA(At, 1, 1); PG8_STAGE(PG8_SA(1, 0), a3, voffA);
            PG8_BAR; PG8_WAIT_L(0); PG8_MMA(1, 0, At, B0); PG8_BAR; PG8_SCHED;
            PG8_STAGE(PG8_SB(1, 1), b3 + hstep, voffB);
            PG8_WAIT_V(6); PG8_BAR; PG8_MMA(1, 1, At, B1); PG8_BAR;
        }
        PG8_STAMP();
        if constexpr (!Epi::AFTER_DRAIN) { E(acc, cur, wr, wc, fr, fq); S.done(cur); }
        PG8_STAMP();
        if (!has_next) break;
#pragma unroll
        for (int a = 0; a < 2; ++a)
#pragma unroll
            for (int b = 0; b < 2; ++b)
#pragma unroll
                for (int m = 0; m < 4; ++m)
#pragma unroll
                    for (int n = 0; n < 2; ++n) acc[a][b][m][n] = (f32x4){0.f, 0.f, 0.f, 0.f};
        cur = nxt; cA = nA; cB = nB; ++ui;
    }
    PG8_WAIT_V(0);
    if (wr == 0) PG8_BAR;
    PG8_BAR;
    if constexpr (Epi::AFTER_DRAIN) { E.fused(acc, cur, wr, wc, fr, fq, lds, wid, lane); S.done(cur); }
    PG8_STAMP();
    if (STAMP && wid == 0) { stamps[lane] = lane < nts ? (((unsigned long long)(unsigned)ts_hi << 32) | (unsigned)ts_lo) : 0ull;
        if (lane == 62) stamps[62] = rt_entry; if (lane == 63) stamps[63] = (unsigned long long)wall_clock64(); }
#undef PG8_STAMP
#undef PG8_SA
#undef PG8_SB
#undef PG8_STAGE
#undef PG8_LDA
#undef PG8_LDB
#undef PG8_MMA
#undef PG8_WAIT_V
#undef PG8_WAIT_L
#undef PG8_BAR
#undef PG8_SCHED
}
}

DEV float fsig(float x) { return __builtin_amdgcn_rcpf(1.f + __expf(-x)); }
DEV u32x4 pack8(f32x4 a, f32x4 b) { u32x4 w; w.x = pg8::cvt_pk_bf16(a[0], a[1]); w.y = pg8::cvt_pk_bf16(a[2], a[3]); w.z = pg8::cvt_pk_bf16(b[0], b[1]); w.w = pg8::cvt_pk_bf16(b[2], b[3]); return w; }

DEV float row_rstd_q(const float* part, int row, int fq) {
    const f32x4 a = *(const f32x4*)(part + (size_t)row * 16 + fq * 4);
    float ss = (a[0] + a[1]) + (a[2] + a[3]);
    ss += __shfl_xor(ss, 16); ss += __shfl_xor(ss, 32);
    return rsqrtf(ss * (1.0f / 1024.0f) + 1e-6f);
}
struct EpiSwiglu {
    static constexpr bool PERM = true, AFTER_DRAIN = false;
    bf16_t* hid; const float* part;
    __device__ __forceinline__ void operator()(const f32x4 (&acc)[2][2][4][2], const pg8::Unit& u, int wr, int wc, int fr, int fq) const {
#pragma unroll
        for (int ai = 0; ai < 2; ++ai)
#pragma unroll
            for (int m = 0; m < 4; ++m) {
                __builtin_amdgcn_sched_barrier(0);
                const int row = u.pm * 256 + ai * 128 + wr * 64 + m * 16 + fr;
                const float rs = row_rstd_q(part, row, fq);
                f32x4 o[2];
#pragma unroll
                for (int n = 0; n < 2; ++n)
#pragma unroll
                    for (int e = 0; e < 4; ++e) { const float g = acc[ai][0][m][n][e] * rs, up = acc[ai][1][m][n][e] * rs; o[n][e] = g * fsig(g) * up; }
                *(u32x4*)(hid + (size_t)row * DFF + u.pn * 128 + wc * 32 + fq * 8) = pack8(o[0], o[1]);
            }
    }
};
struct EpiResid {
    static constexpr bool PERM = true, AFTER_DRAIN = false;
    float* h; bf16_t* hb; float* part; float scale;
    __device__ __forceinline__ void operator()(const f32x4 (&acc)[2][2][4][2], const pg8::Unit& u, int wr, int wc, int fr, int fq) const {
#pragma unroll
        for (int ai = 0; ai < 2; ++ai)
#pragma unroll
            for (int m = 0; m < 4; ++m) {
                __builtin_amdgcn_sched_barrier(0);
                const int row = u.pm * 256 + ai * 128 + wr * 64 + m * 16 + fr;
                float ss = 0.f;
#pragma unroll
                for (int bj = 0; bj < 2; ++bj) {
                    const int col = u.pn * 256 + bj * 128 + wc * 32 + fq * 8;
                    float* hp = h + (size_t)row * DM + col;
                    f32x4 h0 = *(const f32x4*)hp, h1 = *(const f32x4*)(hp + 4);
                    h0 += acc[ai][bj][m][0] * scale; h1 += acc[ai][bj][m][1] * scale;
                    *(f32x4*)hp = h0; *(f32x4*)(hp + 4) = h1;
                    *(u32x4*)(hb + (size_t)row * DM + col) = pack8(h0, h1);
                    ss += (h0[0] * h0[0] + h0[1] * h0[1]) + (h0[2] * h0[2] + h0[3] * h0[3]) + (h1[0] * h1[0] + h1[1] * h1[1]) + (h1[2] * h1[2] + h1[3] * h1[3]);
                }
                ss += __shfl_xor(ss, 16); ss += __shfl_xor(ss, 32);
                if (fq == 0) part[(size_t)row * 16 + u.pn * 4 + wc] = ss;
            }
    }
};
struct EpiP {
    static constexpr bool PERM = true, AFTER_DRAIN = false;
    bf16_t* big; bf16_t* vt; const float* part;
    __device__ __forceinline__ void operator()(const f32x4 (&acc)[2][2][4][2], const pg8::Unit& u, int wr, int wc, int fr, int fq) const {
#pragma unroll
        for (int ai = 0; ai < 2; ++ai)
#pragma unroll
            for (int m = 0; m < 4; ++m) {
                __builtin_amdgcn_sched_barrier(0);
                const int row = u.pm * 256 + ai * 128 + wr * 64 + m * 16 + fr;
                const float rs = row_rstd_q(part, row, fq);
#pragma unroll
                for (int bj = 0; bj < 2; ++bj) {
                    const int col = u.pn * 256 + bj * 128 + wc * 32 + fq * 8;
                    const f32x4 a0 = acc[ai][bj][m][0] * rs, a1 = acc[ai][bj][m][1] * rs;
                    const u32x4 w = pack8(a0, a1);
                    *(u32x4*)(big + (size_t)row * DIN + col) = w;
                    if (col >= C_V && row < MTOK) {
                        const int hh = (col - C_V) >> 6, d = (col - C_V) & 63;
                        int b, pos;
                        if (row < MMAIN) { b = row >> 11; pos = (row & 2047) + NMETA; } else { b = (row - MMAIN) >> 4; pos = (row - MMAIN) & 15; }
                        bf16_t* vp = vt + ((size_t)((b * 6 + hh) * 64 + d)) * LPV + pos;
#pragma unroll
                        for (int e = 0; e < 4; ++e) { vp[(size_t)(2 * e) * LPV] = (bf16_t)(w[e] & 0xFFFFu); vp[(size_t)(2 * e + 1) * LPV] = (bf16_t)(w[e] >> 16); }
                    }
                }
            }
    }
};
template <class Epi>
DEV void gemm_big(const bf16_t* A, const bf16_t* Bt, int M, int N, int K, const Epi& E, int bid, int nblk, unsigned char* smem) {
    pg8::StaticOrder S; S.init(M, N, nblk, bid);
    const pg8::Gemm g{A, Bt, M, N, K};
    pg8::gemm_phase<Epi, pg8::StaticOrder, false>((PG8_LAS unsigned char*)smem, g, S, E, nullptr);
}

DEV void phase_conv(CP& p, int l, int bid, int nblk, float* lds) {
    float* cS = lds;
    float* yS = lds + 46 * 256;
    const int tid = tid_(), ch = tid & 255, half = tid >> 8, lane = tid & 63, wave = tid >> 6;
    float wreg[31];
#pragma unroll
    for (int j = 0; j < 31; ++j) wreg[j] = p.conv_w[(size_t)l * 31 * 256 + j * 256 + ch];
    const float cb = p.conv_b[l * 256 + ch];
    for (int it = bid; it < NB * 129; it += nblk) {
        const int b = it / 129, p0 = (it % 129) * 16;
        __syncthreads();
        for (int e = tid; e < 46 * 256; e += 512) {
            const int pp = e >> 8, c = e & 255, pos = p0 - 30 + pp;
            float v = 0.f;
            if (pos >= 0) { const size_t ro = (size_t)row_of(b, pos) * DIN; v = bf2f(p.big[ro + c]) * sigm(bf2f(p.big[ro + 256 + c])); }
            cS[e] = v;
        }
        __syncthreads();
#pragma unroll
        for (int i = 0; i < 8; ++i) {
            const int ii = half * 8 + i;
            float acc = cb;
#pragma unroll
            for (int j = 0; j < 31; ++j) acc += wreg[j] * cS[(ii + j) * 256 + ch];
            yS[ii * 256 + ch] = acc;
        }
        __syncthreads();
#pragma unroll
        for (int q = 0; q < 2; ++q) {
            const int ii = wave * 2 + q;
            const f32x4 v = *(const f32x4*)(yS + ii * 256 + lane * 4);
            const float mu = wave_sum((v[0] + v[1]) + (v[2] + v[3])) * (1.f / 256.f);
            const f32x4 d = v - mu;
            const float var = wave_sum(d[0] * d[0] + d[1] * d[1] + d[2] * d[2] + d[3] * d[3]) * (1.f / 256.f);
            const float rs = rsqrtf(var + 1e-5f);
            const f32x4 g = *(const f32x4*)(p.conv_ln_g + l * 256 + lane * 4), bb = *(const f32x4*)(p.conv_ln_b + l * 256 + lane * 4);
            float o[4];
#pragma unroll
            for (int e = 0; e < 4; ++e) { const float yn = d[e] * rs * g[e] + bb[e]; o[e] = yn * sigm(yn); }
            u32x2 w; w.x = pack2(o[0], o[1]); w.y = pack2(o[2], o[3]);
            *(u32x2*)(p.y + (size_t)row_of(b, p0 + ii) * DM + lane * 4) = w;
        }
    }
}

DEV void phase_rwkv_prep(CP& p, int l, int bid, int nblk, float* lds) {
    float* xin = lds;
    const int tid = tid_();
    const float* mu = p.rwkv_mu + (size_t)l * 1408;
    for (int it = bid; it < NB * 258; it += nblk) {
        const int b = it / 258, p0 = (it % 258) * 8;
        __syncthreads();
        for (int e = tid; e < 8 * 256; e += 512) {
            const int tk = e >> 8, c = e & 255, pos = p0 + tk;
            const float cur = bf2f(p.big[(size_t)row_of(b, pos) * DIN + C_RW + 1152 + c]);
            const float prv = pos > 0 ? bf2f(p.big[(size_t)row_of(b, pos - 1) * DIN + C_RW + 1152 + c]) : 0.f;
            float xs = cur + mu[1152 + c] * (prv - cur);
            if (c < 64) xs = tanhf(xs); else if (c >= 128) xs = sigm(xs);
            xin[e] = xs;
        }
        __syncthreads();
        if (tid < DRW) {
            const int c = tid;
            float aw[8], aa[8], ag[8];
#pragma unroll
            for (int t = 0; t < 8; ++t) { aw[t] = 0.f; aa[t] = 0.f; ag[t] = 0.f; }
            const float* wB = p.rwkv_wB + (size_t)l * 64 * DRW + c;
            const float* aB = p.rwkv_aB + (size_t)l * 64 * DRW + c;
            const float* gB = p.rwkv_gB + (size_t)l * 128 * DRW + c;
            for (int i = 0; i < 64; ++i) {
                const float w1 = wB[(size_t)i * DRW], w2 = aB[(size_t)i * DRW];
#pragma unroll
                for (int t = 0; t < 8; ++t) { aw[t] += xin[t * 256 + i] * w1; aa[t] += xin[t * 256 + 64 + i] * w2; }
            }
            for (int i = 0; i < 128; ++i) {
                const float w3 = gB[(size_t)i * DRW];
#pragma unroll
                for (int t = 0; t < 8; ++t) ag[t] += xin[t * 256 + 128 + i] * w3;
            }
            const float w0 = p.rwkv_w0[l * DRW + c], a0 = p.rwkv_a0[l * DRW + c];
#pragma unroll
            for (int t = 0; t < 8; ++t) {
                const size_t o = (size_t)row_of(b, p0 + t) * DRW + c;
                const float xw = -(w0 + aw[t]);
                const float sp = fmaxf(xw, 0.f) + log1pf(expf(-fabsf(xw)));
                p.lw[o] = -expf(-sp - 0.5f);
                p.aa[o] = sigm(a0 + aa[t]);
                p.gg[o] = ag[t];
            }
        }
    }
}

DEV void phase_rwkv_scan(CP& p, int l, int bid, int nblk, float* lds) {
    float* rS = lds;
    float* wS = rS + 1024;
    float* kS = wS + 1024;
    float* vS = kS + 1024;
    float* nS = vS + 1024;
    float* bS = nS + 1024;
    float* gS = bS + 1024;
    float* oS = gS + 1024;
    float* cS = oS + 1024;
    const int tid = tid_(), lane = tid & 63, wave = tid >> 6;
    const int vi = tid >> 3, ks = tid & 7;
    const float* mu = p.rwkv_mu + (size_t)l * 1408;
    for (int it = bid; it < NB * 6; it += nblk) {
        const int b = it / 6, hh = it % 6;
        float S[8];
#pragma unroll
        for (int i = 0; i < 8; ++i) S[i] = 0.f;
        const int hc = hh * 64 + lane;
        const float mr = mu[hc], mk = mu[384 + hc], mv = mu[768 + hc];
        const float kkw = p.rwkv_kk[l * DRW + hc], kaw = p.rwkv_ka[l * DRW + hc], rkw = p.rwkv_rk[l * DRW + hc];
        const float lng = p.rwkv_ln_g[l * DRW + hc], lnb = p.rwkv_ln_b[l * DRW + hc];
        for (int ck = 0; ck < 129; ++ck) {
            const int p0 = ck * 16;
            __syncthreads();
#pragma unroll
            for (int q = 0; q < 2; ++q) {
                const int tk = wave * 2 + q, pos = p0 + tk;
                const int row = row_of(b, pos);
                const bf16_t* cur = p.big + (size_t)row * DIN + C_RW + hc;
                float r = bf2f(cur[0]), k = bf2f(cur[384]), v = bf2f(cur[768]);
                float pr = 0.f, pk = 0.f, pv = 0.f;
                if (pos > 0) { const bf16_t* prv = p.big + (size_t)row_of(b, pos - 1) * DIN + C_RW + hc; pr = bf2f(prv[0]); pk = bf2f(prv[384]); pv = bf2f(prv[768]); }
                r += mr * (pr - r); k += mk * (pk - k); v += mv * (pv - v);
                const size_t o = (size_t)row * DRW + hc;
                const float a = p.aa[o], w = expf(p.lw[o]), g = p.gg[o];
                const float kkr = k * kkw;
                const float nrm = fmaxf(sqrtf(wave_sum(kkr * kkr)), 1e-12f);
                const float kk = kkr / nrm;
                const float kp = k * (1.f + (a - 1.f) * kaw);
                const float ct = wave_sum(r * kp * rkw);
                const int e = tk * 64 + lane;
                rS[e] = r; wS[e] = w; kS[e] = kp; vS[e] = v; nS[e] = kk; bS[e] = kk * a; gS[e] = g;
                if (lane == 0) cS[tk] = ct;
            }
            __syncthreads();
            for (int tk = 0; tk < 16; ++tk) {
                const int e = tk * 64 + ks * 8;
                const f32x4 n0 = *(const f32x4*)(nS + e), n1 = *(const f32x4*)(nS + e + 4);
                float sa = 0.f;
#pragma unroll
                for (int i = 0; i < 4; ++i) { sa -= S[i] * n0[i]; sa -= S[4 + i] * n1[i]; }
                sa += __shfl_xor(sa, 1); sa += __shfl_xor(sa, 2); sa += __shfl_xor(sa, 4);
                const f32x4 w0 = *(const f32x4*)(wS + e), w1 = *(const f32x4*)(wS + e + 4);
                const f32x4 b0 = *(const f32x4*)(bS + e), b1 = *(const f32x4*)(bS + e + 4);
                const f32x4 k0 = *(const f32x4*)(kS + e), k1 = *(const f32x4*)(kS + e + 4);
                const f32x4 r0 = *(const f32x4*)(rS + e), r1 = *(const f32x4*)(rS + e + 4);
                const float vv = vS[tk * 64 + vi];
                float o = 0.f;
#pragma unroll
                for (int i = 0; i < 4; ++i) {
                    S[i] = S[i] * w0[i] + sa * b0[i] + vv * k0[i];
                    S[4 + i] = S[4 + i] * w1[i] + sa * b1[i] + vv * k1[i];
                    o += S[i] * r0[i]; o += S[4 + i] * r1[i];
                }
                o += __shfl_xor(o, 1); o += __shfl_xor(o, 2); o += __shfl_xor(o, 4);
                if (ks == 0) oS[tk * 64 + vi] = o;
            }
            __syncthreads();
#pragma unroll
            for (int q = 0; q < 2; ++q) {
                const int tk = wave * 2 + q, e = tk * 64 + lane;
                const float o = oS[e];
                const float m = wave_sum(o) * (1.f / 64.f);
                const float d = o - m;
                const float var = wave_sum(d * d) * (1.f / 64.f);
                float yv = d * rsqrtf(var + 64e-5f) * lng + lnb;
                yv = (yv + cS[tk] * vS[e]) * gS[e];
                p.y[(size_t)row_of(b, p0 + tk) * DM + 256 + hc] = f2bf(yv);
            }
        }
    }
}

DEV float dpp_sum16(float x) {
    x += __builtin_bit_cast(float, __builtin_amdgcn_update_dpp(0, __builtin_bit_cast(int, x), 0xB1, 0xF, 0xF, false));
    x += __builtin_bit_cast(float, __builtin_amdgcn_update_dpp(0, __builtin_bit_cast(int, x), 0x4E, 0xF, 0xF, false));
    x += __builtin_bit_cast(float, __builtin_amdgcn_update_dpp(0, __builtin_bit_cast(int, x), 0x141, 0xF, 0xF, false));
    x += __builtin_bit_cast(float, __builtin_amdgcn_update_dpp(0, __builtin_bit_cast(int, x), 0x140, 0xF, 0xF, false));
    return x;
}
constexpr int TCH = 32, NCH = 65;
struct ScanRegs { unsigned short r[8], k[8], v[8]; unsigned short pr, pk, pv; float a[8], lw[8]; };
DEV void scan_issue(CP& p, ScanRegs& R, int b, int hc, int c, int lwv) {
#pragma unroll
    for (int q = 0; q < 8; ++q) {
        const int pos = c * TCH + lwv * 8 + q;
        R.r[q] = 0; R.k[q] = 0; R.v[q] = 0; R.a[q] = 0.f; R.lw[q] = 0.f;
        if (pos < LT) {
            const int row = row_of(b, pos);
            const bf16_t* cur = p.big + (size_t)row * DIN + C_RW + hc;
            R.r[q] = cur[0]; R.k[q] = cur[384]; R.v[q] = cur[768];
            R.a[q] = p.aa[(size_t)row * DRW + hc]; R.lw[q] = p.lw[(size_t)row * DRW + hc];
        }
    }
    const int pp = c * TCH + lwv * 8 - 1;
    R.pr = 0; R.pk = 0; R.pv = 0;
    if (pp >= 0) { const bf16_t* prv = p.big + (size_t)row_of(b, pp) * DIN + C_RW + hc; R.pr = prv[0]; R.pk = prv[384]; R.pv = prv[768]; }
}
DEV void phase_rwkv_scan2(CP& p, int l, int item, float* lds) {
    const int tid = tid_(), lane = tid & 63;
    const int b = item / 24, hh = (item >> 2) % 6, rq = item & 3;
    if (tid >= 256) {
        const int lwv = (tid - 256) >> 6, hc = hh * 64 + lane;
        const float* mu = p.rwkv_mu + (size_t)l * 1408;
        const float mr = mu[hc], mk = mu[384 + hc], mv = mu[768 + hc];
        const float kkw = p.rwkv_kk[l * DRW + hc], kaw = p.rwkv_ka[l * DRW + hc], rkw = p.rwkv_rk[l * DRW + hc];
        ScanRegs R;
        scan_issue(p, R, b, hc, 0, lwv);
        for (int c = 0; c <= NCH; ++c) {
            if (c < NCH) {
                float* buf = lds + (c & 1) * (6 * TCH * 64);
                float pr = bf2f(R.pr), pk = bf2f(R.pk), pv = bf2f(R.pv);
#pragma unroll
                for (int q = 0; q < 8; ++q) {
                    const int tk = lwv * 8 + q;
                    const float r0 = bf2f(R.r[q]), k0 = bf2f(R.k[q]), v0 = bf2f(R.v[q]);
                    const float r = r0 + mr * (pr - r0), k = k0 + mk * (pk - k0), v = v0 + mv * (pv - v0);
                    pr = r0; pk = k0; pv = v0;
                    const float a = R.a[q], w = __expf(R.lw[q]);
                    const float kkr = k * kkw;
                    const float nrm = fmaxf(sqrtf(wave_sum(kkr * kkr)), 1e-12f);
                    const float kk = kkr / nrm;
                    const float kp = k * (1.f + (a - 1.f) * kaw);
                    const int e = tk * 64 + lane;
                    buf[e] = r; buf[2048 + e] = w; buf[4096 + e] = kp; buf[6144 + e] = v; buf[8192 + e] = kk; buf[10240 + e] = kk * a;
                    if (rq == 0) {
                        const float ct = wave_sum(r * kp * rkw);
                        const int pos = c * TCH + tk;
                        if (lane == 0 && pos < LT) p.ct[(size_t)row_of(b, pos) * 8 + hh] = ct;
                    }
                }
                if (c + 1 < NCH) scan_issue(p, R, b, hc, c + 1, lwv);
            }
            __syncthreads();
        }
    } else {
        const int vi = tid >> 4, ks = tid & 15, vrow = rq * 16 + vi;
        float S0 = 0.f, S1 = 0.f, S2 = 0.f, S3 = 0.f;
        __syncthreads();
        for (int c = 0; c < NCH; ++c) {
            const float* buf = lds + (c & 1) * (6 * TCH * 64);
            const int nst = (LT - c * TCH) < TCH ? (LT - c * TCH) : TCH;
            for (int tk = 0; tk < nst; ++tk) {
                const int e = tk * 64 + ks * 4;
                const f32x4 r4 = *(const f32x4*)(buf + e), w4 = *(const f32x4*)(buf + 2048 + e), k4 = *(const f32x4*)(buf + 4096 + e);
                const f32x4 n4 = *(const f32x4*)(buf + 8192 + e), b4 = *(const f32x4*)(buf + 10240 + e);
                const float vv = buf[6144 + tk * 64 + vrow];
                float sa = (S0 * n4[0] + S1 * n4[1]) + (S2 * n4[2] + S3 * n4[3]);
                const float t0 = S0 * w4[0] + vv * k4[0], t1 = S1 * w4[1] + vv * k4[1], t2 = S2 * w4[2] + vv * k4[2], t3 = S3 * w4[3] + vv * k4[3];
                sa = -dpp_sum16(sa);
                S0 = t0 + sa * b4[0]; S1 = t1 + sa * b4[1]; S2 = t2 + sa * b4[2]; S3 = t3 + sa * b4[3];
                float o = (S0 * r4[0] + S1 * r4[1]) + (S2 * r4[2] + S3 * r4[3]);
                o = dpp_sum16(o);
                if (ks == 0) p.oraw[(size_t)row_of(b, c * TCH + tk) * DRW + hh * 64 + vrow] = o;
            }
            __syncthreads();
        }
    }
}
DEV void phase_rwkv_post(CP& p, int l, int bid, int nblk) {
    const int tid = tid_(), lane = tid & 63, wave = tid >> 6;
    const float* mu = p.rwkv_mu + (size_t)l * 1408;
    for (int it = bid * 8 + wave; it < NB * LT * 6; it += nblk * 8) {
        const int hh = it % 6, tok = it / 6, b = tok / LT, pos = tok % LT;
        const int row = row_of(b, pos), hc = hh * 64 + lane;
        const float o = p.oraw[(size_t)row * DRW + hc];
        const float v0 = bf2f(p.big[(size_t)row * DIN + C_RW + 768 + hc]);
        const float pv = pos > 0 ? bf2f(p.big[(size_t)row_of(b, pos - 1) * DIN + C_RW + 768 + hc]) : 0.f;
        const float v = v0 + mu[768 + hc] * (pv - v0);
        const float g = p.gg[(size_t)row * DRW + hc], ct = p.ct[(size_t)row * 8 + hh];
        const float m = wave_sum(o) * (1.f / 64.f);
        const float d = o - m;
        const float var = wave_sum(d * d) * (1.f / 64.f);
        float yv = d * rsqrtf(var + 64e-5f) * p.rwkv_ln_g[l * DRW + hc] + p.rwkv_ln_b[l * DRW + hc];
        yv = (yv + ct * v) * g;
        p.y[(size_t)row * DM + 256 + hc] = f2bf(yv);
    }
}

DEV void phase_sb(CP& p, int l, int bid, int nblk, float* lds) {
    float* Ks = lds;
    float* Vs = lds + 2048;
    const int tid = tid_(), qi = tid >> 1, hf = tid & 1;
    for (int it = bid; it < NB * 6 * 9; it += nblk) {
        const int qt = it % 9, bh = it / 9, b = bh / 6, hh = bh % 6;
        const int t = qt * 256 + qi;
        const bool valid = t < LT;
        const int myrow = row_of(b, valid ? t : 0);
        float q[64], acc[32];
        {
            const bf16_t* qp = p.big + (size_t)myrow * DIN + C_Q + hh * 64;
#pragma unroll
            for (int i = 0; i < 8; ++i) {
                const u32x4 w = *(const u32x4*)(qp + i * 8);
#pragma unroll
                for (int e = 0; e < 4; ++e) { q[i * 8 + 2 * e] = __uint_as_float(w[e] << 16) * 0.125f; q[i * 8 + 2 * e + 1] = __uint_as_float(w[e] & 0xFFFF0000u) * 0.125f; }
            }
        }
#pragma unroll
        for (int d = 0; d < 32; ++d) acc[d] = 0.f;
        float carry = 0.f;
        int thi = qt * 256 + 254; if (thi > LT - 2) thi = LT - 2;
        for (int kt = thi >> 5; kt >= 0; --kt) {
            __syncthreads();
            {
                const int which = tid >> 8, key = (tid & 255) >> 3, part = tid & 7, s = kt * 32 + key;
                float f[8];
#pragma unroll
                for (int e = 0; e < 8; ++e) f[e] = 0.f;
                if (s < LT) {
                    const u32x4 w = *(const u32x4*)(p.big + (size_t)row_of(b, s) * DIN + (which ? C_V : C_K) + hh * 64 + part * 8);
#pragma unroll
                    for (int e = 0; e < 4; ++e) { f[2 * e] = __uint_as_float(w[e] << 16); f[2 * e + 1] = __uint_as_float(w[e] & 0xFFFF0000u); }
                }
                float* dst = (which ? Vs : Ks) + key * 64 + part * 8;
                *(f32x4*)dst = (f32x4){f[0], f[1], f[2], f[3]};
                *(f32x4*)(dst + 4) = (f32x4){f[4], f[5], f[6], f[7]};
            }
            __syncthreads();
            for (int kk = 31; kk >= 0; --kk) {
                const int s = kt * 32 + kk;
                if (valid && s < t) {
                    float z0 = 0.f, z1 = 0.f;
#pragma unroll
                    for (int i = 0; i < 16; ++i) {
                        if ((i & 3) == 0) asm volatile("" ::: "memory");
                        const f32x4 kv = *(const f32x4*)(Ks + kk * 64 + i * 4);
                        z0 += q[i * 4] * kv[0]; z1 += q[i * 4 + 1] * kv[1]; z0 += q[i * 4 + 2] * kv[2]; z1 += q[i * 4 + 3] * kv[3];
                    }
                    const float z = z0 + z1;
                    const float ls = fminf(z, 0.f) - log1pf(expf(-fabsf(z)));
                    const float a = expf(ls + carry);
                    carry += ls - z;
#pragma unroll
                    for (int i = 0; i < 8; ++i) {
                        const f32x4 vv = *(const f32x4*)(Vs + kk * 64 + hf * 32 + i * 4);
                        acc[i * 4] += a * vv[0]; acc[i * 4 + 1] += a * vv[1]; acc[i * 4 + 2] += a * vv[2]; acc[i * 4 + 3] += a * vv[3];
                    }
                }
            }
            if (__syncthreads_and((!valid || carry < -110.f) ? 1 : 0)) break;
        }
        float ms = 0.f;
#pragma unroll
        for (int d = 0; d < 32; ++d) ms += acc[d] * acc[d];
        ms += __shfl_xor(ms, 1);
        if (valid) {
            const float rs = rsqrtf(ms * (1.f / 64.f) + 1e-6f);
            const float* g = p.sb_norm + l * 384 + hh * 64 + hf * 32;
            bf16_t* yp = p.y + (size_t)myrow * DM + 640 + hh * 64 + hf * 32;
#pragma unroll
            for (int i = 0; i < 4; ++i) {
                u32x4 w;
#pragma unroll
                for (int e = 0; e < 4; ++e) w[e] = pack2(acc[i * 8 + 2 * e] * rs * g[i * 8 + 2 * e], acc[i * 8 + 2 * e + 1] * rs * g[i * 8 + 2 * e + 1]);
                *(u32x4*)(yp + i * 8) = w;
            }
        }
    }
}

typedef float f32x16 __attribute__((ext_vector_type(16)));
typedef __bf16 bfv2 __attribute__((ext_vector_type(2)));
typedef float f32x2v __attribute__((ext_vector_type(2)));
typedef short s16x4 __attribute__((ext_vector_type(4)));
DEV unsigned cvt2(float a, float b) { return __builtin_bit_cast(unsigned, __builtin_convertvector((f32x2v){a, b}, bfv2)); }
DEV bf16x8 pack_frag(float a0, float a1, float a2, float a3, float a4, float a5, float a6, float a7) {
    u32x4 w; w.x = cvt2(a0, a1); w.y = cvt2(a2, a3); w.z = cvt2(a4, a5); w.w = cvt2(a6, a7);
    return __builtin_bit_cast(bf16x8, w);
}
DEV void phase_sb_mfma(CP& p, int l, int bid, int nblk) {
    const int tid = tid_(), lane = tid & 63, wave = tid >> 6, r = lane & 31, h = lane >> 5;
    for (int it = bid * 8 + wave; it < NB * 6 * 65; it += nblk * 8) {
        const int qt = it % 65, bh = it / 65, b = bh / 6, hh = bh % 6;
        const int q0 = qt * 32, t = q0 + r;
        const bool valid = t < LT;
        const int myrow = row_of(b, valid ? t : LT - 1);
        bf16x8 qf[4];
        {
            const bf16_t* qp = p.big + (size_t)myrow * DIN + C_Q + hh * 64 + 8 * h;
#pragma unroll
            for (int ks = 0; ks < 4; ++ks) qf[ks] = *(const bf16x8*)(qp + 16 * ks);
        }
        f32x16 o0, o1;
#pragma unroll
        for (int i = 0; i < 16; ++i) { o0[i] = 0.f; o1[i] = 0.f; }
        float carry = 0.f;
        const bf16_t* vbase = p.vt + (size_t)((b * 6 + hh) * 64 + r) * LPV + 4 * h;
        bf16x8 kf[4];
        {
            const bf16_t* kp = p.big + (size_t)row_of(b, q0 + r) * DIN + C_K + hh * 64 + 8 * h;
#pragma unroll
            for (int ks = 0; ks < 4; ++ks) kf[ks] = *(const bf16x8*)(kp + 16 * ks);
        }
        for (int k0 = q0; k0 >= 0; k0 -= 32) {
            bf16x8 vf[2][2];
#pragma unroll
            for (int db = 0; db < 2; ++db)
#pragma unroll
                for (int s = 0; s < 2; ++s) {
                    const bf16_t* vp = vbase + (size_t)(db * 32) * LPV + k0 + 16 * s;
                    const s16x4 lo = *(const s16x4*)vp, hi = *(const s16x4*)(vp + 8);
                    vf[db][s] = __builtin_shufflevector(lo, hi, 0, 1, 2, 3, 4, 5, 6, 7);
                }
            bf16x8 kn[4];
            {
                const int kpos = k0 >= 32 ? k0 - 32 + r : r;
                const bf16_t* kp = p.big + (size_t)row_of(b, kpos) * DIN + C_K + hh * 64 + 8 * h;
#pragma unroll
                for (int ks = 0; ks < 4; ++ks) kn[ks] = *(const bf16x8*)(kp + 16 * ks);
            }
            f32x16 x;
#pragma unroll
            for (int i = 0; i < 16; ++i) x[i] = 0.f;
#pragma unroll
            for (int ks = 0; ks < 4; ++ks) x = __builtin_amdgcn_mfma_f32_32x32x16_bf16(kf[ks], qf[ks], x, 0, 0, 0);
            float lr[16], ls[16];
#pragma unroll
            for (int i = 0; i < 16; ++i) {
                const int key = k0 + (i & 3) + 8 * (i >> 2) + 4 * h;
                const float z = x[i] * 0.125f;
                const float sp = __logf(1.f + __expf(-fabsf(z)));
                const float lsi = fminf(z, 0.f) - sp;
                ls[i] = lsi;
                lr[i] = key < t ? lsi - z : 0.f;
            }
            float pw[16];
            float run = carry;
#pragma unroll
            for (int g = 3; g >= 0; --g) {
                const float G = (lr[4 * g] + lr[4 * g + 1]) + (lr[4 * g + 2] + lr[4 * g + 3]);
                const float Gp = __shfl_xor(G, 32);
                const float s3 = run + (h == 0 ? Gp : 0.f);
                const float s2 = s3 + lr[4 * g + 3], s1 = s2 + lr[4 * g + 2], s0 = s1 + lr[4 * g + 1];
                const int keyb = k0 + 8 * g + 4 * h;
                pw[4 * g + 3] = keyb + 3 < t ? __expf(ls[4 * g + 3] + s3) : 0.f;
                pw[4 * g + 2] = keyb + 2 < t ? __expf(ls[4 * g + 2] + s2) : 0.f;
                pw[4 * g + 1] = keyb + 1 < t ? __expf(ls[4 * g + 1] + s1) : 0.f;
                pw[4 * g + 0] = keyb + 0 < t ? __expf(ls[4 * g + 0] + s0) : 0.f;
                run += G + Gp;
            }
            carry = run;
            const bf16x8 pf0 = pack_frag(pw[0], pw[1], pw[2], pw[3], pw[4], pw[5], pw[6], pw[7]);
            const bf16x8 pf1 = pack_frag(pw[8], pw[9], pw[10], pw[11], pw[12], pw[13], pw[14], pw[15]);
            o0 = __builtin_amdgcn_mfma_f32_32x32x16_bf16(vf[0][0], pf0, o0, 0, 0, 0);
            o0 = __builtin_amdgcn_mfma_f32_32x32x16_bf16(vf[0][1], pf1, o0, 0, 0, 0);
            o1 = __builtin_amdgcn_mfma_f32_32x32x16_bf16(vf[1][0], pf0, o1, 0, 0, 0);
            o1 = __builtin_amdgcn_mfma_f32_32x32x16_bf16(vf[1][1], pf1, o1, 0, 0, 0);
#pragma unroll
            for (int ks = 0; ks < 4; ++ks) kf[ks] = kn[ks];
            if (__all((!valid || carry < -110.f) ? 1 : 0)) break;
        }
        float ss = 0.f;
#pragma unroll
        for (int i = 0; i < 16; ++i) ss += o0[i] * o0[i] + o1[i] * o1[i];
        ss += __shfl_xor(ss, 32);
        const float rs = rsqrtf(ss * (1.f / 64.f) + 1e-6f);
        if (valid) {
            const float* g = p.sb_norm + l * 384 + hh * 64 + 4 * h;
            bf16_t* yp = p.y + (size_t)myrow * DM + 640 + hh * 64 + 4 * h;
#pragma unroll
            for (int gq = 0; gq < 4; ++gq) {
                const f32x4 g0 = *(const f32x4*)(g + 8 * gq), g1 = *(const f32x4*)(g + 32 + 8 * gq);
                u32x2 w0, w1;
                w0.x = cvt2(o0[4 * gq] * rs * g0[0], o0[4 * gq + 1] * rs * g0[1]); w0.y = cvt2(o0[4 * gq + 2] * rs * g0[2], o0[4 * gq + 3] * rs * g0[3]);
                w1.x = cvt2(o1[4 * gq] * rs * g1[0], o1[4 * gq + 1] * rs * g1[1]); w1.y = cvt2(o1[4 * gq + 2] * rs * g1[2], o1[4 * gq + 3] * rs * g1[3]);
                *(u32x2*)(yp + 8 * gq) = w0;
                *(u32x2*)(yp + 32 + 8 * gq) = w1;
            }
        }
    }
}

DEV void phase_final(CP& p, int bid, int nblk) {
    const int lane = tid_() & 63, wave = tid_() >> 6;
    for (int r = bid * 8 + wave; r < MMAIN; r += nblk * 8) {
        const float rs = row_rstd(p.part, r);
#pragma unroll
        for (int i = 0; i < 4; ++i) {
            const int c = (i * 64 + lane) * 4;
            const f32x4 v = *(const f32x4*)(p.h + (size_t)r * DM + c), g = *(const f32x4*)(p.final_norm + c);
            *(f32x4*)(p.out + (size_t)r * DM + c) = v * rs * g;
        }
    }
}

enum { PH_INIT = 0, PH_CONVERT, PH_G1A, PH_G2A, PH_G3, PH_CONV, PH_PREP, PH_SCAN, PH_SB, PH_G4, PH_G1B, PH_G2B, PH_FINAL };

DEV void run_phase(CP& p, int ph, int l, int bid, int nblk, float* lds) {
    switch (ph) {
    case PH_INIT: phase_init(p, bid, nblk); break;
    case PH_CONVERT: phase_convert(p, l, bid, nblk, lds); break;
    case PH_G1A: gemm_big(p.hb, p.W13a, MMAIN, 2 * DFF, DM, EpiSwiglu{p.big, p.part}, bid, nblk, (unsigned char*)lds);
        if (bid >= 128) gemm_meta<EPI_SWIGLU>(p, p.hb, p.W13a, 2 * DFF, DM, 0.f, bid - 128, nblk - 128, lds); break;
    case PH_G2A: gemm_big(p.big, p.W2a, MMAIN, DM, DFF, EpiResid{p.h, p.hb, p.part, 0.5f}, bid, nblk, (unsigned char*)lds);
        gemm_meta<EPI_RESID>(p, p.big, p.W2a, DM, DFF, 0.5f, bid, nblk, lds); break;
    case PH_G3: gemm_big(p.hb, p.Win, MMAIN, DIN, DM, EpiP{p.big, p.vt, p.part}, bid, nblk, (unsigned char*)lds);
        gemm_meta<EPI_P>(p, p.hb, p.Win, DIN, DM, 0.f, bid, nblk, lds); break;
    case PH_CONV: phase_conv(p, l, bid, nblk, lds); break;
    case PH_PREP: phase_rwkv_prep(p, l, bid, nblk, lds); break;
    case PH_SCAN: phase_rwkv_scan(p, l, bid, nblk, lds); break;
    case PH_SB: phase_sb_mfma(p, l, bid, nblk); break;
    case PH_G4: gemm_big(p.y, p.Wout, MMAIN, DM, DM, EpiResid{p.h, p.hb, p.part, 1.0f}, bid, nblk, (unsigned char*)lds);
        gemm_meta<EPI_RESID>(p, p.y, p.Wout, DM, DM, 1.0f, bid, nblk, lds); break;
    case PH_G1B: gemm_big(p.hb, p.W13b, MMAIN, 2 * DFF, DM, EpiSwiglu{p.big, p.part}, bid, nblk, (unsigned char*)lds);
        if (bid >= 128) gemm_meta<EPI_SWIGLU>(p, p.hb, p.W13b, 2 * DFF, DM, 0.f, bid - 128, nblk - 128, lds); break;
    case PH_G2B: gemm_big(p.big, p.W2b, MMAIN, DM, DFF, EpiResid{p.h, p.hb, p.part, 0.5f}, bid, nblk, (unsigned char*)lds);
        gemm_meta<EPI_RESID>(p, p.big, p.W2b, DM, DFF, 0.5f, bid, nblk, lds); break;
    case PH_FINAL: phase_final(p, bid, nblk); break;
    }
}

namespace cg = cooperative_groups;
constexpr int LDS_BYTES = 131072;

__global__ void __launch_bounds__(512) k_mega(P p) {
    extern __shared__ __attribute__((aligned(16))) unsigned char smem[];
    float* lds = (float*)smem;
    cg::grid_group grid = cg::this_grid();
    const int bid = blockIdx.x, nblk = gridDim.x;
    phase_init(*kargs(), bid, nblk);
    for (int l = 0; l < 4; ++l) {
        phase_convert(*kargs(), l, bid, nblk, lds);
        grid.sync();
        run_phase(*kargs(), PH_G1A, l, bid, nblk, lds); grid.sync();
        run_phase(*kargs(), PH_G2A, l, bid, nblk, lds); grid.sync();
        run_phase(*kargs(), PH_G3, l, bid, nblk, lds); grid.sync();
        run_phase(*kargs(), PH_CONV, l, bid, nblk, lds);
        run_phase(*kargs(), PH_PREP, l, bid, nblk, lds);
        grid.sync();
        if (bid < 192) phase_rwkv_scan2(*kargs(), l, bid, lds);
        else phase_sb_mfma(*kargs(), l, bid - 192, nblk - 192);
        grid.sync();
        phase_rwkv_post(*kargs(), l, bid, nblk);
        grid.sync();
        run_phase(*kargs(), PH_G4, l, bid, nblk, lds); grid.sync();
        run_phase(*kargs(), PH_G1B, l, bid, nblk, lds); grid.sync();
        run_phase(*kargs(), PH_G2B, l, bid, nblk, lds); grid.sync();
    }
    phase_final(*kargs(), bid, nblk);
}

extern "C" void kernel_launch(void* const* d_in, const int* in_sizes, int n_in, void* d_out, int out_size, void* d_ws, size_t ws_size, hipStream_t stream) {
    static int grid_blocks = 0;
    if (grid_blocks == 0) {
        int dev = 0, cus = 0, per_cu = 0;
        hipGetDevice(&dev);
        hipDeviceGetAttribute(&cus, hipDeviceAttributeMultiprocessorCount, dev);
        if (hipFuncSetAttribute((const void*)k_mega, hipFuncAttributeMaxDynamicSharedMemorySize, LDS_BYTES) != hipSuccess) { fprintf(stderr, "hipFuncSetAttribute failed\n"); grid_blocks = -1; return; }
        if (hipOccupancyMaxActiveBlocksPerMultiprocessor(&per_cu, (const void*)k_mega, 512, LDS_BYTES) != hipSuccess || per_cu < 1) { fprintf(stderr, "occupancy query failed (%d)\n", per_cu); per_cu = 1; }
        (void)hipGetLastError();
        grid_blocks = cus * per_cu;
    }
    if (grid_blocks < 0) return;
    P p{};
    const float** f = (const float**)&p;
    for (int i = 0; i < 28; ++i) f[i] = (const float*)d_in[i];
    p.out = (float*)d_out;
    size_t off = 0;
    auto take = [&](size_t bytes) { void* r = (char*)d_ws + off; off += (bytes + 255) & ~(size_t)255; return r; };
    p.W13a = (bf16_t*)take((size_t)2 * DFF * DM * 2);
    p.W2a = (bf16_t*)take((size_t)DM * DFF * 2);
    p.Win = (bf16_t*)take((size_t)DIN * DM * 2);
    p.Wout = (bf16_t*)take((size_t)DM * DM * 2);
    p.W13b = (bf16_t*)take((size_t)2 * DFF * DM * 2);
    p.W2b = (bf16_t*)take((size_t)DM * DFF * 2);
    p.h = (float*)take((size_t)MP * DM * 4);
    p.hb = (bf16_t*)take((size_t)MP * DM * 2);
    p.big = (bf16_t*)take((size_t)MP * DIN * 2);
    p.y = (bf16_t*)take((size_t)MP * DM * 2);
    p.vt = (bf16_t*)take((size_t)NB * 6 * 64 * LPV * 2);
    p.part = (float*)take((size_t)MP * 16 * 4);
    p.lw = (float*)take((size_t)MP * DRW * 4);
    p.aa = (float*)take((size_t)MP * DRW * 4);
    p.gg = (float*)take((size_t)MP * DRW * 4);
    p.oraw = (float*)take((size_t)MP * DRW * 4);
    p.ct = (float*)take((size_t)MP * 8 * 4);
    if (off > ws_size) { fprintf(stderr, "workspace too small: need %zu have %zu\n", off, ws_size); return; }
    void* args[] = {&p};
    hipError_t e = hipLaunchCooperativeKernel((const void*)k_mega, dim3(grid_blocks), dim3(512), args, LDS_BYTES, stream);
    if (e != hipSuccess) fprintf(stderr, "cooperative launch failed: %s (grid %d)\n", hipGetErrorString(e), grid_blocks);
}
```

```cpp
#include <hip/hip_runtime.h>
#include <hip/hip_cooperative_groups.h>
#include <stdint.h>
#include <stdio.h>

typedef unsigned short bf16_t;
typedef short bf16x8 __attribute__((ext_vector_type(8)));
typedef float f32x4 __attribute__((ext_vector_type(4)));
typedef unsigned u32x4 __attribute__((ext_vector_type(4)));
typedef unsigned u32x2 __attribute__((ext_vector_type(2)));

#define DEV __device__ __forceinline__

constexpr int NB = 8, SEQ = 2048, NMETA = 16, LT = 2064, DM = 1024, DFF = 2816, DIN = 3072;
constexpr int MMAIN = 16384, MTOK = 16512, MP = 16640;
constexpr int DRW = 384, LPV = 2080;
constexpr int C_RW = 512, C_Q = 1920, C_K = 2304, C_V = 2688;

struct P {
    const float *x, *meta, *ffn1_norm, *ffn1_w13, *ffn1_w2, *mix_norm, *w_in, *conv_w, *conv_b, *conv_ln_g, *conv_ln_b,
        *rwkv_mu, *rwkv_w0, *rwkv_wB, *rwkv_a0, *rwkv_aB, *rwkv_gB, *rwkv_kk, *rwkv_ka, *rwkv_rk, *rwkv_ln_g, *rwkv_ln_b,
        *sb_norm, *w_out, *ffn2_norm, *ffn2_w13, *ffn2_w2, *final_norm;
    float* out;
    bf16_t *W13a, *W2a, *Win, *Wout, *W13b, *W2b, *Wl;
    float* h; bf16_t* hb; bf16_t* big; bf16_t* y; bf16_t* vt; float* part;
    float *lw, *aa, *gg, *oraw, *ct;
};

typedef const __attribute__((address_space(4))) P CP;
DEV CP* kargs() { CP* k = (CP*)__builtin_amdgcn_kernarg_segment_ptr(); asm volatile("" : "+s"(k)); return k; }
DEV int tid_() { int t = threadIdx.x; asm volatile("" : "+v"(t)); return t; }
DEV float bf2f(bf16_t v) { return __uint_as_float(((unsigned)v) << 16); }
DEV bf16_t f2bf(float f) { unsigned u = __float_as_uint(f); u += 0x7FFFu + ((u >> 16) & 1u); return (bf16_t)(u >> 16); }
DEV unsigned pack2(float a, float b) { return (unsigned)f2bf(a) | ((unsigned)f2bf(b) << 16); }
DEV float wave_sum(float v) {
#pragma unroll
    for (int o = 32; o; o >>= 1) v += __shfl_xor(v, o);
    return v;
}
DEV float dpp_sum16(float x) {
    x += __builtin_bit_cast(float, __builtin_amdgcn_update_dpp(0, __builtin_bit_cast(int, x), 0xB1, 0xF, 0xF, false));
    x += __builtin_bit_cast(float, __builtin_amdgcn_update_dpp(0, __builtin_bit_cast(int, x), 0x4E, 0xF, 0xF, false));
    x += __builtin_bit_cast(float, __builtin_amdgcn_update_dpp(0, __builtin_bit_cast(int, x), 0x141, 0xF, 0xF, false));
    x += __builtin_bit_cast(float, __builtin_amdgcn_update_dpp(0, __builtin_bit_cast(int, x), 0x140, 0xF, 0xF, false));
    return x;
}
DEV float wave_sum_fast(float x) {
    x = dpp_sum16(x);
    const int xi = __builtin_bit_cast(int, x);
    return (__builtin_bit_cast(float, __builtin_amdgcn_readlane(xi, 0)) + __builtin_bit_cast(float, __builtin_amdgcn_readlane(xi, 16))) +
           (__builtin_bit_cast(float, __builtin_amdgcn_readlane(xi, 32)) + __builtin_bit_cast(float, __builtin_amdgcn_readlane(xi, 48)));
}
typedef float f32x16 __attribute__((ext_vector_type(16)));
typedef __bf16 bfv2 __attribute__((ext_vector_type(2)));
typedef float f32x2v __attribute__((ext_vector_type(2)));
typedef short s16x4 __attribute__((ext_vector_type(4)));
DEV unsigned cvt2(float a, float b) { return __builtin_bit_cast(unsigned, __builtin_convertvector((f32x2v){a, b}, bfv2)); }
DEV bf16x8 pack_frag(float a0, float a1, float a2, float a3, float a4, float a5, float a6, float a7) {
    u32x4 w; w.x = cvt2(a0, a1); w.y = cvt2(a2, a3); w.z = cvt2(a4, a5); w.w = cvt2(a6, a7);
    return __builtin_bit_cast(bf16x8, w);
}
DEV float sigm(float x) { return 1.f / (1.f + expf(-x)); }
DEV int row_of(int b, int pos) { return pos < NMETA ? MMAIN + b * NMETA + pos : b * SEQ + pos - NMETA; }
DEV float row_rstd(const float* part, int row) {
    const f32x4* pp = (const f32x4*)(part + (size_t)row * 16);
    f32x4 a = pp[0], b = pp[1], c = pp[2], d = pp[3];
    float ss = ((a[0] + a[1]) + (a[2] + a[3])) + ((b[0] + b[1]) + (b[2] + b[3])) + ((c[0] + c[1]) + (c[2] + c[3])) + ((d[0] + d[1]) + (d[2] + d[3]));
    return rsqrtf(ss * (1.0f / 1024.0f) + 1e-6f);
}

DEV void phase_init(CP& p, int bid, int nblk) {
    const int lane = tid_() & 63, wave = tid_() >> 6;
    for (int r = bid * 8 + wave; r < MP; r += nblk * 8) {
        const float* src = nullptr;
        if (r < MMAIN) src = p.x + (size_t)r * DM;
        else if (r < MTOK) src = p.meta + (size_t)((r - MMAIN) & 15) * DM;
        float ss = 0.f;
#pragma unroll
        for (int i = 0; i < 4; ++i) {
            const int c = (i * 64 + lane) * 4;
            f32x4 v = src ? *(const f32x4*)(src + c) : (f32x4){0.f, 0.f, 0.f, 0.f};
            *(f32x4*)(p.h + (size_t)r * DM + c) = v;
            u32x2 w; w.x = pack2(v[0], v[1]); w.y = pack2(v[2], v[3]);
            *(u32x2*)(p.hb + (size_t)r * DM + c) = w;
            ss += v[0] * v[0] + v[1] * v[1] + v[2] * v[2] + v[3] * v[3];
        }
        ss = wave_sum(ss);
        if (lane < 16) p.part[(size_t)r * 16 + lane] = lane == 0 ? ss : 0.f;
    }
    for (int i = bid * 512 + tid_(); i < NB * 6 * 64 * (LPV - LT); i += nblk * 512) p.vt[(size_t)(i >> 4) * LPV + LT + (i & 15)] = 0;
}

struct ConvDesc { const float* W; const float* g; bf16_t* dst; int K, N, swz, kt, nt; };
DEV ConvDesc conv_desc(CP& p, int l, int grp, int idx) {
    ConvDesc d;
    int t = idx;
    if (grp == 0) {
        if (t < 1408) { d.W = p.ffn1_w13 + (size_t)l * DM * 2 * DFF; d.g = p.ffn1_norm + l * DM; d.dst = p.W13a; d.K = DM; d.N = 2 * DFF; d.swz = 1; d.kt = t / 88; d.nt = t % 88; return d; }
        t -= 1408;
        if (t < 704) { d.W = p.ffn1_w2 + (size_t)l * DFF * DM; d.g = nullptr; d.dst = p.W2a; d.K = DFF; d.N = DM; d.swz = 0; d.kt = t / 16; d.nt = t % 16; return d; }
        t -= 704;
        if (t < 768) { d.W = p.w_in + (size_t)l * DM * DIN; d.g = p.mix_norm + l * DM; d.dst = p.Win; d.K = DM; d.N = DIN; d.swz = 0; d.kt = t / 48; d.nt = t % 48; return d; }
        t -= 768;
        d.g = nullptr; d.N = DRW; d.swz = 0;
        if (t < 6) { d.W = p.rwkv_wB + (size_t)l * 64 * DRW; d.dst = p.Wl; d.K = 64; d.kt = 0; d.nt = t; return d; }
        if (t < 12) { d.W = p.rwkv_aB + (size_t)l * 64 * DRW; d.dst = p.Wl + DRW * 64; d.K = 64; d.kt = 0; d.nt = t - 6; return d; }
        d.W = p.rwkv_gB + (size_t)l * 128 * DRW; d.dst = p.Wl + DRW * 128; d.K = 128; d.kt = (t - 12) / 6; d.nt = (t - 12) % 6; return d;
    }
    if (t < 256) { d.W = p.w_out + (size_t)l * DM * DM; d.g = nullptr; d.dst = p.Wout; d.K = DM; d.N = DM; d.swz = 0; d.kt = t / 16; d.nt = t % 16; return d; }
    t -= 256;
    if (t < 1408) { d.W = p.ffn2_w13 + (size_t)l * DM * 2 * DFF; d.g = p.ffn2_norm + l * DM; d.dst = p.W13b; d.K = DM; d.N = 2 * DFF; d.swz = 1; d.kt = t / 88; d.nt = t % 88; return d; }
    t -= 1408;
    d.W = p.ffn2_w2 + (size_t)l * DFF * DM; d.g = nullptr; d.dst = p.W2b; d.K = DFF; d.N = DM; d.swz = 0; d.kt = t / 16; d.nt = t % 16; return d;
}
constexpr int CONV_A = 2904, CONV_B = 2368;
DEV void conv_load(const ConvDesc& d, int tid, f32x4 (&v)[2]) {
#pragma unroll
    for (int i = 0; i < 2; ++i) {
        const int idx = tid + i * 512, kk = idx >> 4, n4 = (idx & 15) * 4;
        v[i] = *(const f32x4*)(d.W + (size_t)(d.kt * 64 + kk) * d.N + d.nt * 64 + n4);
        if (d.g) v[i] *= d.g[d.kt * 64 + kk];
    }
}
DEV void phase_convert(CP& p, int l, int grp, int bid, int nblk, float* tile) {
    const int tid = tid_(), total = grp == 0 ? CONV_A : CONV_B;
    if (bid >= total) return;
    f32x4 v[2];
    ConvDesc d = conv_desc(p, l, grp, bid);
    conv_load(d, tid, v);
    for (int it = bid; it < total; it += nblk) {
#pragma unroll
        for (int i = 0; i < 2; ++i) {
            const int idx = tid + i * 512, kk = idx >> 4, n4 = (idx & 15) * 4;
#pragma unroll
            for (int j = 0; j < 4; ++j) tile[kk * 65 + n4 + j] = v[i][j];
        }
        __syncthreads();
        const ConvDesc dc = d;
        if (it + nblk < total) { d = conv_desc(p, l, grp, it + nblk); conv_load(d, tid, v); }
        {
            const int nn = tid >> 3, kc = (tid & 7) * 8;
            const int sc = dc.nt * 64 + nn;
            int nd = sc;
            if (dc.swz) { const int bj = sc >= DFF ? 1 : 0; const int j = sc - bj * DFF; nd = (j >> 7) * 256 + bj * 128 + (j & 127); }
            u32x4 w;
            w.x = cvt2(tile[(kc + 0) * 65 + nn], tile[(kc + 1) * 65 + nn]); w.y = cvt2(tile[(kc + 2) * 65 + nn], tile[(kc + 3) * 65 + nn]);
            w.z = cvt2(tile[(kc + 4) * 65 + nn], tile[(kc + 5) * 65 + nn]); w.w = cvt2(tile[(kc + 6) * 65 + nn], tile[(kc + 7) * 65 + nn]);
            *(u32x4*)(dc.dst + (size_t)nd * dc.K + dc.kt * 64 + kc) = w;
        }
        __syncthreads();
    }
}

enum { EPI_SWIGLU = 0, EPI_RESID = 1, EPI_P = 2 };

DEV void epi_swiglu(CP& p, int row, int colh, f32x4 g, f32x4 u, float rs) {
    float o[4];
#pragma unroll
    for (int e = 0; e < 4; ++e) { const float gg = g[e] * rs, uu = u[e] * rs; o[e] = gg * sigm(gg) * uu; }
    u32x2 w; w.x = pack2(o[0], o[1]); w.y = pack2(o[2], o[3]);
    *(u32x2*)(p.big + (size_t)row * DFF + colh) = w;
}
DEV float epi_resid(CP& p, int row, int col, f32x4 a, float scale) {
    float* hp = p.h + (size_t)row * DM + col;
    f32x4 hv = *(const f32x4*)hp;
    hv += a * scale;
    *(f32x4*)hp = hv;
    u32x2 w; w.x = pack2(hv[0], hv[1]); w.y = pack2(hv[2], hv[3]);
    *(u32x2*)(p.hb + (size_t)row * DM + col) = w;
    return hv[0] * hv[0] + hv[1] * hv[1] + hv[2] * hv[2] + hv[3] * hv[3];
}
DEV void epi_p(CP& p, int row, int col, f32x4 a, float rs) {
    a *= rs;
    u32x2 w; w.x = pack2(a[0], a[1]); w.y = pack2(a[2], a[3]);
    *(u32x2*)(p.big + (size_t)row * DIN + col) = w;
    if (col >= C_V && row < MTOK) {
        const int hh = (col - C_V) >> 6, d = (col - C_V) & 63;
        int b, pos;
        if (row < MMAIN) { b = row >> 11; pos = (row & 2047) + NMETA; } else { b = (row - MMAIN) >> 4; pos = (row - MMAIN) & 15; }
        bf16_t* vp = p.vt + ((size_t)((b * 6 + hh) * 64 + d)) * LPV + pos;
#pragma unroll
        for (int e = 0; e < 4; ++e) vp[(size_t)e * LPV] = f2bf(a[e]);
    }
}

template <int EPI>
DEV void gemm_v0(CP& p, const bf16_t* __restrict__ A, const bf16_t* __restrict__ Bt, int row_begin, int row_end, int N, int K, float scale, int bid, int nblk) {
    const int lane = tid_() & 63, wave = tid_() >> 6, fr = lane & 15, fq = lane >> 4;
    const int nt = N / 64, total = ((row_end - row_begin) / 32) * nt;
    for (int u = bid * 8 + wave; u < total; u += nblk * 8) {
        const int mu = u / nt, nu = u % nt, row0 = row_begin + mu * 32;
        const int cb = (EPI == EPI_SWIGLU) ? ((nu >> 2) * 256 + (nu & 3) * 32) : nu * 64;
        f32x4 acc[2][4];
#pragma unroll
        for (int i = 0; i < 2; ++i)
#pragma unroll
            for (int j = 0; j < 4; ++j) acc[i][j] = (f32x4){0.f, 0.f, 0.f, 0.f};
        const bf16_t* ap = A + (size_t)(row0 + fr) * K + fq * 8;
        const bf16_t* bp = Bt + (size_t)(cb + fr) * K + fq * 8;
#pragma unroll 2
        for (int k0 = 0; k0 < K; k0 += 32) {
            const bf16x8 a0 = *(const bf16x8*)(ap + k0), a1 = *(const bf16x8*)(ap + (size_t)16 * K + k0);
#pragma unroll
            for (int j = 0; j < 4; ++j) {
                const int co = (EPI == EPI_SWIGLU) ? ((j & 1) * 16 + (j >> 1) * 128) : j * 16;
                const bf16x8 b = *(const bf16x8*)(bp + (size_t)co * K + k0);
                acc[0][j] = __builtin_amdgcn_mfma_f32_16x16x32_bf16(b, a0, acc[0][j], 0, 0, 0);
                acc[1][j] = __builtin_amdgcn_mfma_f32_16x16x32_bf16(b, a1, acc[1][j], 0, 0, 0);
            }
        }
#pragma unroll
        for (int i = 0; i < 2; ++i) {
            const int row = row0 + 16 * i + fr;
            if (EPI == EPI_SWIGLU) {
                const float rs = row_rstd(p.part, row);
                const int colh = (nu >> 2) * 128 + (nu & 3) * 32 + 4 * fq;
                epi_swiglu(p, row, colh, acc[i][0], acc[i][2], rs);
                epi_swiglu(p, row, colh + 16, acc[i][1], acc[i][3], rs);
            } else if (EPI == EPI_RESID) {
                float ss = 0.f;
#pragma unroll
                for (int j = 0; j < 4; ++j) ss += epi_resid(p, row, cb + 16 * j + 4 * fq, acc[i][j], scale);
                ss += __shfl_xor(ss, 16); ss += __shfl_xor(ss, 32);
                if (fq == 0) p.part[(size_t)row * 16 + nu] = ss;
            } else {
                const float rs = row_rstd(p.part, row);
#pragma unroll
                for (int j = 0; j < 4; ++j) epi_p(p, row, cb + 16 * j + 4 * fq, acc[i][j], rs);
            }
        }
    }
}

template <int EPI>
DEV void gemm_meta(CP& p, const bf16_t* __restrict__ A, const bf16_t* __restrict__ Bt, int N, int K, float scale, int bid, int nblk, float* lds) {
    const int tid = tid_(), lane = tid & 63, wave = tid >> 6, fr = lane & 15, fq = lane >> 4;
    const int nt = N / 64, total = 4 * nt, kw = K / 8;
    float* red = lds + 8 * 8 * 64 * 4;
    for (int u = bid; u < total; u += nblk) {
        const int mu = u / nt, nu = u % nt, row0 = MMAIN + mu * 32;
        const int cb = (EPI == EPI_SWIGLU) ? ((nu >> 2) * 256 + (nu & 3) * 32) : nu * 64;
        f32x4 acc[2][4];
#pragma unroll
        for (int i = 0; i < 2; ++i)
#pragma unroll
            for (int j = 0; j < 4; ++j) acc[i][j] = (f32x4){0.f, 0.f, 0.f, 0.f};
        const bf16_t* ap = A + (size_t)(row0 + fr) * K + wave * kw + fq * 8;
        const bf16_t* bp = Bt + (size_t)(cb + fr) * K + wave * kw + fq * 8;
        for (int k0 = 0; k0 < kw; k0 += 32) {
            const bf16x8 a0 = *(const bf16x8*)(ap + k0), a1 = *(const bf16x8*)(ap + (size_t)16 * K + k0);
#pragma unroll
            for (int j = 0; j < 4; ++j) {
                const int co = (EPI == EPI_SWIGLU) ? ((j & 1) * 16 + (j >> 1) * 128) : j * 16;
                const bf16x8 bv = *(const bf16x8*)(bp + (size_t)co * K + k0);
                acc[0][j] = __builtin_amdgcn_mfma_f32_16x16x32_bf16(bv, a0, acc[0][j], 0, 0, 0);
                acc[1][j] = __builtin_amdgcn_mfma_f32_16x16x32_bf16(bv, a1, acc[1][j], 0, 0, 0);
            }
        }
#pragma unroll
        for (int i = 0; i < 2; ++i)
#pragma unroll
            for (int j = 0; j < 4; ++j) *(f32x4*)(lds + ((wave * 8 + i * 4 + j) * 64 + lane) * 4) = acc[i][j];
        __syncthreads();
        {
            f32x4 sum = (f32x4){0.f, 0.f, 0.f, 0.f};
#pragma unroll
            for (int w = 0; w < 8; ++w) sum += *(const f32x4*)(lds + ((w * 8 + wave) * 64 + lane) * 4);
            *(f32x4*)(red + (wave * 64 + lane) * 4) = sum;
        }
        __syncthreads();
        if (wave < 2) {
            const int i = wave, row = row0 + 16 * i + fr;
            f32x4 a[4];
#pragma unroll
            for (int j = 0; j < 4; ++j) a[j] = *(const f32x4*)(red + ((i * 4 + j) * 64 + lane) * 4);
            if (EPI == EPI_SWIGLU) {
                const float rs = row_rstd(p.part, row);
                const int colh = (nu >> 2) * 128 + (nu & 3) * 32 + 4 * fq;
                epi_swiglu(p, row, colh, a[0], a[2], rs);
                epi_swiglu(p, row, colh + 16, a[1], a[3], rs);
            } else if (EPI == EPI_RESID) {
                float ss = 0.f;
#pragma unroll
                for (int j = 0; j < 4; ++j) ss += epi_resid(p, row, cb + 16 * j + 4 * fq, a[j], scale);
                ss += __shfl_xor(ss, 16); ss += __shfl_xor(ss, 32);
                if (fq == 0) p.part[(size_t)row * 16 + nu] = ss;
            } else {
                const float rs = row_rstd(p.part, row);
#pragma unroll
                for (int j = 0; j < 4; ++j) epi_p(p, row, cb + 16 * j + 4 * fq, a[j], rs);
            }
        }
        __syncthreads();
    }
}

namespace pg8 {
#define PG8_LAS __attribute__((address_space(3)))
typedef unsigned short bf16_t;
typedef short bf16x8 __attribute__((ext_vector_type(8)));
typedef float f32x4 __attribute__((ext_vector_type(4)));
typedef unsigned u32x4 __attribute__((ext_vector_type(4)));
constexpr int BM = 256, BK = 64, HALF = 128, HTB = HALF * BK * 2  , STAGE_BYTES = 8 * HTB, NXCD = 8, WGM = 8;

__host__ __device__ __forceinline__ int lds_byte(int r, int c) { const int st = (r >> 4) * 2 + (c >> 5), rr = r & 15, cc = c & 31, ob = rr * 64 + cc * 2; return st * 1024 + (ob ^ (((ob >> 9) & 1) << 5)); }
__host__ __device__ __forceinline__ void stage_rc(int b, int& R, int& C) { const int st = b / 1024, sb = b % 1024, swz = sb ^ (((sb >> 9) & 1) << 5); R = (st >> 1) * 16 + swz / 64; C = (st & 1) * 32 + (swz % 64) / 2; }
__host__ __device__ __forceinline__ int perm32(int rho) { const int n = rho >> 4, i = rho & 15; return 8 * (i >> 2) + 4 * n + (i & 3); }

struct Unit { int pm, pn; };
struct Gemm { const bf16_t* A; const bf16_t* Bt; int M, N, K; };

struct StaticOrder {
    int nM, nN, nwg, G, c;
    __host__ __device__ void init(int M, int N, int G_, int c_) { nM = M / BM; nN = N / BM; nwg = nM * nN; G = G_; c = c_; }
    __host__ __device__ bool next(int i, Unit& u) const {
        const long L = (long)i * G + c; if (L >= nwg) return false;
        int wgid = (int)L; { const int q = nwg / NXCD, r = nwg % NXCD, xcd = wgid % NXCD, off = wgid / NXCD; wgid = (xcd < r ? xcd * (q + 1) : r * (q + 1) + (xcd - r) * q) + off; }
        const int nig = WGM * nN, gid = wgid / nig, fm = gid * WGM, gsz = (nM - fm) < WGM ? (nM - fm) : WGM;
        u.pm = fm + ((wgid % nig) % gsz); u.pn = (wgid % nig) / gsz; return true;
    }
    __device__ __forceinline__ void a_ready(const Unit&) const {}
    __device__ __forceinline__ void done(const Unit&) const {}
};
__device__ __forceinline__ unsigned cvt_pk_bf16(float lo, float hi) { unsigned r; asm volatile("v_cvt_pk_bf16_f32 %0, %1, %2" : "=v"(r) : "v"(lo), "v"(hi)); return r; }
template <class Epi, class Sched, bool STAMP = false>
__device__ __forceinline__ void gemm_phase(PG8_LAS unsigned char* lds, const Gemm g, const Sched& S, const Epi& E, unsigned long long* stamps) {
    const int tid = tid_(), wid = __builtin_amdgcn_readfirstlane(tid >> 6), lane = tid & 63, wr = wid >> 2, wc = wid & 3, fr = lane & 15, fq = lane >> 4;
    const int K = g.K, nt = K / BK;
    int ts_lo = 0, ts_hi = 0, nts = 0; const unsigned long long rt_entry = STAMP ? (unsigned long long)wall_clock64() : 0ull;
#define PG8_STAMP() do { if (STAMP && wid == 0 && nts < 64) { const unsigned long long _c = (unsigned long long)clock64(); \
        ts_lo = (lane == nts) ? (int)(unsigned)_c : ts_lo; ts_hi = (lane == nts) ? (int)(unsigned)(_c >> 32) : ts_hi; ++nts; } } while (0)
    PG8_STAMP();
    unsigned voffA[2], voffB[2];
#pragma unroll
    for (int i = 0; i < 2; ++i) { int R, C; stage_rc(tid * 16 + i * 8192, R, C); const int Rb = Epi::PERM ? ((R & ~31) + perm32(R & 31)) : R;
        voffA[i] = (unsigned)(R * K + C) * 2u; voffB[i] = (unsigned)(Rb * K + C) * 2u; }
    const size_t kstep = (size_t)(BK * 2);
    const size_t hstep = (size_t)HALF * K * 2;
    const size_t tstep = 2 * hstep;
    const unsigned ldsw = (unsigned)wid * 1024u;
    const int aoff = lds_byte(wr * 64 + fr, fq * 8), boff = lds_byte(wc * 32 + fr, fq * 8);
#define PG8_SA(b, h) (((b) * 2 + (h)) * HTB)
#define PG8_SB(b, h) ((4 + (b) * 2 + (h)) * HTB)
#define PG8_STAGE(bufoff, gbase, voff) do { _Pragma("unroll") for (int _i = 0; _i < 2; ++_i) \
        __builtin_amdgcn_global_load_lds((const unsigned*)((const char*)(gbase) + (voff)[_i]), (PG8_LAS unsigned*)(lds + (bufoff) + ldsw + _i * 8192), 16, 0, 0); } while (0)
#define PG8_LDA(dst, b, h) do { _Pragma("unroll") for (int m = 0; m < 4; ++m) _Pragma("unroll") for (int k = 0; k < 2; ++k) dst[m][k] = *(const PG8_LAS bf16x8*)(lds + PG8_SA(b, h) + aoff + m * 2048 + k * 1024); } while (0)
#define PG8_LDB(dst, b, h) do { _Pragma("unroll") for (int n = 0; n < 2; ++n) _Pragma("unroll") for (int k = 0; k < 2; ++k) dst[n][k] = *(const PG8_LAS bf16x8*)(lds + PG8_SB(b, h) + boff + n * 2048 + k * 1024); } while (0)
#define PG8_MMA(ai, bj, At, Bt) do { __builtin_amdgcn_s_setprio(1); _Pragma("unroll") for (int m = 0; m < 4; ++m) _Pragma("unroll") for (int n = 0; n < 2; ++n) _Pragma("unroll") for (int k = 0; k < 2; ++k) \
        acc[ai][bj][m][n] = __builtin_amdgcn_mfma_f32_16x16x32_bf16(Bt[n][k], At[m][k], acc[ai][bj][m][n], 0, 0, 0); __builtin_amdgcn_s_setprio(0); } while (0)
#define PG8_WAIT_V(n) asm volatile("s_waitcnt vmcnt(" #n ")" ::: "memory")
#define PG8_WAIT_L(n) asm volatile("s_waitcnt lgkmcnt(" #n ")" ::: "memory")
#define PG8_BAR __builtin_amdgcn_s_barrier()
#define PG8_SCHED __builtin_amdgcn_sched_barrier(0)
    Unit cur, nxt; int ui = 0;
    if (!S.next(0, cur)) return;
    f32x4 acc[2][2][4][2];
#pragma unroll
    for (int a = 0; a < 2; ++a)
#pragma unroll
        for (int b = 0; b < 2; ++b)
#pragma unroll
            for (int m = 0; m < 4; ++m)
#pragma unroll
                for (int n = 0; n < 2; ++n) acc[a][b][m][n] = (f32x4){0.f, 0.f, 0.f, 0.f};
    bf16x8 At[4][2], B0[2][2], B1[2][2];
    const char* cA = (const char*)g.A + (size_t)cur.pm * tstep; const char* cB = (const char*)g.Bt + (size_t)cur.pn * tstep;
    S.a_ready(cur);
    PG8_STAGE(PG8_SB(0, 0), cB, voffB); PG8_STAGE(PG8_SA(0, 0), cA, voffA); PG8_STAGE(PG8_SB(0, 1), cB + hstep, voffB); PG8_STAGE(PG8_SA(0, 1), cA + hstep, voffA);
    if (wr == 1) PG8_BAR;
    PG8_WAIT_V(4); PG8_BAR;
    PG8_STAGE(PG8_SB(1, 0), cB + kstep, voffB); PG8_STAGE(PG8_SA(1, 0), cA + kstep, voffA); PG8_STAGE(PG8_SB(1, 1), cB + hstep + kstep, voffB);
    PG8_WAIT_V(6); PG8_BAR;
    PG8_STAMP();
    for (;;) {
        const bool has_next = S.next(ui + 1, nxt);
        const char* nA = has_next ? (const char*)g.A + (size_t)nxt.pm * tstep : cA; const char* nB = has_next ? (const char*)g.Bt + (size_t)nxt.pn * tstep : cB;
        for (int t = 0; t < nt; t += 2) {
            const bool last = (t == nt - 2);
            const char* a1 = cA + (size_t)(t + 1) * kstep;
            const char* a2 = last ? nA : cA + (size_t)(t + 2) * kstep; const char* b2 = last ? nB : cB + (size_t)(t + 2) * kstep;
            const char* a3 = a2 + kstep; const char* b3 = b2 + kstep;
            if (last && has_next) S.a_ready(nxt);
            PG8_LDB(B0, 0, 0); PG8_SCHED; PG8_LDA(At, 0, 0); PG8_STAGE(PG8_SA(1, 1), a1 + hstep, voffA);
            PG8_WAIT_L(8); PG8_BAR; PG8_WAIT_L(0); PG8_MMA(0, 0, At, B0); PG8_BAR; PG8_SCHED;
            PG8_LDB(B1, 0, 1); PG8_STAGE(PG8_SB(0, 0), b2, voffB);
            PG8_BAR; PG8_WAIT_L(0); PG8_MMA(0, 1, At, B1); PG8_BAR;
            PG8_LDA(At, 0, 1); PG8_STAGE(PG8_SA(0, 0), a2, voffA);
            PG8_BAR; PG8_WAIT_L(0); PG8_MMA(1, 0, At, B0); PG8_BAR; PG8_SCHED;
            PG8_STAGE(PG8_SB(0, 1), b2 + hstep, voffB);
            PG8_WAIT_V(6); PG8_BAR; PG8_MMA(1, 1, At, B1); PG8_BAR;
            PG8_LDB(B0, 1, 0); PG8_SCHED; PG8_LDA(At, 1, 0); PG8_STAGE(PG8_SA(0, 1), a2 + hstep, voffA);
            PG8_WAIT_L(8); PG8_BAR; PG8_WAIT_L(0); PG8_MMA(0, 0, At, B0); PG8_BAR; PG8_SCHED;
            PG8_LDB(B1, 1, 1); PG8_STAGE(PG8_SB(1, 0), b3, voffB);
            PG8_BAR; PG8_WAIT_L(0); PG8_MMA(0, 1, At, B1); PG8_BAR;
            PG8_LDA(At, 1, 1); PG8_STAGE(PG8_SA(1, 0), a3, voffA);
            PG8_BAR; PG8_WAIT_L(0); PG8_MMA(1, 0, At, B0); PG8_BAR; PG8_SCHED;
            PG8_STAGE(PG8_SB(1, 1), b3 + hstep, voffB);
            PG8_WAIT_V(6); PG8_BAR; PG8_MMA(1, 1, At, B1); PG8_BAR;
        }
        PG8_STAMP();
        if constexpr (!Epi::AFTER_DRAIN) { E(acc, cur, wr, wc, fr, fq); S.done(cur); }
        PG8_STAMP();
        if (!has_next) break;
#pragma unroll
        for (int a = 0; a < 2; ++a)
#pragma unroll
            for (int b = 0; b < 2; ++b)
#pragma unroll
                for (int m = 0; m < 4; ++m)
#pragma unroll
                    for (int n = 0; n < 2; ++n) acc[a][b][m][n] = (f32x4){0.f, 0.f, 0.f, 0.f};
        cur = nxt; cA = nA; cB = nB; ++ui;
    }
    PG8_WAIT_V(0);
    if (wr == 0) PG8_BAR;
    PG8_BAR;
    if constexpr (Epi::AFTER_DRAIN) { E.fused(acc, cur, wr, wc, fr, fq, lds, wid, lane); S.done(cur); }
    PG8_STAMP();
    if (STAMP && wid == 0) { stamps[lane] = lane < nts ? (((unsigned long long)(unsigned)ts_hi << 32) | (unsigned)ts_lo) : 0ull;
        if (lane == 62) stamps[62] = rt_entry; if (lane == 63) stamps[63] = (unsigned long long)wall_clock64(); }
#undef PG8_STAMP
#undef PG8_SA
#undef PG8_SB
#undef PG8_STAGE
#undef PG8_LDA
#undef PG8_LDB
#undef PG8_MMA
#undef PG8_WAIT_V
#undef PG8_WAIT_L
#undef PG8_BAR
#undef PG8_SCHED
}
}

DEV float fsig(float x) { return __builtin_amdgcn_rcpf(1.f + __expf(-x)); }
DEV u32x4 pack8(f32x4 a, f32x4 b) { u32x4 w; w.x = pg8::cvt_pk_bf16(a[0], a[1]); w.y = pg8::cvt_pk_bf16(a[2], a[3]); w.z = pg8::cvt_pk_bf16(b[0], b[1]); w.w = pg8::cvt_pk_bf16(b[2], b[3]); return w; }

DEV float row_rstd_q(const float* part, int row, int fq) {
    const f32x4 a = *(const f32x4*)(part + (size_t)row * 16 + fq * 4);
    float ss = (a[0] + a[1]) + (a[2] + a[3]);
    ss += __shfl_xor(ss, 16); ss += __shfl_xor(ss, 32);
    return rsqrtf(ss * (1.0f / 1024.0f) + 1e-6f);
}
struct EpiSwiglu {
    static constexpr bool PERM = true, AFTER_DRAIN = false;
    bf16_t* hid; const float* part;
    __device__ __forceinline__ void operator()(const f32x4 (&acc)[2][2][4][2], const pg8::Unit& u, int wr, int wc, int fr, int fq) const {
#pragma unroll
        for (int ai = 0; ai < 2; ++ai)
#pragma unroll
            for (int m = 0; m < 4; ++m) {
                __builtin_amdgcn_sched_barrier(0);
                const int row = u.pm * 256 + ai * 128 + wr * 64 + m * 16 + fr;
                const float rs = row_rstd_q(part, row, fq);
                f32x4 o[2];
#pragma unroll
                for (int n = 0; n < 2; ++n)
#pragma unroll
                    for (int e = 0; e < 4; ++e) { const float g = acc[ai][0][m][n][e] * rs, up = acc[ai][1][m][n][e] * rs; o[n][e] = g * fsig(g) * up; }
                *(u32x4*)(hid + (size_t)row * DFF + u.pn * 128 + wc * 32 + fq * 8) = pack8(o[0], o[1]);
            }
    }
};
struct EpiResid {
    static constexpr bool PERM = true, AFTER_DRAIN = false;
    float* h; bf16_t* hb; float* part; float scale;
    __device__ __forceinline__ void operator()(const f32x4 (&acc)[2][2][4][2], const pg8::Unit& u, int wr, int wc, int fr, int fq) const {
#pragma unroll
        for (int ai = 0; ai < 2; ++ai)
#pragma unroll
            for (int m = 0; m < 4; ++m) {
                __builtin_amdgcn_sched_barrier(0);
                const int row = u.pm * 256 + ai * 128 + wr * 64 + m * 16 + fr;
                float ss = 0.f;
#pragma unroll
                for (int bj = 0; bj < 2; ++bj) {
                    const int col = u.pn * 256 + bj * 128 + wc * 32 + fq * 8;
                    float* hp = h + (size_t)row * DM + col;
                    f32x4 h0 = *(const f32x4*)hp, h1 = *(const f32x4*)(hp + 4);
                    h0 += acc[ai][bj][m][0] * scale; h1 += acc[ai][bj][m][1] * scale;
                    *(f32x4*)hp = h0; *(f32x4*)(hp + 4) = h1;
                    *(u32x4*)(hb + (size_t)row * DM + col) = pack8(h0, h1);
                    ss += (h0[0] * h0[0] + h0[1] * h0[1]) + (h0[2] * h0[2] + h0[3] * h0[3]) + (h1[0] * h1[0] + h1[1] * h1[1]) + (h1[2] * h1[2] + h1[3] * h1[3]);
                }
                ss += __shfl_xor(ss, 16); ss += __shfl_xor(ss, 32);
                if (fq == 0) part[(size_t)row * 16 + u.pn * 4 + wc] = ss;
            }
    }
};
struct EpiP {
    static constexpr bool PERM = true, AFTER_DRAIN = false;
    bf16_t* big; bf16_t* vt; const float* part;
    __device__ __forceinline__ void operator()(const f32x4 (&acc)[2][2][4][2], const pg8::Unit& u, int wr, int wc, int fr, int fq) const {
#pragma unroll
        for (int ai = 0; ai < 2; ++ai)
#pragma unroll
            for (int m = 0; m < 4; ++m) {
                __builtin_amdgcn_sched_barrier(0);
                const int row = u.pm * 256 + ai * 128 + wr * 64 + m * 16 + fr;
                const float rs = row_rstd_q(part, row, fq);
#pragma unroll
                for (int bj = 0; bj < 2; ++bj) {
                    const int col = u.pn * 256 + bj * 128 + wc * 32 + fq * 8;
                    const f32x4 a0 = acc[ai][bj][m][0] * rs, a1 = acc[ai][bj][m][1] * rs;
                    const u32x4 w = pack8(a0, a1);
                    *(u32x4*)(big + (size_t)row * DIN + col) = w;
                    if (col >= C_V && row < MTOK) {
                        const int hh = (col - C_V) >> 6, d = (col - C_V) & 63;
                        int b, pos;
                        if (row < MMAIN) { b = row >> 11; pos = (row & 2047) + NMETA; } else { b = (row - MMAIN) >> 4; pos = (row - MMAIN) & 15; }
                        bf16_t* vp = vt + ((size_t)((b * 6 + hh) * 64 + d)) * LPV + pos;
#pragma unroll
                        for (int e = 0; e < 4; ++e) { vp[(size_t)(2 * e) * LPV] = (bf16_t)(w[e] & 0xFFFFu); vp[(size_t)(2 * e + 1) * LPV] = (bf16_t)(w[e] >> 16); }
                    }
                }
            }
    }
};
template <class Epi>
DEV void gemm_big(const bf16_t* A, const bf16_t* Bt, int M, int N, int K, const Epi& E, int bid, int nblk, unsigned char* smem) {
    pg8::StaticOrder S; S.init(M, N, nblk, bid);
    const pg8::Gemm g{A, Bt, M, N, K};
    pg8::gemm_phase<Epi, pg8::StaticOrder, false>((PG8_LAS unsigned char*)smem, g, S, E, nullptr);
}

DEV void phase_conv(CP& p, int l, int bid, int nblk, float* lds) {
    float* cS = lds;
    float* yS = lds + 46 * 256;
    const int tid = tid_(), ch = tid & 255, half = tid >> 8, lane = tid & 63, wave = tid >> 6;
    float wreg[31];
#pragma unroll
    for (int j = 0; j < 31; ++j) wreg[j] = p.conv_w[(size_t)l * 31 * 256 + j * 256 + ch];
    const float cb = p.conv_b[l * 256 + ch];
    for (int it = bid; it < NB * 129; it += nblk) {
        const int b = it / 129, p0 = (it % 129) * 16;
        __syncthreads();
#pragma unroll
        for (int q = 0; q < 3; ++q) {
            const int e = tid + q * 512;
            if (e < 46 * 32) {
                const int pp = e >> 5, c8 = (e & 31) * 8, pos = p0 - 30 + pp;
                f32x4 o0 = (f32x4){0.f, 0.f, 0.f, 0.f}, o1 = o0;
                if (pos >= 0) {
                    const bf16_t* rp = p.big + (size_t)row_of(b, pos) * DIN + c8;
                    const u32x4 vw = *(const u32x4*)rp, gw = *(const u32x4*)(rp + 256);
#pragma unroll
                    for (int j = 0; j < 2; ++j) {
                        o0[2 * j] = __uint_as_float(vw[j] << 16) * fsig(__uint_as_float(gw[j] << 16));
                        o0[2 * j + 1] = __uint_as_float(vw[j] & 0xFFFF0000u) * fsig(__uint_as_float(gw[j] & 0xFFFF0000u));
                        o1[2 * j] = __uint_as_float(vw[2 + j] << 16) * fsig(__uint_as_float(gw[2 + j] << 16));
                        o1[2 * j + 1] = __uint_as_float(vw[2 + j] & 0xFFFF0000u) * fsig(__uint_as_float(gw[2 + j] & 0xFFFF0000u));
                    }
                }
                *(f32x4*)(cS + pp * 256 + c8) = o0; *(f32x4*)(cS + pp * 256 + c8 + 4) = o1;
            }
        }
        __syncthreads();
#pragma unroll
        for (int i = 0; i < 8; ++i) {
            const int ii = half * 8 + i;
            float acc = cb;
#pragma unroll
            for (int j = 0; j < 31; ++j) acc += wreg[j] * cS[(ii + j) * 256 + ch];
            yS[ii * 256 + ch] = acc;
        }
        __syncthreads();
#pragma unroll
        for (int q = 0; q < 2; ++q) {
            const int ii = wave * 2 + q;
            const f32x4 v = *(const f32x4*)(yS + ii * 256 + lane * 4);
            const float mu = wave_sum_fast((v[0] + v[1]) + (v[2] + v[3])) * (1.f / 256.f);
            const f32x4 d = v - mu;
            const float var = wave_sum_fast(d[0] * d[0] + d[1] * d[1] + d[2] * d[2] + d[3] * d[3]) * (1.f / 256.f);
            const float rs = rsqrtf(var + 1e-5f);
            const f32x4 g = *(const f32x4*)(p.conv_ln_g + l * 256 + lane * 4), bb = *(const f32x4*)(p.conv_ln_b + l * 256 + lane * 4);
            float o[4];
#pragma unroll
            for (int e = 0; e < 4; ++e) { const float yn = d[e] * rs * g[e] + bb[e]; o[e] = yn * sigm(yn); }
            u32x2 w; w.x = pack2(o[0], o[1]); w.y = pack2(o[2], o[3]);
            *(u32x2*)(p.y + (size_t)row_of(b, p0 + ii) * DM + lane * 4) = w;
        }
    }
}

DEV void phase_rwkv_prep(CP& p, int l, int bid, int nblk, float* lds) {
    bf16_t* X = (bf16_t*)lds;
    constexpr int XS = 264;
    const int tid = tid_(), lane = tid & 63, wave = tid >> 6, fr = lane & 15, fq = lane >> 4;
    const float* mu = p.rwkv_mu + (size_t)l * 1408;
    for (int it = bid; it < MTOK / 64; it += nblk) {
        __syncthreads();
        {
            const int rr = tid >> 3, c0 = (tid & 7) * 32, row = it * 64 + rr;
            int b, pos;
            if (row < MMAIN) { b = row >> 11; pos = (row & 2047) + NMETA; } else { b = (row - MMAIN) >> 4; pos = (row - MMAIN) & 15; }
            const bf16_t* cp = p.big + (size_t)row * DIN + C_RW + 1152 + c0;
            const bf16_t* pp = p.big + (size_t)row_of(b, pos > 0 ? pos - 1 : 0) * DIN + C_RW + 1152 + c0;
#pragma unroll
            for (int q = 0; q < 4; ++q) {
                const u32x4 cw = *(const u32x4*)(cp + q * 8);
                u32x4 pw = *(const u32x4*)(pp + q * 8);
                if (pos == 0) pw = (u32x4){0u, 0u, 0u, 0u};
                const int c = c0 + q * 8;
                const f32x4 m0 = *(const f32x4*)(mu + 1152 + c), m1 = *(const f32x4*)(mu + 1152 + c + 4);
                float xs[8];
#pragma unroll
                for (int j = 0; j < 4; ++j) {
                    const float a0 = __uint_as_float(cw[j] << 16), a1 = __uint_as_float(cw[j] & 0xFFFF0000u);
                    const float q0 = __uint_as_float(pw[j] << 16), q1 = __uint_as_float(pw[j] & 0xFFFF0000u);
                    const float ma = j < 2 ? m0[2 * j] : m1[2 * j - 4], mb = j < 2 ? m0[2 * j + 1] : m1[2 * j - 3];
                    xs[2 * j] = a0 + ma * (q0 - a0); xs[2 * j + 1] = a1 + mb * (q1 - a1);
                }
#pragma unroll
                for (int j = 0; j < 8; ++j) { if (c < 64) xs[j] = tanhf(xs[j]); else if (c >= 128) xs[j] = fsig(xs[j]); }
                u32x4 w; w.x = cvt2(xs[0], xs[1]); w.y = cvt2(xs[2], xs[3]); w.z = cvt2(xs[4], xs[5]); w.w = cvt2(xs[6], xs[7]);
                *(u32x4*)(X + rr * XS + c) = w;
            }
        }
        __syncthreads();
        const int rt = wave & 3, chalf = wave >> 2;
        bf16x8 af[8];
#pragma unroll
        for (int ks = 0; ks < 8; ++ks) af[ks] = *(const bf16x8*)(X + (rt * 16 + fr) * XS + ks * 32 + fq * 8);
        const int row = it * 64 + rt * 16 + fr;
        for (int nt = chalf * 12; nt < chalf * 12 + 12; ++nt) {
            const bf16_t* wb = p.Wl + (size_t)(nt * 16 + fr) * 64 + fq * 8;
            const bf16_t* ab = p.Wl + DRW * 64 + (size_t)(nt * 16 + fr) * 64 + fq * 8;
            const bf16_t* gb = p.Wl + DRW * 128 + (size_t)(nt * 16 + fr) * 128 + fq * 8;
            f32x4 cw = (f32x4){0.f, 0.f, 0.f, 0.f}, ca = cw, cg = cw;
#pragma unroll
            for (int ks = 0; ks < 2; ++ks) {
                cw = __builtin_amdgcn_mfma_f32_16x16x32_bf16(*(const bf16x8*)(wb + ks * 32), af[ks], cw, 0, 0, 0);
                ca = __builtin_amdgcn_mfma_f32_16x16x32_bf16(*(const bf16x8*)(ab + ks * 32), af[2 + ks], ca, 0, 0, 0);
            }
#pragma unroll
            for (int ks = 0; ks < 4; ++ks) cg = __builtin_amdgcn_mfma_f32_16x16x32_bf16(*(const bf16x8*)(gb + ks * 32), af[4 + ks], cg, 0, 0, 0);
            const int col = nt * 16 + 4 * fq;
            const f32x4 w0 = *(const f32x4*)(p.rwkv_w0 + l * DRW + col), a0 = *(const f32x4*)(p.rwkv_a0 + l * DRW + col);
            f32x4 olw, oaa;
#pragma unroll
            for (int j = 0; j < 4; ++j) {
                const float xw = -(w0[j] + cw[j]);
                const float sp = fmaxf(xw, 0.f) + __logf(1.f + __expf(-fabsf(xw)));
                olw[j] = -__expf(-sp - 0.5f);
                oaa[j] = fsig(a0[j] + ca[j]);
            }
            const size_t o = (size_t)row * DRW + col;
            *(f32x4*)(p.lw + o) = olw; *(f32x4*)(p.aa + o) = oaa; *(f32x4*)(p.gg + o) = cg;
        }
    }
}

DEV void phase_rwkv_scan(CP& p, int l, int bid, int nblk, float* lds) {
    float* rS = lds;
    float* wS = rS + 1024;
    float* kS = wS + 1024;
    float* vS = kS + 1024;
    float* nS = vS + 1024;
    float* bS = nS + 1024;
    float* gS = bS + 1024;
    float* oS = gS + 1024;
    float* cS = oS + 1024;
    const int tid = tid_(), lane = tid & 63, wave = tid >> 6;
    const int vi = tid >> 3, ks = tid & 7;
    const float* mu = p.rwkv_mu + (size_t)l * 1408;
    for (int it = bid; it < NB * 6; it += nblk) {
        const int b = it / 6, hh = it % 6;
        float S[8];
#pragma unroll
        for (int i = 0; i < 8; ++i) S[i] = 0.f;
        const int hc = hh * 64 + lane;
        const float mr = mu[hc], mk = mu[384 + hc], mv = mu[768 + hc];
        const float kkw = p.rwkv_kk[l * DRW + hc], kaw = p.rwkv_ka[l * DRW + hc], rkw = p.rwkv_rk[l * DRW + hc];
        const float lng = p.rwkv_ln_g[l * DRW + hc], lnb = p.rwkv_ln_b[l * DRW + hc];
        for (int ck = 0; ck < 129; ++ck) {
            const int p0 = ck * 16;
            __syncthreads();
#pragma unroll
            for (int q = 0; q < 2; ++q) {
                const int tk = wave * 2 + q, pos = p0 + tk;
                const int row = row_of(b, pos);
                const bf16_t* cur = p.big + (size_t)row * DIN + C_RW + hc;
                float r = bf2f(cur[0]), k = bf2f(cur[384]), v = bf2f(cur[768]);
                float pr = 0.f, pk = 0.f, pv = 0.f;
                if (pos > 0) { const bf16_t* prv = p.big + (size_t)row_of(b, pos - 1) * DIN + C_RW + hc; pr = bf2f(prv[0]); pk = bf2f(prv[384]); pv = bf2f(prv[768]); }
                r += mr * (pr - r); k += mk * (pk - k); v += mv * (pv - v);
                const size_t o = (size_t)row * DRW + hc;
                const float a = p.aa[o], w = expf(p.lw[o]), g = p.gg[o];
                const float kkr = k * kkw;
                const float nrm = fmaxf(sqrtf(wave_sum(kkr * kkr)), 1e-12f);
                const float kk = kkr / nrm;
                const float kp = k * (1.f + (a - 1.f) * kaw);
                const float ct = wave_sum(r * kp * rkw);
                const int e = tk * 64 + lane;
                rS[e] = r; wS[e] = w; kS[e] = kp; vS[e] = v; nS[e] = kk; bS[e] = kk * a; gS[e] = g;
                if (lane == 0) cS[tk] = ct;
            }
            __syncthreads();
            for (int tk = 0; tk < 16; ++tk) {
                const int e = tk * 64 + ks * 8;
                const f32x4 n0 = *(const f32x4*)(nS + e), n1 = *(const f32x4*)(nS + e + 4);
                float sa = 0.f;
#pragma unroll
                for (int i = 0; i < 4; ++i) { sa -= S[i] * n0[i]; sa -= S[4 + i] * n1[i]; }
                sa += __shfl_xor(sa, 1); sa += __shfl_xor(sa, 2); sa += __shfl_xor(sa, 4);
                const f32x4 w0 = *(const f32x4*)(wS + e), w1 = *(const f32x4*)(wS + e + 4);
                const f32x4 b0 = *(const f32x4*)(bS + e), b1 = *(const f32x4*)(bS + e + 4);
                const f32x4 k0 = *(const f32x4*)(kS + e), k1 = *(const f32x4*)(kS + e + 4);
                const f32x4 r0 = *(const f32x4*)(rS + e), r1 = *(const f32x4*)(rS + e + 4);
                const float vv = vS[tk * 64 + vi];
                float o = 0.f;
#pragma unroll
                for (int i = 0; i < 4; ++i) {
                    S[i] = S[i] * w0[i] + sa * b0[i] + vv * k0[i];
                    S[4 + i] = S[4 + i] * w1[i] + sa * b1[i] + vv * k1[i];
                    o += S[i] * r0[i]; o += S[4 + i] * r1[i];
                }
                o += __shfl_xor(o, 1); o += __shfl_xor(o, 2); o += __shfl_xor(o, 4);
                if (ks == 0) oS[tk * 64 + vi] = o;
            }
            __syncthreads();
#pragma unroll
            for (int q = 0; q < 2; ++q) {
                const int tk = wave * 2 + q, e = tk * 64 + lane;
                const float o = oS[e];
                const float m = wave_sum(o) * (1.f / 64.f);
                const float d = o - m;
                const float var = wave_sum(d * d) * (1.f / 64.f);
                float yv = d * rsqrtf(var + 64e-5f) * lng + lnb;
                yv = (yv + cS[tk] * vS[e]) * gS[e];
                p.y[(size_t)row_of(b, p0 + tk) * DM + 256 + hc] = f2bf(yv);
            }
        }
    }
}

constexpr int TCH = 32, NCH = 65;
struct ScanRegs { unsigned short r[8], k[8], v[8]; unsigned short pr, pk, pv; float a[8], lw[8]; };
DEV void scan_issue(CP& p, ScanRegs& R, int b, int hc, int c, int lwv) {
#pragma unroll
    for (int q = 0; q < 8; ++q) {
        const int pos = c * TCH + lwv * 8 + q;
        R.r[q] = 0; R.k[q] = 0; R.v[q] = 0; R.a[q] = 0.f; R.lw[q] = 0.f;
        if (pos < LT) {
            const int row = row_of(b, pos);
            const bf16_t* cur = p.big + (size_t)row * DIN + C_RW + hc;
            R.r[q] = cur[0]; R.k[q] = cur[384]; R.v[q] = cur[768];
            R.a[q] = p.aa[(size_t)row * DRW + hc]; R.lw[q] = p.lw[(size_t)row * DRW + hc];
        }
    }
    const int pp = c * TCH + lwv * 8 - 1;
    R.pr = 0; R.pk = 0; R.pv = 0;
    if (pp >= 0) { const bf16_t* prv = p.big + (size_t)row_of(b, pp) * DIN + C_RW + hc; R.pr = prv[0]; R.pk = prv[384]; R.pv = prv[768]; }
}
DEV void phase_rwkv_scan2(CP& p, int l, int item, float* lds) {
    const int tid = tid_(), lane = tid & 63;
    const int b = item / 24, hh = (item >> 2) % 6, rq = item & 3;
    if (tid >= 256) {
        const int lwv = (tid - 256) >> 6, hc = hh * 64 + lane;
        const float* mu = p.rwkv_mu + (size_t)l * 1408;
        const float mr = mu[hc], mk = mu[384 + hc], mv = mu[768 + hc];
        const float kkw = p.rwkv_kk[l * DRW + hc], kaw = p.rwkv_ka[l * DRW + hc], rkw = p.rwkv_rk[l * DRW + hc];
        ScanRegs R;
        scan_issue(p, R, b, hc, 0, lwv);
        for (int c = 0; c <= NCH; ++c) {
            if (c < NCH) {
                float* buf = lds + (c & 1) * (6 * TCH * 64);
                float pr = bf2f(R.pr), pk = bf2f(R.pk), pv = bf2f(R.pv);
#pragma unroll
                for (int q = 0; q < 8; ++q) {
                    const int tk = lwv * 8 + q;
                    const float r0 = bf2f(R.r[q]), k0 = bf2f(R.k[q]), v0 = bf2f(R.v[q]);
                    const float r = r0 + mr * (pr - r0), k = k0 + mk * (pk - k0), v = v0 + mv * (pv - v0);
                    pr = r0; pk = k0; pv = v0;
                    const float a = R.a[q], w = __expf(R.lw[q]);
                    const float kkr = k * kkw;
                    const float kk = kkr * __builtin_amdgcn_rsqf(fmaxf(wave_sum_fast(kkr * kkr), 1e-24f));
                    const float kp = k * (1.f + (a - 1.f) * kaw);
                    const int e = tk * 64 + lane;
                    buf[e] = r; buf[2048 + e] = w; buf[4096 + e] = kp; buf[6144 + e] = v; buf[8192 + e] = kk; buf[10240 + e] = kk * a;
                    if (rq == 0) {
                        const float ct = wave_sum_fast(r * kp * rkw);
                        const int pos = c * TCH + tk;
                        if (lane == 0 && pos < LT) p.ct[(size_t)row_of(b, pos) * 8 + hh] = ct;
                    }
                }
                if (c + 1 < NCH) scan_issue(p, R, b, hc, c + 1, lwv);
            }
            __syncthreads();
        }
    } else {
        const int vi = tid >> 4, ks = tid & 15, vrow = rq * 16 + vi;
        float S0 = 0.f, S1 = 0.f, S2 = 0.f, S3 = 0.f;
        __syncthreads();
        for (int c = 0; c < NCH; ++c) {
            const float* buf = lds + (c & 1) * (6 * TCH * 64);
            const int nst = (LT - c * TCH) < TCH ? (LT - c * TCH) : TCH;
#define SCAN_LOAD(R4, W4, K4, N4, B4, VV, TK) { const int e_ = ((TK) & 31) * 64 + ks * 4; R4 = *(const f32x4*)(buf + e_); W4 = *(const f32x4*)(buf + 2048 + e_); K4 = *(const f32x4*)(buf + 4096 + e_); \
                N4 = *(const f32x4*)(buf + 8192 + e_); B4 = *(const f32x4*)(buf + 10240 + e_); VV = buf[6144 + ((TK) & 31) * 64 + vrow]; }
#define SCAN_STEP(R4, W4, K4, N4, B4, VV, TK) { \
                float sa = (S0 * N4[0] + S1 * N4[1]) + (S2 * N4[2] + S3 * N4[3]); \
                const float t0 = S0 * W4[0] + VV * K4[0], t1 = S1 * W4[1] + VV * K4[1], t2 = S2 * W4[2] + VV * K4[2], t3 = S3 * W4[3] + VV * K4[3]; \
                sa = -dpp_sum16(sa); \
                S0 = t0 + sa * B4[0]; S1 = t1 + sa * B4[1]; S2 = t2 + sa * B4[2]; S3 = t3 + sa * B4[3]; \
                float o = (S0 * R4[0] + S1 * R4[1]) + (S2 * R4[2] + S3 * R4[3]); \
                o = dpp_sum16(o); \
                if (ks == 0) p.oraw[(size_t)row_of(b, c * TCH + (TK)) * DRW + hh * 64 + vrow] = o; }
            f32x4 rA, wA, kA, nA, bA, rB, wB, kB, nB, bB; float vA, vB;
            SCAN_LOAD(rA, wA, kA, nA, bA, vA, 0);
            for (int tk = 0; tk < nst; tk += 2) {
                SCAN_LOAD(rB, wB, kB, nB, bB, vB, tk + 1);
                SCAN_STEP(rA, wA, kA, nA, bA, vA, tk);
                SCAN_LOAD(rA, wA, kA, nA, bA, vA, tk + 2);
                SCAN_STEP(rB, wB, kB, nB, bB, vB, tk + 1);
            }
#undef SCAN_LOAD
#undef SCAN_STEP
            __syncthreads();
        }
    }
}
DEV void phase_rwkv_post(CP& p, int l, int bid, int nblk) {
    const int tid = tid_(), lane = tid & 63, wave = tid >> 6;
    const float* mu = p.rwkv_mu + (size_t)l * 1408;
    for (int it = bid * 8 + wave; it < NB * LT * 6; it += nblk * 8) {
        const int hh = it % 6, tok = it / 6, b = tok / LT, pos = tok % LT;
        const int row = row_of(b, pos), hc = hh * 64 + lane;
        const float o = p.oraw[(size_t)row * DRW + hc];
        const float v0 = bf2f(p.big[(size_t)row * DIN + C_RW + 768 + hc]);
        const float pv = pos > 0 ? bf2f(p.big[(size_t)row_of(b, pos - 1) * DIN + C_RW + 768 + hc]) : 0.f;
        const float v = v0 + mu[768 + hc] * (pv - v0);
        const float g = p.gg[(size_t)row * DRW + hc], ct = p.ct[(size_t)row * 8 + hh];
        const float m = wave_sum(o) * (1.f / 64.f);
        const float d = o - m;
        const float var = wave_sum(d * d) * (1.f / 64.f);
        float yv = d * rsqrtf(var + 64e-5f) * p.rwkv_ln_g[l * DRW + hc] + p.rwkv_ln_b[l * DRW + hc];
        yv = (yv + ct * v) * g;
        p.y[(size_t)row * DM + 256 + hc] = f2bf(yv);
    }
}

DEV void phase_sb(CP& p, int l, int bid, int nblk, float* lds) {
    float* Ks = lds;
    float* Vs = lds + 2048;
    const int tid = tid_(), qi = tid >> 1, hf = tid & 1;
    for (int it = bid; it < NB * 6 * 9; it += nblk) {
        const int qt = it % 9, bh = it / 9, b = bh / 6, hh = bh % 6;
        const int t = qt * 256 + qi;
        const bool valid = t < LT;
        const int myrow = row_of(b, valid ? t : 0);
        float q[64], acc[32];
        {
            const bf16_t* qp = p.big + (size_t)myrow * DIN + C_Q + hh * 64;
#pragma unroll
            for (int i = 0; i < 8; ++i) {
                const u32x4 w = *(const u32x4*)(qp + i * 8);
#pragma unroll
                for (int e = 0; e < 4; ++e) { q[i * 8 + 2 * e] = __uint_as_float(w[e] << 16) * 0.125f; q[i * 8 + 2 * e + 1] = __uint_as_float(w[e] & 0xFFFF0000u) * 0.125f; }
            }
        }
#pragma unroll
        for (int d = 0; d < 32; ++d) acc[d] = 0.f;
        float carry = 0.f;
        int thi = qt * 256 + 254; if (thi > LT - 2) thi = LT - 2;
        for (int kt = thi >> 5; kt >= 0; --kt) {
            __syncthreads();
            {
                const int which = tid >> 8, key = (tid & 255) >> 3, part = tid & 7, s = kt * 32 + key;
                float f[8];
#pragma unroll
                for (int e = 0; e < 8; ++e) f[e] = 0.f;
                if (s < LT) {
                    const u32x4 w = *(const u32x4*)(p.big + (size_t)row_of(b, s) * DIN + (which ? C_V : C_K) + hh * 64 + part * 8);
#pragma unroll
                    for (int e = 0; e < 4; ++e) { f[2 * e] = __uint_as_float(w[e] << 16); f[2 * e + 1] = __uint_as_float(w[e] & 0xFFFF0000u); }
                }
                float* dst = (which ? Vs : Ks) + key * 64 + part * 8;
                *(f32x4*)dst = (f32x4){f[0], f[1], f[2], f[3]};
                *(f32x4*)(dst + 4) = (f32x4){f[4], f[5], f[6], f[7]};
            }
            __syncthreads();
            for (int kk = 31; kk >= 0; --kk) {
                const int s = kt * 32 + kk;
                if (valid && s < t) {
                    float z0 = 0.f, z1 = 0.f;
#pragma unroll
                    for (int i = 0; i < 16; ++i) {
                        if ((i & 3) == 0) asm volatile("" ::: "memory");
                        const f32x4 kv = *(const f32x4*)(Ks + kk * 64 + i * 4);
                        z0 += q[i * 4] * kv[0]; z1 += q[i * 4 + 1] * kv[1]; z0 += q[i * 4 + 2] * kv[2]; z1 += q[i * 4 + 3] * kv[3];
                    }
                    const float z = z0 + z1;
                    const float ls = fminf(z, 0.f) - log1pf(expf(-fabsf(z)));
                    const float a = expf(ls + carry);
                    carry += ls - z;
#pragma unroll
                    for (int i = 0; i < 8; ++i) {
                        const f32x4 vv = *(const f32x4*)(Vs + kk * 64 + hf * 32 + i * 4);
                        acc[i * 4] += a * vv[0]; acc[i * 4 + 1] += a * vv[1]; acc[i * 4 + 2] += a * vv[2]; acc[i * 4 + 3] += a * vv[3];
                    }
                }
            }
            if (__syncthreads_and((!valid || carry < -110.f) ? 1 : 0)) break;
        }
        float ms = 0.f;
#pragma unroll
        for (int d = 0; d < 32; ++d) ms += acc[d] * acc[d];
        ms += __shfl_xor(ms, 1);
        if (valid) {
            const float rs = rsqrtf(ms * (1.f / 64.f) + 1e-6f);
            const float* g = p.sb_norm + l * 384 + hh * 64 + hf * 32;
            bf16_t* yp = p.y + (size_t)myrow * DM + 640 + hh * 64 + hf * 32;
#pragma unroll
            for (int i = 0; i < 4; ++i) {
                u32x4 w;
#pragma unroll
                for (int e = 0; e < 4; ++e) w[e] = pack2(acc[i * 8 + 2 * e] * rs * g[i * 8 + 2 * e], acc[i * 8 + 2 * e + 1] * rs * g[i * 8 + 2 * e + 1]);
                *(u32x4*)(yp + i * 8) = w;
            }
        }
    }
}

DEV void phase_sb_mfma(CP& p, int l, int bid, int nblk) {
    const int tid = tid_(), lane = tid & 63, wave = tid >> 6, r = lane & 31, h = lane >> 5;
    for (int it = bid * 8 + wave; it < NB * 6 * 65; it += nblk * 8) {
        const int qt = it % 65, bh = it / 65, b = bh / 6, hh = bh % 6;
        const int q0 = qt * 32, t = q0 + r;
        const bool valid = t < LT;
        const int myrow = row_of(b, valid ? t : LT - 1);
        bf16x8 qf[4];
        {
            const bf16_t* qp = p.big + (size_t)myrow * DIN + C_Q + hh * 64 + 8 * h;
#pragma unroll
            for (int ks = 0; ks < 4; ++ks) qf[ks] = *(const bf16x8*)(qp + 16 * ks);
        }
        f32x16 o0, o1;
#pragma unroll
        for (int i = 0; i < 16; ++i) { o0[i] = 0.f; o1[i] = 0.f; }
        float carry = 0.f;
        const bf16_t* vbase = p.vt + (size_t)((b * 6 + hh) * 64 + r) * LPV + 4 * h;
        bf16x8 kf[4];
        {
            const bf16_t* kp = p.big + (size_t)row_of(b, q0 + r) * DIN + C_K + hh * 64 + 8 * h;
#pragma unroll
            for (int ks = 0; ks < 4; ++ks) kf[ks] = *(const bf16x8*)(kp + 16 * ks);
        }
        for (int k0 = q0; k0 >= 0; k0 -= 32) {
            bf16x8 vf[2][2];
#pragma unroll
            for (int db = 0; db < 2; ++db)
#pragma unroll
                for (int s = 0; s < 2; ++s) {
                    const bf16_t* vp = vbase + (size_t)(db * 32) * LPV + k0 + 16 * s;
                    const s16x4 lo = *(const s16x4*)vp, hi = *(const s16x4*)(vp + 8);
                    vf[db][s] = __builtin_shufflevector(lo, hi, 0, 1, 2, 3, 4, 5, 6, 7);
                }
            bf16x8 kn[4];
            {
                const int kpos = k0 >= 32 ? k0 - 32 + r : r;
                const bf16_t* kp = p.big + (size_t)row_of(b, kpos) * DIN + C_K + hh * 64 + 8 * h;
#pragma unroll
                for (int ks = 0; ks < 4; ++ks) kn[ks] = *(const bf16x8*)(kp + 16 * ks);
            }
            f32x16 x;
#pragma unroll
            for (int i = 0; i < 16; ++i) x[i] = 0.f;
#pragma unroll
            for (int ks = 0; ks < 4; ++ks) x = __builtin_amdgcn_mfma_f32_32x32x16_bf16(kf[ks], qf[ks], x, 0, 0, 0);
            float lr[16], ls[16];
#pragma unroll
            for (int i = 0; i < 16; ++i) {
                const int key = k0 + (i & 3) + 8 * (i >> 2) + 4 * h;
                const float z = x[i] * 0.125f;
                const float sp = __logf(1.f + __expf(-fabsf(z)));
                const float lsi = fminf(z, 0.f) - sp;
                ls[i] = lsi;
                lr[i] = key < t ? lsi - z : 0.f;
            }
            float pw[16];
            float run = carry;
#pragma unroll
            for (int g = 3; g >= 0; --g) {
                const float G = (lr[4 * g] + lr[4 * g + 1]) + (lr[4 * g + 2] + lr[4 * g + 3]);
                const float Gp = __shfl_xor(G, 32);
                const float s3 = run + (h == 0 ? Gp : 0.f);
                const float s2 = s3 + lr[4 * g + 3], s1 = s2 + lr[4 * g + 2], s0 = s1 + lr[4 * g + 1];
                const int keyb = k0 + 8 * g + 4 * h;
                pw[4 * g + 3] = keyb + 3 < t ? __expf(ls[4 * g + 3] + s3) : 0.f;
                pw[4 * g + 2] = keyb + 2 < t ? __expf(ls[4 * g + 2] + s2) : 0.f;
                pw[4 * g + 1] = keyb + 1 < t ? __expf(ls[4 * g + 1] + s1) : 0.f;
                pw[4 * g + 0] = keyb + 0 < t ? __expf(ls[4 * g + 0] + s0) : 0.f;
                run += G + Gp;
            }
            carry = run;
            const bf16x8 pf0 = pack_frag(pw[0], pw[1], pw[2], pw[3], pw[4], pw[5], pw[6], pw[7]);
            const bf16x8 pf1 = pack_frag(pw[8], pw[9], pw[10], pw[11], pw[12], pw[13], pw[14], pw[15]);
            o0 = __builtin_amdgcn_mfma_f32_32x32x16_bf16(vf[0][0], pf0, o0, 0, 0, 0);
            o0 = __builtin_amdgcn_mfma_f32_32x32x16_bf16(vf[0][1], pf1, o0, 0, 0, 0);
            o1 = __builtin_amdgcn_mfma_f32_32x32x16_bf16(vf[1][0], pf0, o1, 0, 0, 0);
            o1 = __builtin_amdgcn_mfma_f32_32x32x16_bf16(vf[1][1], pf1, o1, 0, 0, 0);
#pragma unroll
            for (int ks = 0; ks < 4; ++ks) kf[ks] = kn[ks];
            if (__all((!valid || carry < -110.f) ? 1 : 0)) break;
        }
        float ss = 0.f;
#pragma unroll
        for (int i = 0; i < 16; ++i) ss += o0[i] * o0[i] + o1[i] * o1[i];
        ss += __shfl_xor(ss, 32);
        const float rs = rsqrtf(ss * (1.f / 64.f) + 1e-6f);
        if (valid) {
            const float* g = p.sb_norm + l * 384 + hh * 64 + 4 * h;
            bf16_t* yp = p.y + (size_t)myrow * DM + 640 + hh * 64 + 4 * h;
#pragma unroll
            for (int gq = 0; gq < 4; ++gq) {
                const f32x4 g0 = *(const f32x4*)(g + 8 * gq), g1 = *(const f32x4*)(g + 32 + 8 * gq);
                u32x2 w0, w1;
                w0.x = cvt2(o0[4 * gq] * rs * g0[0], o0[4 * gq + 1] * rs * g0[1]); w0.y = cvt2(o0[4 * gq + 2] * rs * g0[2], o0[4 * gq + 3] * rs * g0[3]);
                w1.x = cvt2(o1[4 * gq] * rs * g1[0], o1[4 * gq + 1] * rs * g1[1]); w1.y = cvt2(o1[4 * gq + 2] * rs * g1[2], o1[4 * gq + 3] * rs * g1[3]);
                *(u32x2*)(yp + 8 * gq) = w0;
                *(u32x2*)(yp + 32 + 8 * gq) = w1;
            }
        }
    }
}

DEV void phase_final(CP& p, int bid, int nblk) {
    const int lane = tid_() & 63, wave = tid_() >> 6;
    for (int r = bid * 8 + wave; r < MMAIN; r += nblk * 8) {
        const float rs = row_rstd(p.part, r);
#pragma unroll
        for (int i = 0; i < 4; ++i) {
            const int c = (i * 64 + lane) * 4;
            const f32x4 v = *(const f32x4*)(p.h + (size_t)r * DM + c), g = *(const f32x4*)(p.final_norm + c);
            *(f32x4*)(p.out + (size_t)r * DM + c) = v * rs * g;
        }
    }
}

enum { PH_INIT = 0, PH_CONVERT, PH_G1A, PH_G2A, PH_G3, PH_CONV, PH_PREP, PH_SCAN, PH_SB, PH_G4, PH_G1B, PH_G2B, PH_FINAL };

DEV void run_phase(CP& p, int ph, int l, int bid, int nblk, float* lds) {
    switch (ph) {
    case PH_INIT: phase_init(p, bid, nblk); break;
    case PH_G1A: gemm_big(p.hb, p.W13a, MMAIN, 2 * DFF, DM, EpiSwiglu{p.big, p.part}, bid, nblk, (unsigned char*)lds);
        if (bid >= 128) gemm_meta<EPI_SWIGLU>(p, p.hb, p.W13a, 2 * DFF, DM, 0.f, bid - 128, nblk - 128, lds); break;
    case PH_G2A: gemm_big(p.big, p.W2a, MMAIN, DM, DFF, EpiResid{p.h, p.hb, p.part, 0.5f}, bid, nblk, (unsigned char*)lds);
        gemm_meta<EPI_RESID>(p, p.big, p.W2a, DM, DFF, 0.5f, bid, nblk, lds); break;
    case PH_G3: gemm_big(p.hb, p.Win, MMAIN, DIN, DM, EpiP{p.big, p.vt, p.part}, bid, nblk, (unsigned char*)lds);
        gemm_meta<EPI_P>(p, p.hb, p.Win, DIN, DM, 0.f, bid, nblk, lds); break;
    case PH_CONV: phase_conv(p, l, bid, nblk, lds); break;
    case PH_PREP: phase_rwkv_prep(p, l, bid, nblk, lds); break;
    case PH_SCAN: phase_rwkv_scan(p, l, bid, nblk, lds); break;
    case PH_SB: phase_sb_mfma(p, l, bid, nblk); break;
    case PH_G4: gemm_big(p.y, p.Wout, MMAIN, DM, DM, EpiResid{p.h, p.hb, p.part, 1.0f}, bid, nblk, (unsigned char*)lds);
        gemm_meta<EPI_RESID>(p, p.y, p.Wout, DM, DM, 1.0f, bid, nblk, lds); break;
    case PH_G1B: gemm_big(p.hb, p.W13b, MMAIN, 2 * DFF, DM, EpiSwiglu{p.big, p.part}, bid, nblk, (unsigned char*)lds);
        if (bid >= 128) gemm_meta<EPI_SWIGLU>(p, p.hb, p.W13b, 2 * DFF, DM, 0.f, bid - 128, nblk - 128, lds); break;
    case PH_G2B: gemm_big(p.big, p.W2b, MMAIN, DM, DFF, EpiResid{p.h, p.hb, p.part, 0.5f}, bid, nblk, (unsigned char*)lds);
        gemm_meta<EPI_RESID>(p, p.big, p.W2b, DM, DFF, 0.5f, bid, nblk, lds); break;
    case PH_FINAL: phase_final(p, bid, nblk); break;
    }
}

namespace cg = cooperative_groups;
constexpr int LDS_BYTES = 131072;

__global__ void __launch_bounds__(512) k_mega(P p) {
    extern __shared__ __attribute__((aligned(16))) unsigned char smem[];
    float* lds = (float*)smem;
    cg::grid_group grid = cg::this_grid();
    const int bid = blockIdx.x, nblk = gridDim.x;
    phase_init(*kargs(), bid, nblk);
    phase_convert(*kargs(), 0, 0, bid, nblk, lds);
    grid.sync();
    for (int l = 0; l < 4; ++l) {
        run_phase(*kargs(), PH_G1A, l, bid, nblk, lds); grid.sync();
        run_phase(*kargs(), PH_G2A, l, bid, nblk, lds); grid.sync();
        run_phase(*kargs(), PH_G3, l, bid, nblk, lds); grid.sync();
        run_phase(*kargs(), PH_CONV, l, bid, nblk, lds);
        run_phase(*kargs(), PH_PREP, l, bid, nblk, lds);
        grid.sync();
        if (bid < 192) phase_rwkv_scan2(*kargs(), l, bid, lds);
        else {
            phase_sb_mfma(*kargs(), l, bid - 192, nblk - 192);
            __syncthreads();
            phase_convert(*kargs(), l, 1, bid - 192, nblk - 192, lds);
            if (l < 3) phase_convert(*kargs(), l + 1, 0, bid - 192, nblk - 192, lds);
        }
        grid.sync();
        phase_rwkv_post(*kargs(), l, bid, nblk);
        grid.sync();
        run_phase(*kargs(), PH_G4, l, bid, nblk, lds); grid.sync();
        run_phase(*kargs(), PH_G1B, l, bid, nblk, lds); grid.sync();
        run_phase(*kargs(), PH_G2B, l, bid, nblk, lds); grid.sync();
    }
    phase_final(*kargs(), bid, nblk);
}

extern "C" void kernel_launch(void* const* d_in, const int* in_sizes, int n_in, void* d_out, int out_size, void* d_ws, size_t ws_size, hipStream_t stream) {
    static int grid_blocks = 0;
    if (grid_blocks == 0) {
        int dev = 0, cus = 0, per_cu = 0;
        hipGetDevice(&dev);
        hipDeviceGetAttribute(&cus, hipDeviceAttributeMultiprocessorCount, dev);
        if (hipFuncSetAttribute((const void*)k_mega, hipFuncAttributeMaxDynamicSharedMemorySize, LDS_BYTES) != hipSuccess) { fprintf(stderr, "hipFuncSetAttribute failed\n"); grid_blocks = -1; return; }
        if (hipOccupancyMaxActiveBlocksPerMultiprocessor(&per_cu, (const void*)k_mega, 512, LDS_BYTES) != hipSuccess || per_cu < 1) { fprintf(stderr, "occupancy query failed (%d)\n", per_cu); per_cu = 1; }
        (void)hipGetLastError();
        grid_blocks = cus * per_cu;
    }
    if (grid_blocks < 0) return;
    P p{};
    const float** f = (const float**)&p;
    for (int i = 0; i < 28; ++i) f[i] = (const float*)d_in[i];
    p.out = (float*)d_out;
    size_t off = 0;
    auto take = [&](size_t bytes) { void* r = (char*)d_ws + off; off += (bytes + 255) & ~(size_t)255; return r; };
    p.W13a = (bf16_t*)take((size_t)2 * DFF * DM * 2);
    p.W2a = (bf16_t*)take((size_t)DM * DFF * 2);
    p.Win = (bf16_t*)take((size_t)DIN * DM * 2);
    p.Wout = (bf16_t*)take((size_t)DM * DM * 2);
    p.W13b = (bf16_t*)take((size_t)2 * DFF * DM * 2);
    p.W2b = (bf16_t*)take((size_t)DM * DFF * 2);
    p.Wl = (bf16_t*)take((size_t)DRW * 256 * 2);
    p.h = (float*)take((size_t)MP * DM * 4);
    p.hb = (bf16_t*)take((size_t)MP * DM * 2);
    p.big = (bf16_t*)take((size_t)MP * DIN * 2);
    p.y = (bf16_t*)take((size_t)MP * DM * 2);
    p.vt = (bf16_t*)take((size_t)NB * 6 * 64 * LPV * 2);
    p.part = (float*)take((size_t)MP * 16 * 4);
    p.lw = (float*)take((size_t)MP * DRW * 4);
    p.aa = (float*)take((size_t)MP * DRW * 4);
    p.gg = (float*)take((size_t)MP * DRW * 4);
    p.oraw = (float*)take((size_t)MP * DRW * 4);
    p.ct = (float*)take((size_t)MP * 8 * 4);
    if (off > ws_size) { fprintf(stderr, "workspace too small: need %zu have %zu\n", off, ws_size); return; }
    void* args[] = {&p};
    hipError_t e = hipLaunchCooperativeKernel((const void*)k_mega, dim3(grid_blocks), dim3(512), args, LDS_BYTES, stream);
    if (e != hipSuccess) fprintf(stderr, "cooperative launch failed: %s (grid %d)\n", hipGetErrorString(e), grid_blocks);
}
```

```cpp
#include <hip/hip_runtime.h>
#include <hip/hip_cooperative_groups.h>
#include <stdint.h>
#include <stdio.h>

typedef unsigned short bf16_t;
typedef short bf16x8 __attribute__((ext_vector_type(8)));
typedef float f32x4 __attribute__((ext_vector_type(4)));
typedef unsigned u32x4 __attribute__((ext_vector_type(4)));
typedef unsigned u32x2 __attribute__((ext_vector_type(2)));

#define DEV __device__ __forceinline__

constexpr int NB = 8, SEQ = 2048, NMETA = 16, LT = 2064, DM = 1024, DFF = 2816, DIN = 3072;
constexpr int MMAIN = 16384, MTOK = 16512, MP = 16640;
constexpr int DRW = 384, LPV = 2080;
constexpr int C_RW = 512, C_Q = 1920, C_K = 2304, C_V = 2688;

struct P {
    const float *x, *meta, *ffn1_norm, *ffn1_w13, *ffn1_w2, *mix_norm, *w_in, *conv_w, *conv_b, *conv_ln_g, *conv_ln_b,
        *rwkv_mu, *rwkv_w0, *rwkv_wB, *rwkv_a0, *rwkv_aB, *rwkv_gB, *rwkv_kk, *rwkv_ka, *rwkv_rk, *rwkv_ln_g, *rwkv_ln_b,
        *sb_norm, *w_out, *ffn2_norm, *ffn2_w13, *ffn2_w2, *final_norm;
    float* out;
    bf16_t *W13a, *W2a, *Win, *Wout, *W13b, *W2b, *Wl;
    float* h; bf16_t* hb; bf16_t* big; bf16_t* y; bf16_t* vt; float* part;
    float *lw, *aa, *gg, *oraw, *ct;
    unsigned* bar;
};

typedef const __attribute__((address_space(4))) P CP;
DEV CP* kargs() { CP* k = (CP*)__builtin_amdgcn_kernarg_segment_ptr(); asm volatile("" : "+s"(k)); return k; }
DEV int tid_() { int t = threadIdx.x; asm volatile("" : "+v"(t)); return t; }
DEV float bf2f(bf16_t v) { return __uint_as_float(((unsigned)v) << 16); }
DEV bf16_t f2bf(float f) { unsigned u = __float_as_uint(f); u += 0x7FFFu + ((u >> 16) & 1u); return (bf16_t)(u >> 16); }
DEV unsigned pack2(float a, float b) { return (unsigned)f2bf(a) | ((unsigned)f2bf(b) << 16); }
DEV float wave_sum(float v) {
#pragma unroll
    for (int o = 32; o; o >>= 1) v += __shfl_xor(v, o);
    return v;
}
DEV float dpp_sum16(float x) {
    x += __builtin_bit_cast(float, __builtin_amdgcn_update_dpp(0, __builtin_bit_cast(int, x), 0xB1, 0xF, 0xF, false));
    x += __builtin_bit_cast(float, __builtin_amdgcn_update_dpp(0, __builtin_bit_cast(int, x), 0x4E, 0xF, 0xF, false));
    x += __builtin_bit_cast(float, __builtin_amdgcn_update_dpp(0, __builtin_bit_cast(int, x), 0x141, 0xF, 0xF, false));
    x += __builtin_bit_cast(float, __builtin_amdgcn_update_dpp(0, __builtin_bit_cast(int, x), 0x140, 0xF, 0xF, false));
    return x;
}
DEV float wave_sum_fast(float x) {
    x = dpp_sum16(x);
    const int xi = __builtin_bit_cast(int, x);
    return (__builtin_bit_cast(float, __builtin_amdgcn_readlane(xi, 0)) + __builtin_bit_cast(float, __builtin_amdgcn_readlane(xi, 16))) +
           (__builtin_bit_cast(float, __builtin_amdgcn_readlane(xi, 32)) + __builtin_bit_cast(float, __builtin_amdgcn_readlane(xi, 48)));
}
typedef float f32x16 __attribute__((ext_vector_type(16)));
typedef __bf16 bfv2 __attribute__((ext_vector_type(2)));
typedef float f32x2v __attribute__((ext_vector_type(2)));
typedef short s16x4 __attribute__((ext_vector_type(4)));
DEV unsigned cvt2(float a, float b) { return __builtin_bit_cast(unsigned, __builtin_convertvector((f32x2v){a, b}, bfv2)); }
DEV bf16x8 pack_frag(float a0, float a1, float a2, float a3, float a4, float a5, float a6, float a7) {
    u32x4 w; w.x = cvt2(a0, a1); w.y = cvt2(a2, a3); w.z = cvt2(a4, a5); w.w = cvt2(a6, a7);
    return __builtin_bit_cast(bf16x8, w);
}
DEV float sigm(float x) { return 1.f / (1.f + expf(-x)); }
DEV int row_of(int b, int pos) { return pos < NMETA ? MMAIN + b * NMETA + pos : b * SEQ + pos - NMETA; }
DEV float row_rstd(const float* part, int row) {
    const f32x4* pp = (const f32x4*)(part + (size_t)row * 16);
    f32x4 a = pp[0], b = pp[1], c = pp[2], d = pp[3];
    float ss = ((a[0] + a[1]) + (a[2] + a[3])) + ((b[0] + b[1]) + (b[2] + b[3])) + ((c[0] + c[1]) + (c[2] + c[3])) + ((d[0] + d[1]) + (d[2] + d[3]));
    return rsqrtf(ss * (1.0f / 1024.0f) + 1e-6f);
}

DEV void phase_init(CP& p, int bid, int nblk) {
    const int lane = tid_() & 63, wave = tid_() >> 6;
    for (int r = bid * 8 + wave; r < MP; r += nblk * 8) {
        const float* src = nullptr;
        if (r < MMAIN) src = p.x + (size_t)r * DM;
        else if (r < MTOK) src = p.meta + (size_t)((r - MMAIN) & 15) * DM;
        float ss = 0.f;
#pragma unroll
        for (int i = 0; i < 4; ++i) {
            const int c = (i * 64 + lane) * 4;
            f32x4 v = src ? *(const f32x4*)(src + c) : (f32x4){0.f, 0.f, 0.f, 0.f};
            *(f32x4*)(p.h + (size_t)r * DM + c) = v;
            u32x2 w; w.x = pack2(v[0], v[1]); w.y = pack2(v[2], v[3]);
            *(u32x2*)(p.hb + (size_t)r * DM + c) = w;
            ss += v[0] * v[0] + v[1] * v[1] + v[2] * v[2] + v[3] * v[3];
        }
        ss = wave_sum(ss);
        if (lane < 16) p.part[(size_t)r * 16 + lane] = lane == 0 ? ss : 0.f;
    }
    for (int i = bid * 512 + tid_(); i < NB * 6 * 64 * (LPV - LT); i += nblk * 512) p.vt[(size_t)(i >> 4) * LPV + LT + (i & 15)] = 0;
}

struct ConvDesc { const float* W; const float* g; bf16_t* dst; int K, N, swz, kt, nt; };
DEV ConvDesc conv_desc(CP& p, int l, int grp, int idx) {
    ConvDesc d;
    int t = idx;
    if (grp == 0) {
        if (t < 1408) { d.W = p.ffn1_w13 + (size_t)l * DM * 2 * DFF; d.g = p.ffn1_norm + l * DM; d.dst = p.W13a; d.K = DM; d.N = 2 * DFF; d.swz = 1; d.kt = t / 88; d.nt = t % 88; return d; }
        t -= 1408;
        if (t < 704) { d.W = p.ffn1_w2 + (size_t)l * DFF * DM; d.g = nullptr; d.dst = p.W2a; d.K = DFF; d.N = DM; d.swz = 0; d.kt = t / 16; d.nt = t % 16; return d; }
        t -= 704;
        if (t < 768) { d.W = p.w_in + (size_t)l * DM * DIN; d.g = p.mix_norm + l * DM; d.dst = p.Win; d.K = DM; d.N = DIN; d.swz = 0; d.kt = t / 48; d.nt = t % 48; return d; }
        t -= 768;
        d.g = nullptr; d.N = DRW; d.swz = 0;
        if (t < 6) { d.W = p.rwkv_wB + (size_t)l * 64 * DRW; d.dst = p.Wl; d.K = 64; d.kt = 0; d.nt = t; return d; }
        if (t < 12) { d.W = p.rwkv_aB + (size_t)l * 64 * DRW; d.dst = p.Wl + DRW * 64; d.K = 64; d.kt = 0; d.nt = t - 6; return d; }
        d.W = p.rwkv_gB + (size_t)l * 128 * DRW; d.dst = p.Wl + DRW * 128; d.K = 128; d.kt = (t - 12) / 6; d.nt = (t - 12) % 6; return d;
    }
    if (t < 256) { d.W = p.w_out + (size_t)l * DM * DM; d.g = nullptr; d.dst = p.Wout; d.K = DM; d.N = DM; d.swz = 0; d.kt = t / 16; d.nt = t % 16; return d; }
    t -= 256;
    if (t < 1408) { d.W = p.ffn2_w13 + (size_t)l * DM * 2 * DFF; d.g = p.ffn2_norm + l * DM; d.dst = p.W13b; d.K = DM; d.N = 2 * DFF; d.swz = 1; d.kt = t / 88; d.nt = t % 88; return d; }
    t -= 1408;
    d.W = p.ffn2_w2 + (size_t)l * DFF * DM; d.g = nullptr; d.dst = p.W2b; d.K = DFF; d.N = DM; d.swz = 0; d.kt = t / 16; d.nt = t % 16; return d;
}
constexpr int CONV_A = 2904, CONV_B = 2368;
DEV void conv_load(const ConvDesc& d, int tid, f32x4 (&v)[2]) {
#pragma unroll
    for (int i = 0; i < 2; ++i) {
        const int idx = tid + i * 512, kk = idx >> 4, n4 = (idx & 15) * 4;
        v[i] = *(const f32x4*)(d.W + (size_t)(d.kt * 64 + kk) * d.N + d.nt * 64 + n4);
        if (d.g) v[i] *= d.g[d.kt * 64 + kk];
    }
}
DEV void phase_convert(CP& p, int l, int grp, int bid, int nblk, float* tile) {
    const int tid = tid_(), total = grp == 0 ? CONV_A : CONV_B;
    if (bid >= total) return;
    f32x4 v[2];
    ConvDesc d = conv_desc(p, l, grp, bid);
    conv_load(d, tid, v);
    for (int it = bid; it < total; it += nblk) {
#pragma unroll
        for (int i = 0; i < 2; ++i) {
            const int idx = tid + i * 512, kk = idx >> 4, n4 = (idx & 15) * 4;
#pragma unroll
            for (int j = 0; j < 4; ++j) tile[kk * 65 + n4 + j] = v[i][j];
        }
        __syncthreads();
        const ConvDesc dc = d;
        if (it + nblk < total) { d = conv_desc(p, l, grp, it + nblk); conv_load(d, tid, v); }
        {
            const int nn = tid >> 3, kc = (tid & 7) * 8;
            const int sc = dc.nt * 64 + nn;
            int nd = sc;
            if (dc.swz) { const int bj = sc >= DFF ? 1 : 0; const int j = sc - bj * DFF; nd = (j >> 7) * 256 + bj * 128 + (j & 127); }
            u32x4 w;
            w.x = cvt2(tile[(kc + 0) * 65 + nn], tile[(kc + 1) * 65 + nn]); w.y = cvt2(tile[(kc + 2) * 65 + nn], tile[(kc + 3) * 65 + nn]);
            w.z = cvt2(tile[(kc + 4) * 65 + nn], tile[(kc + 5) * 65 + nn]); w.w = cvt2(tile[(kc + 6) * 65 + nn], tile[(kc + 7) * 65 + nn]);
            *(u32x4*)(dc.dst + (size_t)nd * dc.K + dc.kt * 64 + kc) = w;
        }
        __syncthreads();
    }
}

enum { EPI_SWIGLU = 0, EPI_RESID = 1, EPI_P = 2 };

DEV void epi_swiglu(CP& p, int row, int colh, f32x4 g, f32x4 u, float rs) {
    float o[4];
#pragma unroll
    for (int e = 0; e < 4; ++e) { const float gg = g[e] * rs, uu = u[e] * rs; o[e] = gg * sigm(gg) * uu; }
    u32x2 w; w.x = pack2(o[0], o[1]); w.y = pack2(o[2], o[3]);
    *(u32x2*)(p.big + (size_t)row * DFF + colh) = w;
}
DEV float epi_resid(CP& p, int row, int col, f32x4 a, float scale) {
    float* hp = p.h + (size_t)row * DM + col;
    f32x4 hv = *(const f32x4*)hp;
    hv += a * scale;
    *(f32x4*)hp = hv;
    u32x2 w; w.x = pack2(hv[0], hv[1]); w.y = pack2(hv[2], hv[3]);
    *(u32x2*)(p.hb + (size_t)row * DM + col) = w;
    return hv[0] * hv[0] + hv[1] * hv[1] + hv[2] * hv[2] + hv[3] * hv[3];
}
DEV void epi_p(CP& p, int row, int col, f32x4 a, float rs) {
    a *= rs;
    u32x2 w; w.x = pack2(a[0], a[1]); w.y = pack2(a[2], a[3]);
    *(u32x2*)(p.big + (size_t)row * DIN + col) = w;
    if (col >= C_V && row < MTOK) {
        const int hh = (col - C_V) >> 6, d = (col - C_V) & 63;
        int b, pos;
        if (row < MMAIN) { b = row >> 11; pos = (row & 2047) + NMETA; } else { b = (row - MMAIN) >> 4; pos = (row - MMAIN) & 15; }
        bf16_t* vp = p.vt + ((size_t)((b * 6 + hh) * 64 + d)) * LPV + pos;
#pragma unroll
        for (int e = 0; e < 4; ++e) vp[(size_t)e * LPV] = f2bf(a[e]);
    }
}

template <int EPI>
DEV void gemm_v0(CP& p, const bf16_t* __restrict__ A, const bf16_t* __restrict__ Bt, int row_begin, int row_end, int N, int K, float scale, int bid, int nblk) {
    const int lane = tid_() & 63, wave = tid_() >> 6, fr = lane & 15, fq = lane >> 4;
    const int nt = N / 64, total = ((row_end - row_begin) / 32) * nt;
    for (int u = bid * 8 + wave; u < total; u += nblk * 8) {
        const int mu = u / nt, nu = u % nt, row0 = row_begin + mu * 32;
        const int cb = (EPI == EPI_SWIGLU) ? ((nu >> 2) * 256 + (nu & 3) * 32) : nu * 64;
        f32x4 acc[2][4];
#pragma unroll
        for (int i = 0; i < 2; ++i)
#pragma unroll
            for (int j = 0; j < 4; ++j) acc[i][j] = (f32x4){0.f, 0.f, 0.f, 0.f};
        const bf16_t* ap = A + (size_t)(row0 + fr) * K + fq * 8;
        const bf16_t* bp = Bt + (size_t)(cb + fr) * K + fq * 8;
#pragma unroll 2
        for (int k0 = 0; k0 < K; k0 += 32) {
            const bf16x8 a0 = *(const bf16x8*)(ap + k0), a1 = *(const bf16x8*)(ap + (size_t)16 * K + k0);
#pragma unroll
            for (int j = 0; j < 4; ++j) {
                const int co = (EPI == EPI_SWIGLU) ? ((j & 1) * 16 + (j >> 1) * 128) : j * 16;
                const bf16x8 b = *(const bf16x8*)(bp + (size_t)co * K + k0);
                acc[0][j] = __builtin_amdgcn_mfma_f32_16x16x32_bf16(b, a0, acc[0][j], 0, 0, 0);
                acc[1][j] = __builtin_amdgcn_mfma_f32_16x16x32_bf16(b, a1, acc[1][j], 0, 0, 0);
            }
        }
#pragma unroll
        for (int i = 0; i < 2; ++i) {
            const int row = row0 + 16 * i + fr;
            if (EPI == EPI_SWIGLU) {
                const float rs = row_rstd(p.part, row);
                const int colh = (nu >> 2) * 128 + (nu & 3) * 32 + 4 * fq;
                epi_swiglu(p, row, colh, acc[i][0], acc[i][2], rs);
                epi_swiglu(p, row, colh + 16, acc[i][1], acc[i][3], rs);
            } else if (EPI == EPI_RESID) {
                float ss = 0.f;
#pragma unroll
                for (int j = 0; j < 4; ++j) ss += epi_resid(p, row, cb + 16 * j + 4 * fq, acc[i][j], scale);
                ss += __shfl_xor(ss, 16); ss += __shfl_xor(ss, 32);
                if (fq == 0) p.part[(size_t)row * 16 + nu] = ss;
            } else {
                const float rs = row_rstd(p.part, row);
#pragma unroll
                for (int j = 0; j < 4; ++j) epi_p(p, row, cb + 16 * j + 4 * fq, acc[i][j], rs);
            }
        }
    }
}

template <int EPI>
DEV void gemm_meta(CP& p, const bf16_t* __restrict__ A, const bf16_t* __restrict__ Bt, int N, int K, float scale, int bid, int nblk, float* lds) {
    const int tid = tid_(), lane = tid & 63, wave = tid >> 6, fr = lane & 15, fq = lane >> 4;
    const int nt = N / 64, total = 4 * nt, kw = K / 8;
    float* red = lds + 8 * 8 * 64 * 4;
    for (int u = bid; u < total; u += nblk) {
        const int mu = u / nt, nu = u % nt, row0 = MMAIN + mu * 32;
        const int cb = (EPI == EPI_SWIGLU) ? ((nu >> 2) * 256 + (nu & 3) * 32) : nu * 64;
        f32x4 acc[2][4];
#pragma unroll
        for (int i = 0; i < 2; ++i)
#pragma unroll
            for (int j = 0; j < 4; ++j) acc[i][j] = (f32x4){0.f, 0.f, 0.f, 0.f};
        const bf16_t* ap = A + (size_t)(row0 + fr) * K + wave * kw + fq * 8;
        const bf16_t* bp = Bt + (size_t)(cb + fr) * K + wave * kw + fq * 8;
        for (int k0 = 0; k0 < kw; k0 += 32) {
            const bf16x8 a0 = *(const bf16x8*)(ap + k0), a1 = *(const bf16x8*)(ap + (size_t)16 * K + k0);
#pragma unroll
            for (int j = 0; j < 4; ++j) {
                const int co = (EPI == EPI_SWIGLU) ? ((j & 1) * 16 + (j >> 1) * 128) : j * 16;
                const bf16x8 bv = *(const bf16x8*)(bp + (size_t)co * K + k0);
                acc[0][j] = __builtin_amdgcn_mfma_f32_16x16x32_bf16(bv, a0, acc[0][j], 0, 0, 0);
                acc[1][j] = __builtin_amdgcn_mfma_f32_16x16x32_bf16(bv, a1, acc[1][j], 0, 0, 0);
            }
        }
#pragma unroll
        for (int i = 0; i < 2; ++i)
#pragma unroll
            for (int j = 0; j < 4; ++j) *(f32x4*)(lds + ((wave * 8 + i * 4 + j) * 64 + lane) * 4) = acc[i][j];
        __syncthreads();
        {
            f32x4 sum = (f32x4){0.f, 0.f, 0.f, 0.f};
#pragma unroll
            for (int w = 0; w < 8; ++w) sum += *(const f32x4*)(lds + ((w * 8 + wave) * 64 + lane) * 4);
            *(f32x4*)(red + (wave * 64 + lane) * 4) = sum;
        }
        __syncthreads();
        if (wave < 2) {
            const int i = wave, row = row0 + 16 * i + fr;
            f32x4 a[4];
#pragma unroll
            for (int j = 0; j < 4; ++j) a[j] = *(const f32x4*)(red + ((i * 4 + j) * 64 + lane) * 4);
            if (EPI == EPI_SWIGLU) {
                const float rs = row_rstd(p.part, row);
                const int colh = (nu >> 2) * 128 + (nu & 3) * 32 + 4 * fq;
                epi_swiglu(p, row, colh, a[0], a[2], rs);
                epi_swiglu(p, row, colh + 16, a[1], a[3], rs);
            } else if (EPI == EPI_RESID) {
                float ss = 0.f;
#pragma unroll
                for (int j = 0; j < 4; ++j) ss += epi_resid(p, row, cb + 16 * j + 4 * fq, a[j], scale);
                ss += __shfl_xor(ss, 16); ss += __shfl_xor(ss, 32);
                if (fq == 0) p.part[(size_t)row * 16 + nu] = ss;
            } else {
                const float rs = row_rstd(p.part, row);
#pragma unroll
                for (int j = 0; j < 4; ++j) epi_p(p, row, cb + 16 * j + 4 * fq, a[j], rs);
            }
        }
        __syncthreads();
    }
}

namespace pg8 {
#define PG8_LAS __attribute__((address_space(3)))
typedef unsigned short bf16_t;
typedef short bf16x8 __attribute__((ext_vector_type(8)));
typedef float f32x4 __attribute__((ext_vector_type(4)));
typedef unsigned u32x4 __attribute__((ext_vector_type(4)));
constexpr int BM = 256, BK = 64, HALF = 128, HTB = HALF * BK * 2  , STAGE_BYTES = 8 * HTB, NXCD = 8, WGM = 8;

__host__ __device__ __forceinline__ int lds_byte(int r, int c) { const int st = (r >> 4) * 2 + (c >> 5), rr = r & 15, cc = c & 31, ob = rr * 64 + cc * 2; return st * 1024 + (ob ^ (((ob >> 9) & 1) << 5)); }
__host__ __device__ __forceinline__ void stage_rc(int b, int& R, int& C) { const int st = b / 1024, sb = b % 1024, swz = sb ^ (((sb >> 9) & 1) << 5); R = (st >> 1) * 16 + swz / 64; C = (st & 1) * 32 + (swz % 64) / 2; }
__host__ __device__ __forceinline__ int perm32(int rho) { const int n = rho >> 4, i = rho & 15; return 8 * (i >> 2) + 4 * n + (i & 3); }

struct Unit { int pm, pn; };
struct Gemm { const bf16_t* A; const bf16_t* Bt; int M, N, K; };

struct StaticOrder {
    int nM, nN, nwg, G, c;
    __host__ __device__ void init(int M, int N, int G_, int c_) { nM = M / BM; nN = N / BM; nwg = nM * nN; G = G_; c = c_; }
    __host__ __device__ bool next(int i, Unit& u) const {
        const long L = (long)i * G + c; if (L >= nwg) return false;
        int wgid = (int)L; { const int q = nwg / NXCD, r = nwg % NXCD, xcd = wgid % NXCD, off = wgid / NXCD; wgid = (xcd < r ? xcd * (q + 1) : r * (q + 1) + (xcd - r) * q) + off; }
        const int nig = WGM * nN, gid = wgid / nig, fm = gid * WGM, gsz = (nM - fm) < WGM ? (nM - fm) : WGM;
        u.pm = fm + ((wgid % nig) % gsz); u.pn = (wgid % nig) / gsz; return true;
    }
    __device__ __forceinline__ void a_ready(const Unit&) const {}
    __device__ __forceinline__ void done(const Unit&) const {}
};
__device__ __forceinline__ unsigned cvt_pk_bf16(float lo, float hi) { unsigned r; asm volatile("v_cvt_pk_bf16_f32 %0, %1, %2" : "=v"(r) : "v"(lo), "v"(hi)); return r; }
template <class Epi, class Sched, bool STAMP = false>
__device__ __forceinline__ void gemm_phase(PG8_LAS unsigned char* lds, const Gemm g, const Sched& S, const Epi& E, unsigned long long* stamps) {
    const int tid = tid_(), wid = __builtin_amdgcn_readfirstlane(tid >> 6), lane = tid & 63, wr = wid >> 2, wc = wid & 3, fr = lane & 15, fq = lane >> 4;
    const int K = g.K, nt = K / BK;
    int ts_lo = 0, ts_hi = 0, nts = 0; const unsigned long long rt_entry = STAMP ? (unsigned long long)wall_clock64() : 0ull;
#define PG8_STAMP() do { if (STAMP && wid == 0 && nts < 64) { const unsigned long long _c = (unsigned long long)clock64(); \
        ts_lo = (lane == nts) ? (int)(unsigned)_c : ts_lo; ts_hi = (lane == nts) ? (int)(unsigned)(_c >> 32) : ts_hi; ++nts; } } while (0)
    PG8_STAMP();
    unsigned voffA[2], voffB[2];
#pragma unroll
    for (int i = 0; i < 2; ++i) { int R, C; stage_rc(tid * 16 + i * 8192, R, C); const int Rb = Epi::PERM ? ((R & ~31) + perm32(R & 31)) : R;
        voffA[i] = (unsigned)(R * K + C) * 2u; voffB[i] = (unsigned)(Rb * K + C) * 2u; }
    const size_t kstep = (size_t)(BK * 2);
    const size_t hstep = (size_t)HALF * K * 2;
    const size_t tstep = 2 * hstep;
    const unsigned ldsw = (unsigned)wid * 1024u;
    const int aoff = lds_byte(wr * 64 + fr, fq * 8), boff = lds_byte(wc * 32 + fr, fq * 8);
#define PG8_SA(b, h) (((b) * 2 + (h)) * HTB)
#define PG8_SB(b, h) ((4 + (b) * 2 + (h)) * HTB)
#define PG8_STAGE(bufoff, gbase, voff) do { _Pragma("unroll") for (int _i = 0; _i < 2; ++_i) \
        __builtin_amdgcn_global_load_lds((const unsigned*)((const char*)(gbase) + (voff)[_i]), (PG8_LAS unsigned*)(lds + (bufoff) + ldsw + _i * 8192), 16, 0, 0); } while (0)
#define PG8_LDA(dst, b, h) do { _Pragma("unroll") for (int m = 0; m < 4; ++m) _Pragma("unroll") for (int k = 0; k < 2; ++k) dst[m][k] = *(const PG8_LAS bf16x8*)(lds + PG8_SA(b, h) + aoff + m * 2048 + k * 1024); } while (0)
#define PG8_LDB(dst, b, h) do { _Pragma("unroll") for (int n = 0; n < 2; ++n) _Pragma("unroll") for (int k = 0; k < 2; ++k) dst[n][k] = *(const PG8_LAS bf16x8*)(lds + PG8_SB(b, h) + boff + n * 2048 + k * 1024); } while (0)
#define PG8_MMA(ai, bj, At, Bt) do { __builtin_amdgcn_s_setprio(1); _Pragma("unroll") for (int m = 0; m < 4; ++m) _Pragma("unroll") for (int n = 0; n < 2; ++n) _Pragma("unroll") for (int k = 0; k < 2; ++k) \
        acc[ai][bj][m][n] = __builtin_amdgcn_mfma_f32_16x16x32_bf16(Bt[n][k], At[m][k], acc[ai][bj][m][n], 0, 0, 0); __builtin_amdgcn_s_setprio(0); } while (0)
#define PG8_WAIT_V(n) asm volatile("s_waitcnt vmcnt(" #n ")" ::: "memory")
#define PG8_WAIT_L(n) asm volatile("s_waitcnt lgkmcnt(" #n ")" ::: "memory")
#define PG8_BAR __builtin_amdgcn_s_barrier()
#define PG8_SCHED __builtin_amdgcn_sched_barrier(0)
    Unit cur, nxt; int ui = 0;
    if (!S.next(0, cur)) return;
    f32x4 acc[2][2][4][2];
#pragma unroll
    for (int a = 0; a < 2; ++a)
#pragma unroll
        for (int b = 0; b < 2; ++b)
#pragma unroll
            for (int m = 0; m < 4; ++m)
#pragma unroll
                for (int n = 0; n < 2; ++n) acc[a][b][m][n] = (f32x4){0.f, 0.f, 0.f, 0.f};
    bf16x8 At[4][2], B0[2][2], B1[2][2];
    const char* cA = (const char*)g.A + (size_t)cur.pm * tstep; const char* cB = (const char*)g.Bt + (size_t)cur.pn * tstep;
    S.a_ready(cur);
    PG8_STAGE(PG8_SB(0, 0), cB, voffB); PG8_STAGE(PG8_SA(0, 0), cA, voffA); PG8_STAGE(PG8_SB(0, 1), cB + hstep, voffB); PG8_STAGE(PG8_SA(0, 1), cA + hstep, voffA);
    if (wr == 1) PG8_BAR;
    PG8_WAIT_V(4); PG8_BAR;
    PG8_STAGE(PG8_SB(1, 0), cB + kstep, voffB); PG8_STAGE(PG8_SA(1, 0), cA + kstep, voffA); PG8_STAGE(PG8_SB(1, 1), cB + hstep + kstep, voffB);
    PG8_WAIT_V(6); PG8_BAR;
    PG8_STAMP();
    for (;;) {
        const bool has_next = S.next(ui + 1, nxt);
        const char* nA = has_next ? (const char*)g.A + (size_t)nxt.pm * tstep : cA; const char* nB = has_next ? (const char*)g.Bt + (size_t)nxt.pn * tstep : cB;
        for (int t = 0; t < nt; t += 2) {
            const bool last = (t == nt - 2);
            const char* a1 = cA + (size_t)(t + 1) * kstep;
            const char* a2 = last ? nA : cA + (size_t)(t + 2) * kstep; const char* b2 = last ? nB : cB + (size_t)(t + 2) * kstep;
            const char* a3 = a2 + kstep; const char* b3 = b2 + kstep;
            if (last && has_next) S.a_ready(nxt);
            PG8_LDB(B0, 0, 0); PG8_SCHED; PG8_LDA(At, 0, 0); PG8_STAGE(PG8_SA(1, 1), a1 + hstep, voffA);
            PG8_WAIT_L(8); PG8_BAR; PG8_WAIT_L(0); PG8_MMA(0, 0, At, B0); PG8_BAR; PG8_SCHED;
            PG8_LDB(B1, 0, 1); PG8_STAGE(PG8_SB(0, 0), b2, voffB);
            PG8_BAR; PG8_WAIT_L(0); PG8_MMA(0, 1, At, B1); PG8_BAR;
            PG8_LDA(At, 0, 1); PG8_STAGE(PG8_SA(0, 0), a2, voffA);
            PG8_BAR; PG8_WAIT_L(0); PG8_MMA(1, 0, At, B0); PG8_BAR; PG8_SCHED;
            PG8_STAGE(PG8_SB(0, 1), b2 + hstep, voffB);
            PG8_WAIT_V(6); PG8_BAR; PG8_MMA(1, 1, At, B1); PG8_BAR;
            PG8_LDB(B0, 1, 0); PG8_SCHED; PG8_LDA(At, 1, 0); PG8_STAGE(PG8_SA(0, 1), a2 + hstep, voffA);
            PG8_WAIT_L(8); PG8_BAR; PG8_WAIT_L(0); PG8_MMA(0, 0, At, B0); PG8_BAR; PG8_SCHED;
            PG8_LDB(B1, 1, 1); PG8_STAGE(PG8_SB(1, 0), b3, voffB);
            PG8_BAR; PG8_WAIT_L(0); PG8_MMA(0, 1, At, B1); PG8_BAR;
            PG8_LDA(At, 1, 1); PG8_STAGE(PG8_SA(1, 0), a3, voffA);
            PG8_BAR; PG8_WAIT_L(0); PG8_MMA(1, 0, At, B0); PG8_BAR; PG8_SCHED;
            PG8_STAGE(PG8_SB(1, 1), b3 + hstep, voffB);
            PG8_WAIT_V(6); PG8_BAR; PG8_MMA(1, 1, At, B1); PG8_BAR;
        }
        PG8_STAMP();
        if constexpr (!Epi::AFTER_DRAIN) { E(acc, cur, wr, wc, fr, fq); S.done(cur); }
        PG8_STAMP();
        if (!has_next) break;
#pragma unroll
        for (int a = 0; a < 2; ++a)
#pragma unroll
            for (int b = 0; b < 2; ++b)
#pragma unroll
                for (int m = 0; m < 4; ++m)
#pragma unroll
                    for (int n = 0; n < 2; ++n) acc[a][b][m][n] = (f32x4){0.f, 0.f, 0.f, 0.f};
        cur = nxt; cA = nA; cB = nB; ++ui;
    }
    PG8_WAIT_V(0);
    if (wr == 0) PG8_BAR;
    PG8_BAR;
    if constexpr (Epi::AFTER_DRAIN) { E.fused(acc, cur, wr, wc, fr, fq, lds, wid, lane); S.done(cur); }
    PG8_STAMP();
    if (STAMP && wid == 0) { stamps[lane] = lane < nts ? (((unsigned long long)(unsigned)ts_hi << 32) | (unsigned)ts_lo) : 0ull;
        if (lane == 62) stamps[62] = rt_entry; if (lane == 63) stamps[63] = (unsigned long long)wall_clock64(); }
#undef PG8_STAMP
#undef PG8_SA
#undef PG8_SB
#undef PG8_STAGE
#undef PG8_LDA
#undef PG8_LDB
#undef PG8_MMA
#undef PG8_WAIT_V
#undef PG8_WAIT_L
#undef PG8_BAR
#undef PG8_SCHED
}
}

DEV float fsig(float x) { return __builtin_amdgcn_rcpf(1.f + __expf(-x)); }
DEV u32x4 pack8(f32x4 a, f32x4 b) { u32x4 w; w.x = pg8::cvt_pk_bf16(a[0], a[1]); w.y = pg8::cvt_pk_bf16(a[2], a[3]); w.z = pg8::cvt_pk_bf16(b[0], b[1]); w.w = pg8::cvt_pk_bf16(b[2], b[3]); return w; }

DEV float row_rstd_q(const float* part, int row, int fq) {
    const f32x4 a = *(const f32x4*)(part + (size_t)row * 16 + fq * 4);
    float ss = (a[0] + a[1]) + (a[2] + a[3]);
    ss += __shfl_xor(ss, 16); ss += __shfl_xor(ss, 32);
    return rsqrtf(ss * (1.0f / 1024.0f) + 1e-6f);
}
struct EpiSwiglu {
    static constexpr bool PERM = true, AFTER_DRAIN = false;
    bf16_t* hid; const float* part;
    __device__ __forceinline__ void operator()(const f32x4 (&acc)[2][2][4][2], const pg8::Unit& u, int wr, int wc, int fr, int fq) const {
#pragma unroll
        for (int ai = 0; ai < 2; ++ai)
#pragma unroll
            for (int m = 0; m < 4; ++m) {
                __builtin_amdgcn_sched_barrier(0);
                const int row = u.pm * 256 + ai * 128 + wr * 64 + m * 16 + fr;
                const float rs = row_rstd_q(part, row, fq);
                f32x4 o[2];
#pragma unroll
                for (int n = 0; n < 2; ++n)
#pragma unroll
                    for (int e = 0; e < 4; ++e) { const float g = acc[ai][0][m][n][e] * rs, up = acc[ai][1][m][n][e] * rs; o[n][e] = g * fsig(g) * up; }
                *(u32x4*)(hid + (size_t)row * DFF + u.pn * 128 + wc * 32 + fq * 8) = pack8(o[0], o[1]);
            }
    }
};
struct EpiResid {
    static constexpr bool PERM = true, AFTER_DRAIN = false;
    float* h; bf16_t* hb; float* part; float scale;
    __device__ __forceinline__ void operator()(const f32x4 (&acc)[2][2][4][2], const pg8::Unit& u, int wr, int wc, int fr, int fq) const {
#pragma unroll
        for (int ai = 0; ai < 2; ++ai)
#pragma unroll
            for (int m = 0; m < 4; ++m) {
                __builtin_amdgcn_sched_barrier(0);
                const int row = u.pm * 256 + ai * 128 + wr * 64 + m * 16 + fr;
                float ss = 0.f;
#pragma unroll
                for (int bj = 0; bj < 2; ++bj) {
                    const int col = u.pn * 256 + bj * 128 + wc * 32 + fq * 8;
                    float* hp = h + (size_t)row * DM + col;
                    f32x4 h0 = *(const f32x4*)hp, h1 = *(const f32x4*)(hp + 4);
                    h0 += acc[ai][bj][m][0] * scale; h1 += acc[ai][bj][m][1] * scale;
                    *(f32x4*)hp = h0; *(f32x4*)(hp + 4) = h1;
                    *(u32x4*)(hb + (size_t)row * DM + col) = pack8(h0, h1);
                    ss += (h0[0] * h0[0] + h0[1] * h0[1]) + (h0[2] * h0[2] + h0[3] * h0[3]) + (h1[0] * h1[0] + h1[1] * h1[1]) + (h1[2] * h1[2] + h1[3] * h1[3]);
                }
                ss += __shfl_xor(ss, 16); ss += __shfl_xor(ss, 32);
                if (fq == 0) part[(size_t)row * 16 + u.pn * 4 + wc] = ss;
            }
    }
};
struct EpiP {
    static constexpr bool PERM = true, AFTER_DRAIN = false;
    bf16_t* big; bf16_t* vt; const float* part;
    __device__ __forceinline__ void operator()(const f32x4 (&acc)[2][2][4][2], const pg8::Unit& u, int wr, int wc, int fr, int fq) const {
#pragma unroll
        for (int ai = 0; ai < 2; ++ai)
#pragma unroll
            for (int m = 0; m < 4; ++m) {
                __builtin_amdgcn_sched_barrier(0);
                const int row = u.pm * 256 + ai * 128 + wr * 64 + m * 16 + fr;
                const float rs = row_rstd_q(part, row, fq);
#pragma unroll
                for (int bj = 0; bj < 2; ++bj) {
                    const int col = u.pn * 256 + bj * 128 + wc * 32 + fq * 8;
                    const f32x4 a0 = acc[ai][bj][m][0] * rs, a1 = acc[ai][bj][m][1] * rs;
                    const u32x4 w = pack8(a0, a1);
                    *(u32x4*)(big + (size_t)row * DIN + col) = w;
                    if (col >= C_V && row < MTOK) {
                        const int hh = (col - C_V) >> 6, d = (col - C_V) & 63;
                        int b, pos;
                        if (row < MMAIN) { b = row >> 11; pos = (row & 2047) + NMETA; } else { b = (row - MMAIN) >> 4; pos = (row - MMAIN) & 15; }
                        bf16_t* vp = vt + ((size_t)((b * 6 + hh) * 64 + d)) * LPV + pos;
#pragma unroll
                        for (int e = 0; e < 4; ++e) { vp[(size_t)(2 * e) * LPV] = (bf16_t)(w[e] & 0xFFFFu); vp[(size_t)(2 * e + 1) * LPV] = (bf16_t)(w[e] >> 16); }
                    }
                }
            }
    }
};
template <class Epi>
DEV void gemm_big(const bf16_t* A, const bf16_t* Bt, int M, int N, int K, const Epi& E, int bid, int nblk, unsigned char* smem) {
    pg8::StaticOrder S; S.init(M, N, nblk, bid);
    const pg8::Gemm g{A, Bt, M, N, K};
    pg8::gemm_phase<Epi, pg8::StaticOrder, false>((PG8_LAS unsigned char*)smem, g, S, E, nullptr);
}

DEV void phase_conv(CP& p, int l, int bid, int nblk, float* lds) {
    float* cS = lds;
    float* yS = lds + 46 * 256;
    const int tid = tid_(), ch = tid & 255, half = tid >> 8, lane = tid & 63, wave = tid >> 6;
    float wreg[31];
#pragma unroll
    for (int j = 0; j < 31; ++j) wreg[j] = p.conv_w[(size_t)l * 31 * 256 + j * 256 + ch];
    const float cb = p.conv_b[l * 256 + ch];
    for (int it = bid; it < NB * 129; it += nblk) {
        const int b = it / 129, p0 = (it % 129) * 16;
        __syncthreads();
#pragma unroll
        for (int q = 0; q < 3; ++q) {
            const int e = tid + q * 512;
            if (e < 46 * 32) {
                const int pp = e >> 5, c8 = (e & 31) * 8, pos = p0 - 30 + pp;
                f32x4 o0 = (f32x4){0.f, 0.f, 0.f, 0.f}, o1 = o0;
                if (pos >= 0) {
                    const bf16_t* rp = p.big + (size_t)row_of(b, pos) * DIN + c8;
                    const u32x4 vw = *(const u32x4*)rp, gw = *(const u32x4*)(rp + 256);
#pragma unroll
                    for (int j = 0; j < 2; ++j) {
                        o0[2 * j] = __uint_as_float(vw[j] << 16) * fsig(__uint_as_float(gw[j] << 16));
                        o0[2 * j + 1] = __uint_as_float(vw[j] & 0xFFFF0000u) * fsig(__uint_as_float(gw[j] & 0xFFFF0000u));
                        o1[2 * j] = __uint_as_float(vw[2 + j] << 16) * fsig(__uint_as_float(gw[2 + j] << 16));
                        o1[2 * j + 1] = __uint_as_float(vw[2 + j] & 0xFFFF0000u) * fsig(__uint_as_float(gw[2 + j] & 0xFFFF0000u));
                    }
                }
                *(f32x4*)(cS + pp * 256 + c8) = o0; *(f32x4*)(cS + pp * 256 + c8 + 4) = o1;
            }
        }
        __syncthreads();
#pragma unroll
        for (int i = 0; i < 8; ++i) {
            const int ii = half * 8 + i;
            float acc = cb;
#pragma unroll
            for (int j = 0; j < 31; ++j) acc += wreg[j] * cS[(ii + j) * 256 + ch];
            yS[ii * 256 + ch] = acc;
        }
        __syncthreads();
#pragma unroll
        for (int q = 0; q < 2; ++q) {
            const int ii = wave * 2 + q;
            const f32x4 v = *(const f32x4*)(yS + ii * 256 + lane * 4);
            const float mu = wave_sum_fast((v[0] + v[1]) + (v[2] + v[3])) * (1.f / 256.f);
            const f32x4 d = v - mu;
            const float var = wave_sum_fast(d[0] * d[0] + d[1] * d[1] + d[2] * d[2] + d[3] * d[3]) * (1.f / 256.f);
            const float rs = rsqrtf(var + 1e-5f);
            const f32x4 g = *(const f32x4*)(p.conv_ln_g + l * 256 + lane * 4), bb = *(const f32x4*)(p.conv_ln_b + l * 256 + lane * 4);
            float o[4];
#pragma unroll
            for (int e = 0; e < 4; ++e) { const float yn = d[e] * rs * g[e] + bb[e]; o[e] = yn * sigm(yn); }
            u32x2 w; w.x = pack2(o[0], o[1]); w.y = pack2(o[2], o[3]);
            *(u32x2*)(p.y + (size_t)row_of(b, p0 + ii) * DM + lane * 4) = w;
        }
    }
}

DEV void phase_rwkv_prep(CP& p, int l, int bid, int nblk, float* lds) {
    bf16_t* X = (bf16_t*)lds;
    constexpr int XS = 264;
    const int tid = tid_(), lane = tid & 63, wave = tid >> 6, fr = lane & 15, fq = lane >> 4;
    const float* mu = p.rwkv_mu + (size_t)l * 1408;
    for (int it = bid; it < MTOK / 64; it += nblk) {
        __syncthreads();
        {
            const int rr = tid >> 3, c0 = (tid & 7) * 32, row = it * 64 + rr;
            int b, pos;
            if (row < MMAIN) { b = row >> 11; pos = (row & 2047) + NMETA; } else { b = (row - MMAIN) >> 4; pos = (row - MMAIN) & 15; }
            const bf16_t* cp = p.big + (size_t)row * DIN + C_RW + 1152 + c0;
            const bf16_t* pp = p.big + (size_t)row_of(b, pos > 0 ? pos - 1 : 0) * DIN + C_RW + 1152 + c0;
#pragma unroll
            for (int q = 0; q < 4; ++q) {
                const u32x4 cw = *(const u32x4*)(cp + q * 8);
                u32x4 pw = *(const u32x4*)(pp + q * 8);
                if (pos == 0) pw = (u32x4){0u, 0u, 0u, 0u};
                const int c = c0 + q * 8;
                const f32x4 m0 = *(const f32x4*)(mu + 1152 + c), m1 = *(const f32x4*)(mu + 1152 + c + 4);
                float xs[8];
#pragma unroll
                for (int j = 0; j < 4; ++j) {
                    const float a0 = __uint_as_float(cw[j] << 16), a1 = __uint_as_float(cw[j] & 0xFFFF0000u);
                    const float q0 = __uint_as_float(pw[j] << 16), q1 = __uint_as_float(pw[j] & 0xFFFF0000u);
                    const float ma = j < 2 ? m0[2 * j] : m1[2 * j - 4], mb = j < 2 ? m0[2 * j + 1] : m1[2 * j - 3];
                    xs[2 * j] = a0 + ma * (q0 - a0); xs[2 * j + 1] = a1 + mb * (q1 - a1);
                }
#pragma unroll
                for (int j = 0; j < 8; ++j) { if (c < 64) xs[j] = tanhf(xs[j]); else if (c >= 128) xs[j] = fsig(xs[j]); }
                u32x4 w; w.x = cvt2(xs[0], xs[1]); w.y = cvt2(xs[2], xs[3]); w.z = cvt2(xs[4], xs[5]); w.w = cvt2(xs[6], xs[7]);
                *(u32x4*)(X + rr * XS + c) = w;
            }
        }
        __syncthreads();
        const int rt = wave & 3, chalf = wave >> 2;
        bf16x8 af[8];
#pragma unroll
        for (int ks = 0; ks < 8; ++ks) af[ks] = *(const bf16x8*)(X + (rt * 16 + fr) * XS + ks * 32 + fq * 8);
        const int row = it * 64 + rt * 16 + fr;
        for (int nt = chalf * 12; nt < chalf * 12 + 12; ++nt) {
            const bf16_t* wb = p.Wl + (size_t)(nt * 16 + fr) * 64 + fq * 8;
            const bf16_t* ab = p.Wl + DRW * 64 + (size_t)(nt * 16 + fr) * 64 + fq * 8;
            const bf16_t* gb = p.Wl + DRW * 128 + (size_t)(nt * 16 + fr) * 128 + fq * 8;
            f32x4 cw = (f32x4){0.f, 0.f, 0.f, 0.f}, ca = cw, cg = cw;
#pragma unroll
            for (int ks = 0; ks < 2; ++ks) {
                cw = __builtin_amdgcn_mfma_f32_16x16x32_bf16(*(const bf16x8*)(wb + ks * 32), af[ks], cw, 0, 0, 0);
                ca = __builtin_amdgcn_mfma_f32_16x16x32_bf16(*(const bf16x8*)(ab + ks * 32), af[2 + ks], ca, 0, 0, 0);
            }
#pragma unroll
            for (int ks = 0; ks < 4; ++ks) cg = __builtin_amdgcn_mfma_f32_16x16x32_bf16(*(const bf16x8*)(gb + ks * 32), af[4 + ks], cg, 0, 0, 0);
            const int col = nt * 16 + 4 * fq;
            const f32x4 w0 = *(const f32x4*)(p.rwkv_w0 + l * DRW + col), a0 = *(const f32x4*)(p.rwkv_a0 + l * DRW + col);
            f32x4 olw, oaa;
#pragma unroll
            for (int j = 0; j < 4; ++j) {
                const float xw = -(w0[j] + cw[j]);
                const float sp = fmaxf(xw, 0.f) + __logf(1.f + __expf(-fabsf(xw)));
                olw[j] = -__expf(-sp - 0.5f);
                oaa[j] = fsig(a0[j] + ca[j]);
            }
            const size_t o = (size_t)row * DRW + col;
            *(f32x4*)(p.lw + o) = olw; *(f32x4*)(p.aa + o) = oaa; *(f32x4*)(p.gg + o) = cg;
        }
    }
}

DEV void phase_rwkv_scan(CP& p, int l, int bid, int nblk, float* lds) {
    float* rS = lds;
    float* wS = rS + 1024;
    float* kS = wS + 1024;
    float* vS = kS + 1024;
    float* nS = vS + 1024;
    float* bS = nS + 1024;
    float* gS = bS + 1024;
    float* oS = gS + 1024;
    float* cS = oS + 1024;
    const int tid = tid_(), lane = tid & 63, wave = tid >> 6;
    const int vi = tid >> 3, ks = tid & 7;
    const float* mu = p.rwkv_mu + (size_t)l * 1408;
    for (int it = bid; it < NB * 6; it += nblk) {
        const int b = it / 6, hh = it % 6;
        float S[8];
#pragma unroll
        for (int i = 0; i < 8; ++i) S[i] = 0.f;
        const int hc = hh * 64 + lane;
        const float mr = mu[hc], mk = mu[384 + hc], mv = mu[768 + hc];
        const float kkw = p.rwkv_kk[l * DRW + hc], kaw = p.rwkv_ka[l * DRW + hc], rkw = p.rwkv_rk[l * DRW + hc];
        const float lng = p.rwkv_ln_g[l * DRW + hc], lnb = p.rwkv_ln_b[l * DRW + hc];
        for (int ck = 0; ck < 129; ++ck) {
            const int p0 = ck * 16;
            __syncthreads();
#pragma unroll
            for (int q = 0; q < 2; ++q) {
                const int tk = wave * 2 + q, pos = p0 + tk;
                const int row = row_of(b, pos);
                const bf16_t* cur = p.big + (size_t)row * DIN + C_RW + hc;
                float r = bf2f(cur[0]), k = bf2f(cur[384]), v = bf2f(cur[768]);
                float pr = 0.f, pk = 0.f, pv = 0.f;
                if (pos > 0) { const bf16_t* prv = p.big + (size_t)row_of(b, pos - 1) * DIN + C_RW + hc; pr = bf2f(prv[0]); pk = bf2f(prv[384]); pv = bf2f(prv[768]); }
                r += mr * (pr - r); k += mk * (pk - k); v += mv * (pv - v);
                const size_t o = (size_t)row * DRW + hc;
                const float a = p.aa[o], w = expf(p.lw[o]), g = p.gg[o];
                const float kkr = k * kkw;
                const float nrm = fmaxf(sqrtf(wave_sum(kkr * kkr)), 1e-12f);
                const float kk = kkr / nrm;
                const float kp = k * (1.f + (a - 1.f) * kaw);
                const float ct = wave_sum(r * kp * rkw);
                const int e = tk * 64 + lane;
                rS[e] = r; wS[e] = w; kS[e] = kp; vS[e] = v; nS[e] = kk; bS[e] = kk * a; gS[e] = g;
                if (lane == 0) cS[tk] = ct;
            }
            __syncthreads();
            for (int tk = 0; tk < 16; ++tk) {
                const int e = tk * 64 + ks * 8;
                const f32x4 n0 = *(const f32x4*)(nS + e), n1 = *(const f32x4*)(nS + e + 4);
                float sa = 0.f;
#pragma unroll
                for (int i = 0; i < 4; ++i) { sa -= S[i] * n0[i]; sa -= S[4 + i] * n1[i]; }
                sa += __shfl_xor(sa, 1); sa += __shfl_xor(sa, 2); sa += __shfl_xor(sa, 4);
                const f32x4 w0 = *(const f32x4*)(wS + e), w1 = *(const f32x4*)(wS + e + 4);
                const f32x4 b0 = *(const f32x4*)(bS + e), b1 = *(const f32x4*)(bS + e + 4);
                const f32x4 k0 = *(const f32x4*)(kS + e), k1 = *(const f32x4*)(kS + e + 4);
                const f32x4 r0 = *(const f32x4*)(rS + e), r1 = *(const f32x4*)(rS + e + 4);
                const float vv = vS[tk * 64 + vi];
                float o = 0.f;
#pragma unroll
                for (int i = 0; i < 4; ++i) {
                    S[i] = S[i] * w0[i] + sa * b0[i] + vv * k0[i];
                    S[4 + i] = S[4 + i] * w1[i] + sa * b1[i] + vv * k1[i];
                    o += S[i] * r0[i]; o += S[4 + i] * r1[i];
                }
                o += __shfl_xor(o, 1); o += __shfl_xor(o, 2); o += __shfl_xor(o, 4);
                if (ks == 0) oS[tk * 64 + vi] = o;
            }
            __syncthreads();
#pragma unroll
            for (int q = 0; q < 2; ++q) {
                const int tk = wave * 2 + q, e = tk * 64 + lane;
                const float o = oS[e];
                const float m = wave_sum(o) * (1.f / 64.f);
                const float d = o - m;
                const float var = wave_sum(d * d) * (1.f / 64.f);
                float yv = d * rsqrtf(var + 64e-5f) * lng + lnb;
                yv = (yv + cS[tk] * vS[e]) * gS[e];
                p.y[(size_t)row_of(b, p0 + tk) * DM + 256 + hc] = f2bf(yv);
            }
        }
    }
}

constexpr int TCH = 32, NCH = 65;
struct ScanRegs { unsigned short r[8], k[8], v[8]; unsigned short pr, pk, pv; float a[8], lw[8]; };
DEV void scan_issue(CP& p, ScanRegs& R, int b, int hc, int c, int lwv) {
#pragma unroll
    for (int q = 0; q < 8; ++q) {
        const int pos = c * TCH + lwv * 8 + q;
        R.r[q] = 0; R.k[q] = 0; R.v[q] = 0; R.a[q] = 0.f; R.lw[q] = 0.f;
        if (pos < LT) {
            const int row = row_of(b, pos);
            const bf16_t* cur = p.big + (size_t)row * DIN + C_RW + hc;
            R.r[q] = cur[0]; R.k[q] = cur[384]; R.v[q] = cur[768];
            R.a[q] = p.aa[(size_t)row * DRW + hc]; R.lw[q] = p.lw[(size_t)row * DRW + hc];
        }
    }
    const int pp = c * TCH + lwv * 8 - 1;
    R.pr = 0; R.pk = 0; R.pv = 0;
    if (pp >= 0) { const bf16_t* prv = p.big + (size_t)row_of(b, pp) * DIN + C_RW + hc; R.pr = prv[0]; R.pk = prv[384]; R.pv = prv[768]; }
}
DEV void phase_rwkv_scan2(CP& p, int l, int item, float* lds) {
    const int tid = tid_(), lane = tid & 63;
    const int b = item / 24, hh = (item >> 2) % 6, rq = item & 3;
    if (tid >= 256) {
        const int lwv = (tid - 256) >> 6, hc = hh * 64 + lane;
        const float* mu = p.rwkv_mu + (size_t)l * 1408;
        const float mr = mu[hc], mk = mu[384 + hc], mv = mu[768 + hc];
        const float kkw = p.rwkv_kk[l * DRW + hc], kaw = p.rwkv_ka[l * DRW + hc], rkw = p.rwkv_rk[l * DRW + hc];
        ScanRegs R;
        scan_issue(p, R, b, hc, 0, lwv);
        for (int c = 0; c <= NCH; ++c) {
            if (c < NCH) {
                float* buf = lds + (c & 1) * (6 * TCH * 64);
                float pr = bf2f(R.pr), pk = bf2f(R.pk), pv = bf2f(R.pv);
#pragma unroll
                for (int q = 0; q < 8; ++q) {
                    const int tk = lwv * 8 + q;
                    const float r0 = bf2f(R.r[q]), k0 = bf2f(R.k[q]), v0 = bf2f(R.v[q]);
                    const float r = r0 + mr * (pr - r0), k = k0 + mk * (pk - k0), v = v0 + mv * (pv - v0);
                    pr = r0; pk = k0; pv = v0;
                    const float a = R.a[q], w = __expf(R.lw[q]);
                    const float kkr = k * kkw;
                    const float kk = kkr * __builtin_amdgcn_rsqf(fmaxf(wave_sum_fast(kkr * kkr), 1e-24f));
                    const float kp = k * (1.f + (a - 1.f) * kaw);
                    const int e = tk * 64 + lane;
                    buf[e] = r; buf[2048 + e] = w; buf[4096 + e] = kp; buf[6144 + e] = v; buf[8192 + e] = kk; buf[10240 + e] = kk * a;
                    if (rq == 0) {
                        const float ct = wave_sum_fast(r * kp * rkw);
                        const int pos = c * TCH + tk;
                        if (lane == 0 && pos < LT) p.ct[(size_t)row_of(b, pos) * 8 + hh] = ct;
                    }
                }
                if (c + 1 < NCH) scan_issue(p, R, b, hc, c + 1, lwv);
            }
            __syncthreads();
        }
    } else {
        const int vi = tid >> 4, ks = tid & 15, vrow = rq * 16 + vi;
        float S0 = 0.f, S1 = 0.f, S2 = 0.f, S3 = 0.f;
        __syncthreads();
        for (int c = 0; c < NCH; ++c) {
            const float* buf = lds + (c & 1) * (6 * TCH * 64);
            const int nst = (LT - c * TCH) < TCH ? (LT - c * TCH) : TCH;
#define SCAN_LOAD(R4, W4, K4, N4, B4, VV, TK) { const int e_ = ((TK) & 31) * 64 + ks * 4; R4 = *(const f32x4*)(buf + e_); W4 = *(const f32x4*)(buf + 2048 + e_); K4 = *(const f32x4*)(buf + 4096 + e_); \
                N4 = *(const f32x4*)(buf + 8192 + e_); B4 = *(const f32x4*)(buf + 10240 + e_); VV = buf[6144 + ((TK) & 31) * 64 + vrow]; }
#define SCAN_STEP(R4, W4, K4, N4, B4, VV, TK) { \
                float sa = (S0 * N4[0] + S1 * N4[1]) + (S2 * N4[2] + S3 * N4[3]); \
                const float t0 = S0 * W4[0] + VV * K4[0], t1 = S1 * W4[1] + VV * K4[1], t2 = S2 * W4[2] + VV * K4[2], t3 = S3 * W4[3] + VV * K4[3]; \
                sa = -dpp_sum16(sa); \
                S0 = t0 + sa * B4[0]; S1 = t1 + sa * B4[1]; S2 = t2 + sa * B4[2]; S3 = t3 + sa * B4[3]; \
                float o = (S0 * R4[0] + S1 * R4[1]) + (S2 * R4[2] + S3 * R4[3]); \
                o = dpp_sum16(o); \
                if (ks == 0) p.oraw[(size_t)row_of(b, c * TCH + (TK)) * DRW + hh * 64 + vrow] = o; }
            f32x4 rA, wA, kA, nA, bA, rB, wB, kB, nB, bB; float vA, vB;
            SCAN_LOAD(rA, wA, kA, nA, bA, vA, 0);
            for (int tk = 0; tk < nst; tk += 2) {
                SCAN_LOAD(rB, wB, kB, nB, bB, vB, tk + 1);
                SCAN_STEP(rA, wA, kA, nA, bA, vA, tk);
                SCAN_LOAD(rA, wA, kA, nA, bA, vA, tk + 2);
                SCAN_STEP(rB, wB, kB, nB, bB, vB, tk + 1);
            }
#undef SCAN_LOAD
#undef SCAN_STEP
            __syncthreads();
        }
    }
}
DEV void phase_rwkv_post(CP& p, int l, int bid, int nblk) {
    const int tid = tid_(), lane = tid & 63, wave = tid >> 6;
    const float* mu = p.rwkv_mu + (size_t)l * 1408;
    for (int it = bid * 8 + wave; it < NB * LT * 6; it += nblk * 8) {
        const int hh = it % 6, tok = it / 6, b = tok / LT, pos = tok % LT;
        const int row = row_of(b, pos), hc = hh * 64 + lane;
        const float o = p.oraw[(size_t)row * DRW + hc];
        const float v0 = bf2f(p.big[(size_t)row * DIN + C_RW + 768 + hc]);
        const float pv = pos > 0 ? bf2f(p.big[(size_t)row_of(b, pos - 1) * DIN + C_RW + 768 + hc]) : 0.f;
        const float v = v0 + mu[768 + hc] * (pv - v0);
        const float g = p.gg[(size_t)row * DRW + hc], ct = p.ct[(size_t)row * 8 + hh];
        const float m = wave_sum(o) * (1.f / 64.f);
        const float d = o - m;
        const float var = wave_sum(d * d) * (1.f / 64.f);
        float yv = d * rsqrtf(var + 64e-5f) * p.rwkv_ln_g[l * DRW + hc] + p.rwkv_ln_b[l * DRW + hc];
        yv = (yv + ct * v) * g;
        p.y[(size_t)row * DM + 256 + hc] = f2bf(yv);
    }
}

DEV void phase_sb(CP& p, int l, int bid, int nblk, float* lds) {
    float* Ks = lds;
    float* Vs = lds + 2048;
    const int tid = tid_(), qi = tid >> 1, hf = tid & 1;
    for (int it = bid; it < NB * 6 * 9; it += nblk) {
        const int qt = it % 9, bh = it / 9, b = bh / 6, hh = bh % 6;
        const int t = qt * 256 + qi;
        const bool valid = t < LT;
        const int myrow = row_of(b, valid ? t : 0);
        float q[64], acc[32];
        {
            const bf16_t* qp = p.big + (size_t)myrow * DIN + C_Q + hh * 64;
#pragma unroll
            for (int i = 0; i < 8; ++i) {
                const u32x4 w = *(const u32x4*)(qp + i * 8);
#pragma unroll
                for (int e = 0; e < 4; ++e) { q[i * 8 + 2 * e] = __uint_as_float(w[e] << 16) * 0.125f; q[i * 8 + 2 * e + 1] = __uint_as_float(w[e] & 0xFFFF0000u) * 0.125f; }
            }
        }
#pragma unroll
        for (int d = 0; d < 32; ++d) acc[d] = 0.f;
        float carry = 0.f;
        int thi = qt * 256 + 254; if (thi > LT - 2) thi = LT - 2;
        for (int kt = thi >> 5; kt >= 0; --kt) {
            __syncthreads();
            {
                const int which = tid >> 8, key = (tid & 255) >> 3, part = tid & 7, s = kt * 32 + key;
                float f[8];
#pragma unroll
                for (int e = 0; e < 8; ++e) f[e] = 0.f;
                if (s < LT) {
                    const u32x4 w = *(const u32x4*)(p.big + (size_t)row_of(b, s) * DIN + (which ? C_V : C_K) + hh * 64 + part * 8);
#pragma unroll
                    for (int e = 0; e < 4; ++e) { f[2 * e] = __uint_as_float(w[e] << 16); f[2 * e + 1] = __uint_as_float(w[e] & 0xFFFF0000u); }
                }
                float* dst = (which ? Vs : Ks) + key * 64 + part * 8;
                *(f32x4*)dst = (f32x4){f[0], f[1], f[2], f[3]};
                *(f32x4*)(dst + 4) = (f32x4){f[4], f[5], f[6], f[7]};
            }
            __syncthreads();
            for (int kk = 31; kk >= 0; --kk) {
                const int s = kt * 32 + kk;
                if (valid && s < t) {
                    float z0 = 0.f, z1 = 0.f;
#pragma unroll
                    for (int i = 0; i < 16; ++i) {
                        if ((i & 3) == 0) asm volatile("" ::: "memory");
                        const f32x4 kv = *(const f32x4*)(Ks + kk * 64 + i * 4);
                        z0 += q[i * 4] * kv[0]; z1 += q[i * 4 + 1] * kv[1]; z0 += q[i * 4 + 2] * kv[2]; z1 += q[i * 4 + 3] * kv[3];
                    }
                    const float z = z0 + z1;
                    const float ls = fminf(z, 0.f) - log1pf(expf(-fabsf(z)));
                    const float a = expf(ls + carry);
                    carry += ls - z;
#pragma unroll
                    for (int i = 0; i < 8; ++i) {
                        const f32x4 vv = *(const f32x4*)(Vs + kk * 64 + hf * 32 + i * 4);
                        acc[i * 4] += a * vv[0]; acc[i * 4 + 1] += a * vv[1]; acc[i * 4 + 2] += a * vv[2]; acc[i * 4 + 3] += a * vv[3];
                    }
                }
            }
            if (__syncthreads_and((!valid || carry < -110.f) ? 1 : 0)) break;
        }
        float ms = 0.f;
#pragma unroll
        for (int d = 0; d < 32; ++d) ms += acc[d] * acc[d];
        ms += __shfl_xor(ms, 1);
        if (valid) {
            const float rs = rsqrtf(ms * (1.f / 64.f) + 1e-6f);
            const float* g = p.sb_norm + l * 384 + hh * 64 + hf * 32;
            bf16_t* yp = p.y + (size_t)myrow * DM + 640 + hh * 64 + hf * 32;
#pragma unroll
            for (int i = 0; i < 4; ++i) {
                u32x4 w;
#pragma unroll
                for (int e = 0; e < 4; ++e) w[e] = pack2(acc[i * 8 + 2 * e] * rs * g[i * 8 + 2 * e], acc[i * 8 + 2 * e + 1] * rs * g[i * 8 + 2 * e + 1]);
                *(u32x4*)(yp + i * 8) = w;
            }
        }
    }
}

DEV void phase_sb_mfma(CP& p, int l, int bid, int nblk) {
    const int tid = tid_(), lane = tid & 63, wave = tid >> 6, r = lane & 31, h = lane >> 5;
    for (int it = bid * 8 + wave; it < NB * 6 * 65; it += nblk * 8) {
        const int qt = it % 65, bh = it / 65, b = bh / 6, hh = bh % 6;
        const int q0 = qt * 32, t = q0 + r;
        const bool valid = t < LT;
        const int myrow = row_of(b, valid ? t : LT - 1);
        bf16x8 qf[4];
        {
            const bf16_t* qp = p.big + (size_t)myrow * DIN + C_Q + hh * 64 + 8 * h;
#pragma unroll
            for (int ks = 0; ks < 4; ++ks) qf[ks] = *(const bf16x8*)(qp + 16 * ks);
        }
        f32x16 o0, o1;
#pragma unroll
        for (int i = 0; i < 16; ++i) { o0[i] = 0.f; o1[i] = 0.f; }
        float carry = 0.f;
        const bf16_t* vbase = p.vt + (size_t)((b * 6 + hh) * 64 + r) * LPV + 4 * h;
        bf16x8 kf[4];
        {
            const bf16_t* kp = p.big + (size_t)row_of(b, q0 + r) * DIN + C_K + hh * 64 + 8 * h;
#pragma unroll
            for (int ks = 0; ks < 4; ++ks) kf[ks] = *(const bf16x8*)(kp + 16 * ks);
        }
        for (int k0 = q0; k0 >= 0; k0 -= 32) {
            bf16x8 vf[2][2];
#pragma unroll
            for (int db = 0; db < 2; ++db)
#pragma unroll
                for (int s = 0; s < 2; ++s) {
                    const bf16_t* vp = vbase + (size_t)(db * 32) * LPV + k0 + 16 * s;
                    const s16x4 lo = *(const s16x4*)vp, hi = *(const s16x4*)(vp + 8);
                    vf[db][s] = __builtin_shufflevector(lo, hi, 0, 1, 2, 3, 4, 5, 6, 7);
                }
            bf16x8 kn[4];
            {
                const int kpos = k0 >= 32 ? k0 - 32 + r : r;
                const bf16_t* kp = p.big + (size_t)row_of(b, kpos) * DIN + C_K + hh * 64 + 8 * h;
#pragma unroll
                for (int ks = 0; ks < 4; ++ks) kn[ks] = *(const bf16x8*)(kp + 16 * ks);
            }
            f32x16 x;
#pragma unroll
            for (int i = 0; i < 16; ++i) x[i] = 0.f;
#pragma unroll
            for (int ks = 0; ks < 4; ++ks) x = __builtin_amdgcn_mfma_f32_32x32x16_bf16(kf[ks], qf[ks], x, 0, 0, 0);
            float lr[16], ls[16];
#pragma unroll
            for (int i = 0; i < 16; ++i) {
                const int key = k0 + (i & 3) + 8 * (i >> 2) + 4 * h;
                const float z = x[i] * 0.125f;
                const float sp = __logf(1.f + __expf(-fabsf(z)));
                const float lsi = fminf(z, 0.f) - sp;
                ls[i] = lsi;
                lr[i] = key < t ? lsi - z : 0.f;
            }
            float pw[16];
            float run = carry;
#pragma unroll
            for (int g = 3; g >= 0; --g) {
                const float G = (lr[4 * g] + lr[4 * g + 1]) + (lr[4 * g + 2] + lr[4 * g + 3]);
                const float Gp = __shfl_xor(G, 32);
                const float s3 = run + (h == 0 ? Gp : 0.f);
                const float s2 = s3 + lr[4 * g + 3], s1 = s2 + lr[4 * g + 2], s0 = s1 + lr[4 * g + 1];
                const int keyb = k0 + 8 * g + 4 * h;
                pw[4 * g + 3] = keyb + 3 < t ? __expf(ls[4 * g + 3] + s3) : 0.f;
                pw[4 * g + 2] = keyb + 2 < t ? __expf(ls[4 * g + 2] + s2) : 0.f;
                pw[4 * g + 1] = keyb + 1 < t ? __expf(ls[4 * g + 1] + s1) : 0.f;
                pw[4 * g + 0] = keyb + 0 < t ? __expf(ls[4 * g + 0] + s0) : 0.f;
                run += G + Gp;
            }
            carry = run;
            const bf16x8 pf0 = pack_frag(pw[0], pw[1], pw[2], pw[3], pw[4], pw[5], pw[6], pw[7]);
            const bf16x8 pf1 = pack_frag(pw[8], pw[9], pw[10], pw[11], pw[12], pw[13], pw[14], pw[15]);
            o0 = __builtin_amdgcn_mfma_f32_32x32x16_bf16(vf[0][0], pf0, o0, 0, 0, 0);
            o0 = __builtin_amdgcn_mfma_f32_32x32x16_bf16(vf[0][1], pf1, o0, 0, 0, 0);
            o1 = __builtin_amdgcn_mfma_f32_32x32x16_bf16(vf[1][0], pf0, o1, 0, 0, 0);
            o1 = __builtin_amdgcn_mfma_f32_32x32x16_bf16(vf[1][1], pf1, o1, 0, 0, 0);
#pragma unroll
            for (int ks = 0; ks < 4; ++ks) kf[ks] = kn[ks];
            if (__all((!valid || carry < -110.f) ? 1 : 0)) break;
        }
        float ss = 0.f;
#pragma unroll
        for (int i = 0; i < 16; ++i) ss += o0[i] * o0[i] + o1[i] * o1[i];
        ss += __shfl_xor(ss, 32);
        const float rs = rsqrtf(ss * (1.f / 64.f) + 1e-6f);
        if (valid) {
            const float* g = p.sb_norm + l * 384 + hh * 64 + 4 * h;
            bf16_t* yp = p.y + (size_t)myrow * DM + 640 + hh * 64 + 4 * h;
#pragma unroll
            for (int gq = 0; gq < 4; ++gq) {
                const f32x4 g0 = *(const f32x4*)(g + 8 * gq), g1 = *(const f32x4*)(g + 32 + 8 * gq);
                u32x2 w0, w1;
                w0.x = cvt2(o0[4 * gq] * rs * g0[0], o0[4 * gq + 1] * rs * g0[1]); w0.y = cvt2(o0[4 * gq + 2] * rs * g0[2], o0[4 * gq + 3] * rs * g0[3]);
                w1.x = cvt2(o1[4 * gq] * rs * g1[0], o1[4 * gq + 1] * rs * g1[1]); w1.y = cvt2(o1[4 * gq + 2] * rs * g1[2], o1[4 * gq + 3] * rs * g1[3]);
                *(u32x2*)(yp + 8 * gq) = w0;
                *(u32x2*)(yp + 32 + 8 * gq) = w1;
            }
        }
    }
}

DEV void phase_final(CP& p, int bid, int nblk) {
    const int lane = tid_() & 63, wave = tid_() >> 6;
    for (int r = bid * 8 + wave; r < MMAIN; r += nblk * 8) {
        const float rs = row_rstd(p.part, r);
#pragma unroll
        for (int i = 0; i < 4; ++i) {
            const int c = (i * 64 + lane) * 4;
            const f32x4 v = *(const f32x4*)(p.h + (size_t)r * DM + c), g = *(const f32x4*)(p.final_norm + c);
            *(f32x4*)(p.out + (size_t)r * DM + c) = v * rs * g;
        }
    }
}

#define XB_TMO      128
#define XB_XCNT(j)  (256  + 64 * (j))
#define XB_XSUB(j)  (1280 + 64 * (j))
#define XB_XGEN(j)  (2304 + 64 * (j))
#define XB_TOP      3328
#define XB_TOPGEN   3392
#define XCD_BAR_WORDS 3456
#define XB_SPIN_CAP (1u << 18)
#define XB_LAS __attribute__((address_space(3)))

__device__ __forceinline__ unsigned xb_ld(unsigned* p)              { return __hip_atomic_load(p, __ATOMIC_RELAXED, __HIP_MEMORY_SCOPE_AGENT); }
__device__ __forceinline__ unsigned xb_add(unsigned* p, unsigned v) { return __hip_atomic_fetch_add(p, v, __ATOMIC_RELAXED, __HIP_MEMORY_SCOPE_AGENT); }
__device__ __forceinline__ unsigned xb_xcc_id() { return (unsigned)__builtin_amdgcn_s_getreg((3 << 11) | 20) & 0xFu; }
#define XB_SPIN(cond, bar) do { unsigned _sp = 0; while (cond) { __builtin_amdgcn_s_sleep(1); \
    if ((++_sp & 255u) == 0u) { if (xb_ld(&(bar)[XB_TMO])) break; if (_sp > XB_SPIN_CAP) { atomicAdd(&(bar)[XB_TMO], 1u); break; } } } } while (0)

struct XcdBarrier {
    unsigned* bar; unsigned x;
    volatile XB_LAS unsigned* st;
};

__device__ __forceinline__ XcdBarrier xcd_barrier_post(unsigned* bar, volatile XB_LAS unsigned* st) {
    XcdBarrier b; b.bar = bar; b.x = xb_xcc_id(); b.st = st;
    if (threadIdx.x == 0) (void)xb_add(&bar[XB_XCNT(b.x)], 1u);
    return b;
}
__device__ __forceinline__ void xcd_barrier_complete(unsigned* bar, unsigned x, unsigned& nloc, unsigned& nx) {
    const unsigned G = gridDim.x * gridDim.y * gridDim.z;
    unsigned sum, cnt, mine, sp = 0u;
    for (;;) {
        sum = 0u; cnt = 0u; mine = 0u;
#pragma unroll
        for (unsigned j = 0; j < 16; ++j) { const unsigned c = xb_ld(&bar[XB_XCNT(j)]); sum += c; cnt += (c > 0u) ? 1u : 0u; mine = (j == x) ? c : mine; }
        if (sum == G) break;
        __builtin_amdgcn_s_sleep(1);
        if ((++sp & 255u) == 0u) { if (xb_ld(&bar[XB_TMO])) break; if (sp > XB_SPIN_CAP) { atomicAdd(&bar[XB_TMO], 1u); break; } }
    }
    nloc = mine > 0u ? mine : 1u; nx = cnt > 0u ? cnt : 1u;
}

__device__ __forceinline__ void xcd_barrier(const XcdBarrier& b) {
    asm volatile("s_waitcnt vmcnt(0)" ::: "memory");
    __syncthreads();
    if (threadIdx.x == 0) {
        unsigned* bar = b.bar;
        __builtin_amdgcn_s_waitcnt(0);
        unsigned nloc = b.st[0], nx = b.st[1];
        if (nloc == 0u) { xcd_barrier_complete(bar, b.x, nloc, nx); b.st[0] = nloc; b.st[1] = nx; }
        const unsigned old = xb_add(&bar[XB_XSUB(b.x)], 1u);
        const unsigned gen = old / nloc;
        if (old + 1u == (gen + 1u) * nloc) {
            __builtin_amdgcn_fence(__ATOMIC_RELEASE, "agent");
            asm volatile("s_waitcnt vmcnt(0)" ::: "memory");
            const unsigned og = xb_add(&bar[XB_TOP], 1u);
            const unsigned tg = og / nx;
            if (og + 1u == (tg + 1u) * nx) xb_add(&bar[XB_TOPGEN], 1u);
            else XB_SPIN(xb_ld(&bar[XB_TOPGEN]) == tg, bar);
            __builtin_amdgcn_fence(__ATOMIC_ACQUIRE, "agent");
            xb_add(&bar[XB_XGEN(b.x)], 1u);
            asm volatile("s_waitcnt vmcnt(0)" ::: "memory");
        } else {
            XB_SPIN(xb_ld(&bar[XB_XGEN(b.x)]) == gen, bar);
            __builtin_amdgcn_fence(__ATOMIC_ACQUIRE, "agent");
            asm volatile("s_waitcnt vmcnt(0)" ::: "memory");
        }
    }
    __syncthreads();
}


enum { PH_INIT = 0, PH_CONVERT, PH_G1A, PH_G2A, PH_G3, PH_CONV, PH_PREP, PH_SCAN, PH_SB, PH_G4, PH_G1B, PH_G2B, PH_FINAL };

DEV void run_phase(CP& p, int ph, int l, int bid, int nblk, float* lds) {
    switch (ph) {
    case PH_INIT: phase_init(p, bid, nblk); break;
    case PH_G1A: gemm_big(p.hb, p.W13a, MMAIN, 2 * DFF, DM, EpiSwiglu{p.big, p.part}, bid, nblk, (unsigned char*)lds);
        if (bid >= 128) gemm_meta<EPI_SWIGLU>(p, p.hb, p.W13a, 2 * DFF, DM, 0.f, bid - 128, nblk - 128, lds); break;
    case PH_G2A: gemm_big(p.big, p.W2a, MMAIN, DM, DFF, EpiResid{p.h, p.hb, p.part, 0.5f}, bid, nblk, (unsigned char*)lds);
        gemm_meta<EPI_RESID>(p, p.big, p.W2a, DM, DFF, 0.5f, bid, nblk, lds); break;
    case PH_G3: gemm_big(p.hb, p.Win, MMAIN, DIN, DM, EpiP{p.big, p.vt, p.part}, bid, nblk, (unsigned char*)lds);
        gemm_meta<EPI_P>(p, p.hb, p.Win, DIN, DM, 0.f, bid, nblk, lds); break;
    case PH_CONV: phase_conv(p, l, bid, nblk, lds); break;
    case PH_PREP: phase_rwkv_prep(p, l, bid, nblk, lds); break;
    case PH_SCAN: phase_rwkv_scan(p, l, bid, nblk, lds); break;
    case PH_SB: phase_sb_mfma(p, l, bid, nblk); break;
    case PH_G4: gemm_big(p.y, p.Wout, MMAIN, DM, DM, EpiResid{p.h, p.hb, p.part, 1.0f}, bid, nblk, (unsigned char*)lds);
        gemm_meta<EPI_RESID>(p, p.y, p.Wout, DM, DM, 1.0f, bid, nblk, lds); break;
    case PH_G1B: gemm_big(p.hb, p.W13b, MMAIN, 2 * DFF, DM, EpiSwiglu{p.big, p.part}, bid, nblk, (unsigned char*)lds);
        if (bid >= 128) gemm_meta<EPI_SWIGLU>(p, p.hb, p.W13b, 2 * DFF, DM, 0.f, bid - 128, nblk - 128, lds); break;
    case PH_G2B: gemm_big(p.big, p.W2b, MMAIN, DM, DFF, EpiResid{p.h, p.hb, p.part, 0.5f}, bid, nblk, (unsigned char*)lds);
        gemm_meta<EPI_RESID>(p, p.big, p.W2b, DM, DFF, 0.5f, bid, nblk, lds); break;
    case PH_FINAL: phase_final(p, bid, nblk); break;
    }
}

namespace cg = cooperative_groups;
constexpr int LDS_BYTES = 131072 + 16;

__global__ void __launch_bounds__(512) k_mega(P p) {
    extern __shared__ __attribute__((aligned(16))) unsigned char smem[];
    float* lds = (float*)smem;
    cg::grid_group grid = cg::this_grid();
    const int bid = blockIdx.x, nblk = gridDim.x;
    volatile XB_LAS unsigned* xst = (volatile XB_LAS unsigned*)((XB_LAS unsigned char*)smem + 131072);
    if (threadIdx.x < 4) xst[threadIdx.x] = 0u;
    __syncthreads();
    const XcdBarrier xb = xcd_barrier_post(kargs()->bar, xst);
    phase_init(*kargs(), bid, nblk);
    phase_convert(*kargs(), 0, 0, bid, nblk, lds);
    grid.sync();
    for (int l = 0; l < 4; ++l) {
        run_phase(*kargs(), PH_G1A, l, bid, nblk, lds); xcd_barrier(xb);
        run_phase(*kargs(), PH_G2A, l, bid, nblk, lds); xcd_barrier(xb);
        run_phase(*kargs(), PH_G3, l, bid, nblk, lds); xcd_barrier(xb);
        run_phase(*kargs(), PH_CONV, l, bid, nblk, lds);
        run_phase(*kargs(), PH_PREP, l, bid, nblk, lds);
        xcd_barrier(xb);
        if (bid < 192) phase_rwkv_scan2(*kargs(), l, bid, lds);
        else {
            phase_sb_mfma(*kargs(), l, bid - 192, nblk - 192);
            __syncthreads();
            phase_convert(*kargs(), l, 1, bid - 192, nblk - 192, lds);
            if (l < 3) phase_convert(*kargs(), l + 1, 0, bid - 192, nblk - 192, lds);
        }
        xcd_barrier(xb);
        phase_rwkv_post(*kargs(), l, bid, nblk);
        xcd_barrier(xb);
        run_phase(*kargs(), PH_G4, l, bid, nblk, lds); xcd_barrier(xb);
        run_phase(*kargs(), PH_G1B, l, bid, nblk, lds); xcd_barrier(xb);
        run_phase(*kargs(), PH_G2B, l, bid, nblk, lds); xcd_barrier(xb);
    }
    phase_final(*kargs(), bid, nblk);
}

extern "C" void kernel_launch(void* const* d_in, const int* in_sizes, int n_in, void* d_out, int out_size, void* d_ws, size_t ws_size, hipStream_t stream) {
    static int grid_blocks = 0;
    if (grid_blocks == 0) {
        int dev = 0, cus = 0, per_cu = 0;
        hipGetDevice(&dev);
        hipDeviceGetAttribute(&cus, hipDeviceAttributeMultiprocessorCount, dev);
        if (hipFuncSetAttribute((const void*)k_mega, hipFuncAttributeMaxDynamicSharedMemorySize, LDS_BYTES) != hipSuccess) { fprintf(stderr, "hipFuncSetAttribute failed\n"); grid_blocks = -1; return; }
        if (hipOccupancyMaxActiveBlocksPerMultiprocessor(&per_cu, (const void*)k_mega, 512, LDS_BYTES) != hipSuccess || per_cu < 1) { fprintf(stderr, "occupancy query failed (%d)\n", per_cu); per_cu = 1; }
        (void)hipGetLastError();
        grid_blocks = cus * per_cu;
    }
    if (grid_blocks < 0) return;
    P p{};
    const float** f = (const float**)&p;
    for (int i = 0; i < 28; ++i) f[i] = (const float*)d_in[i];
    p.out = (float*)d_out;
    size_t off = 0;
    auto take = [&](size_t bytes) { void* r = (char*)d_ws + off; off += (bytes + 255) & ~(size_t)255; return r; };
    p.W13a = (bf16_t*)take((size_t)2 * DFF * DM * 2);
    p.W2a = (bf16_t*)take((size_t)DM * DFF * 2);
    p.Win = (bf16_t*)take((size_t)DIN * DM * 2);
    p.Wout = (bf16_t*)take((size_t)DM * DM * 2);
    p.W13b = (bf16_t*)take((size_t)2 * DFF * DM * 2);
    p.W2b = (bf16_t*)take((size_t)DM * DFF * 2);
    p.Wl = (bf16_t*)take((size_t)DRW * 256 * 2);
    p.h = (float*)take((size_t)MP * DM * 4);
    p.hb = (bf16_t*)take((size_t)MP * DM * 2);
    p.big = (bf16_t*)take((size_t)MP * DIN * 2);
    p.y = (bf16_t*)take((size_t)MP * DM * 2);
    p.vt = (bf16_t*)take((size_t)NB * 6 * 64 * LPV * 2);
    p.part = (float*)take((size_t)MP * 16 * 4);
    p.lw = (float*)take((size_t)MP * DRW * 4);
    p.aa = (float*)take((size_t)MP * DRW * 4);
    p.gg = (float*)take((size_t)MP * DRW * 4);
    p.oraw = (float*)take((size_t)MP * DRW * 4);
    p.ct = (float*)take((size_t)MP * 8 * 4);
    p.bar = (unsigned*)take((size_t)XCD_BAR_WORDS * 4);
    if (off > ws_size) { fprintf(stderr, "workspace too small: need %zu have %zu\n", off, ws_size); return; }
    if (hipMemsetAsync(p.bar, 0, (size_t)XCD_BAR_WORDS * 4, stream) != hipSuccess) { fprintf(stderr, "memset of barrier words failed\n"); return; }
    void* args[] = {&p};
    hipError_t e = hipLaunchCooperativeKernel((const void*)k_mega, dim3(grid_blocks), dim3(512), args, LDS_BYTES, stream);
    if (e != hipSuccess) fprintf(stderr, "cooperative launch failed: %s (grid %d)\n", hipGetErrorString(e), grid_blocks);
}
```

```cpp
#include <hip/hip_runtime.h>
#include <hip/hip_cooperative_groups.h>
#include <stdint.h>
#include <stdio.h>

typedef unsigned short bf16_t;
typedef short bf16x8 __attribute__((ext_vector_type(8)));
typedef float f32x4 __attribute__((ext_vector_type(4)));
typedef unsigned u32x4 __attribute__((ext_vector_type(4)));
typedef unsigned u32x2 __attribute__((ext_vector_type(2)));

#define DEV __device__ __forceinline__

constexpr int NB = 8, SEQ = 2048, NMETA = 16, LT = 2064, DM = 1024, DFF = 2816, DIN = 3072;
constexpr int MMAIN = 16384, MTOK = 16512, MP = 16640;
constexpr int DRW = 384, LPV = 2080;
constexpr int C_RW = 512, C_Q = 1920, C_K = 2304, C_V = 2688;

struct P {
    const float *x, *meta, *ffn1_norm, *ffn1_w13, *ffn1_w2, *mix_norm, *w_in, *conv_w, *conv_b, *conv_ln_g, *conv_ln_b,
        *rwkv_mu, *rwkv_w0, *rwkv_wB, *rwkv_a0, *rwkv_aB, *rwkv_gB, *rwkv_kk, *rwkv_ka, *rwkv_rk, *rwkv_ln_g, *rwkv_ln_b,
        *sb_norm, *w_out, *ffn2_norm, *ffn2_w13, *ffn2_w2, *final_norm;
    float* out;
    bf16_t *W13a, *W2a, *Win, *Wout, *W13b, *W2b, *Wl;
    float* h; bf16_t* hb; bf16_t* big; bf16_t* y; bf16_t* vt; float* part;
    float *lw, *aa, *gg, *oraw, *ct, *inorm;
    unsigned* bar;
};

typedef const __attribute__((address_space(4))) P CP;
DEV CP* kargs() { CP* k = (CP*)__builtin_amdgcn_kernarg_segment_ptr(); asm volatile("" : "+s"(k)); return k; }
DEV int tid_() { int t = threadIdx.x; asm volatile("" : "+v"(t)); return t; }
DEV float bf2f(bf16_t v) { return __uint_as_float(((unsigned)v) << 16); }
DEV bf16_t f2bf(float f) { unsigned u = __float_as_uint(f); u += 0x7FFFu + ((u >> 16) & 1u); return (bf16_t)(u >> 16); }
DEV unsigned pack2(float a, float b) { return (unsigned)f2bf(a) | ((unsigned)f2bf(b) << 16); }
DEV float wave_sum(float v) {
#pragma unroll
    for (int o = 32; o; o >>= 1) v += __shfl_xor(v, o);
    return v;
}
DEV float dpp_sum16(float x) {
    x += __builtin_bit_cast(float, __builtin_amdgcn_update_dpp(0, __builtin_bit_cast(int, x), 0xB1, 0xF, 0xF, false));
    x += __builtin_bit_cast(float, __builtin_amdgcn_update_dpp(0, __builtin_bit_cast(int, x), 0x4E, 0xF, 0xF, false));
    x += __builtin_bit_cast(float, __builtin_amdgcn_update_dpp(0, __builtin_bit_cast(int, x), 0x141, 0xF, 0xF, false));
    x += __builtin_bit_cast(float, __builtin_amdgcn_update_dpp(0, __builtin_bit_cast(int, x), 0x140, 0xF, 0xF, false));
    return x;
}
DEV float wave_sum_fast(float x) {
    x = dpp_sum16(x);
    const int xi = __builtin_bit_cast(int, x);
    return (__builtin_bit_cast(float, __builtin_amdgcn_readlane(xi, 0)) + __builtin_bit_cast(float, __builtin_amdgcn_readlane(xi, 16))) +
           (__builtin_bit_cast(float, __builtin_amdgcn_readlane(xi, 32)) + __builtin_bit_cast(float, __builtin_amdgcn_readlane(xi, 48)));
}
typedef float f32x16 __attribute__((ext_vector_type(16)));
typedef __bf16 bfv2 __attribute__((ext_vector_type(2)));
typedef float f32x2v __attribute__((ext_vector_type(2)));
typedef short s16x4 __attribute__((ext_vector_type(4)));
DEV unsigned cvt2(float a, float b) { return __builtin_bit_cast(unsigned, __builtin_convertvector((f32x2v){a, b}, bfv2)); }
DEV bf16x8 pack_frag(float a0, float a1, float a2, float a3, float a4, float a5, float a6, float a7) {
    u32x4 w; w.x = cvt2(a0, a1); w.y = cvt2(a2, a3); w.z = cvt2(a4, a5); w.w = cvt2(a6, a7);
    return __builtin_bit_cast(bf16x8, w);
}
DEV float sigm(float x) { return 1.f / (1.f + expf(-x)); }
DEV int row_of(int b, int pos) { return pos < NMETA ? MMAIN + b * NMETA + pos : b * SEQ + pos - NMETA; }
DEV float row_rstd(const float* part, int row) {
    const f32x4* pp = (const f32x4*)(part + (size_t)row * 16);
    f32x4 a = pp[0], b = pp[1], c = pp[2], d = pp[3];
    float ss = ((a[0] + a[1]) + (a[2] + a[3])) + ((b[0] + b[1]) + (b[2] + b[3])) + ((c[0] + c[1]) + (c[2] + c[3])) + ((d[0] + d[1]) + (d[2] + d[3]));
    return rsqrtf(ss * (1.0f / 1024.0f) + 1e-6f);
}

DEV void phase_init(CP& p, int bid, int nblk) {
    const int lane = tid_() & 63, wave = tid_() >> 6;
    for (int r = bid * 8 + wave; r < MP; r += nblk * 8) {
        const float* src = nullptr;
        if (r < MMAIN) src = p.x + (size_t)r * DM;
        else if (r < MTOK) src = p.meta + (size_t)((r - MMAIN) & 15) * DM;
        float ss = 0.f;
#pragma unroll
        for (int i = 0; i < 4; ++i) {
            const int c = (i * 64 + lane) * 4;
            f32x4 v = src ? *(const f32x4*)(src + c) : (f32x4){0.f, 0.f, 0.f, 0.f};
            *(f32x4*)(p.h + (size_t)r * DM + c) = v;
            u32x2 w; w.x = pack2(v[0], v[1]); w.y = pack2(v[2], v[3]);
            *(u32x2*)(p.hb + (size_t)r * DM + c) = w;
            ss += v[0] * v[0] + v[1] * v[1] + v[2] * v[2] + v[3] * v[3];
        }
        ss = wave_sum(ss);
        if (lane < 16) p.part[(size_t)r * 16 + lane] = lane == 0 ? ss : 0.f;
    }
    for (int i = bid * 512 + tid_(); i < NB * 6 * 64 * (LPV - LT); i += nblk * 512) p.vt[(size_t)(i >> 4) * LPV + LT + (i & 15)] = 0;
}

struct ConvDesc { const float* W; const float* g; bf16_t* dst; int K, N, swz, kt, nt; };
DEV ConvDesc conv_desc(CP& p, int l, int grp, int idx) {
    ConvDesc d;
    int t = idx;
    if (grp == 0) {
        if (t < 1408) { d.W = p.ffn1_w13 + (size_t)l * DM * 2 * DFF; d.g = p.ffn1_norm + l * DM; d.dst = p.W13a; d.K = DM; d.N = 2 * DFF; d.swz = 1; d.kt = t / 88; d.nt = t % 88; return d; }
        t -= 1408;
        if (t < 704) { d.W = p.ffn1_w2 + (size_t)l * DFF * DM; d.g = nullptr; d.dst = p.W2a; d.K = DFF; d.N = DM; d.swz = 0; d.kt = t / 16; d.nt = t % 16; return d; }
        t -= 704;
        if (t < 768) { d.W = p.w_in + (size_t)l * DM * DIN; d.g = p.mix_norm + l * DM; d.dst = p.Win; d.K = DM; d.N = DIN; d.swz = 0; d.kt = t / 48; d.nt = t % 48; return d; }
        t -= 768;
        d.g = nullptr; d.N = DRW; d.swz = 0;
        if (t < 6) { d.W = p.rwkv_wB + (size_t)l * 64 * DRW; d.dst = p.Wl; d.K = 64; d.kt = 0; d.nt = t; return d; }
        if (t < 12) { d.W = p.rwkv_aB + (size_t)l * 64 * DRW; d.dst = p.Wl + DRW * 64; d.K = 64; d.kt = 0; d.nt = t - 6; return d; }
        d.W = p.rwkv_gB + (size_t)l * 128 * DRW; d.dst = p.Wl + DRW * 128; d.K = 128; d.kt = (t - 12) / 6; d.nt = (t - 12) % 6; return d;
    }
    if (t < 256) { d.W = p.w_out + (size_t)l * DM * DM; d.g = nullptr; d.dst = p.Wout; d.K = DM; d.N = DM; d.swz = 0; d.kt = t / 16; d.nt = t % 16; return d; }
    t -= 256;
    if (t < 1408) { d.W = p.ffn2_w13 + (size_t)l * DM * 2 * DFF; d.g = p.ffn2_norm + l * DM; d.dst = p.W13b; d.K = DM; d.N = 2 * DFF; d.swz = 1; d.kt = t / 88; d.nt = t % 88; return d; }
    t -= 1408;
    d.W = p.ffn2_w2 + (size_t)l * DFF * DM; d.g = nullptr; d.dst = p.W2b; d.K = DFF; d.N = DM; d.swz = 0; d.kt = t / 16; d.nt = t % 16; return d;
}
constexpr int CONV_A = 2904, CONV_B = 2368;
DEV void conv_load(const ConvDesc& d, int tid, f32x4 (&v)[2]) {
#pragma unroll
    for (int i = 0; i < 2; ++i) {
        const int idx = tid + i * 512, kk = idx >> 4, n4 = (idx & 15) * 4;
        v[i] = *(const f32x4*)(d.W + (size_t)(d.kt * 64 + kk) * d.N + d.nt * 64 + n4);
        if (d.g) v[i] *= d.g[d.kt * 64 + kk];
    }
}
DEV void phase_convert(CP& p, int l, int grp, int bid, int nblk, float* tile) {
    const int tid = tid_(), total = grp == 0 ? CONV_A : CONV_B;
    if (bid >= total) return;
    f32x4 v[2];
    ConvDesc d = conv_desc(p, l, grp, bid);
    conv_load(d, tid, v);
    for (int it = bid; it < total; it += nblk) {
#pragma unroll
        for (int i = 0; i < 2; ++i) {
            const int idx = tid + i * 512, kk = idx >> 4, n4 = (idx & 15) * 4;
#pragma unroll
            for (int j = 0; j < 4; ++j) tile[kk * 65 + n4 + j] = v[i][j];
        }
        __syncthreads();
        const ConvDesc dc = d;
        if (it + nblk < total) { d = conv_desc(p, l, grp, it + nblk); conv_load(d, tid, v); }
        {
            const int nn = tid >> 3, kc = (tid & 7) * 8;
            const int sc = dc.nt * 64 + nn;
            int nd = sc;
            if (dc.swz) { const int bj = sc >= DFF ? 1 : 0; const int j = sc - bj * DFF; nd = (j >> 7) * 256 + bj * 128 + (j & 127); }
            u32x4 w;
            w.x = cvt2(tile[(kc + 0) * 65 + nn], tile[(kc + 1) * 65 + nn]); w.y = cvt2(tile[(kc + 2) * 65 + nn], tile[(kc + 3) * 65 + nn]);
            w.z = cvt2(tile[(kc + 4) * 65 + nn], tile[(kc + 5) * 65 + nn]); w.w = cvt2(tile[(kc + 6) * 65 + nn], tile[(kc + 7) * 65 + nn]);
            *(u32x4*)(dc.dst + (size_t)nd * dc.K + dc.kt * 64 + kc) = w;
        }
        __syncthreads();
    }
}

enum { EPI_SWIGLU = 0, EPI_RESID = 1, EPI_P = 2 };

DEV void epi_swiglu(CP& p, int row, int colh, f32x4 g, f32x4 u, float rs) {
    float o[4];
#pragma unroll
    for (int e = 0; e < 4; ++e) { const float gg = g[e] * rs, uu = u[e] * rs; o[e] = gg * sigm(gg) * uu; }
    u32x2 w; w.x = pack2(o[0], o[1]); w.y = pack2(o[2], o[3]);
    *(u32x2*)(p.big + (size_t)row * DFF + colh) = w;
}
DEV float epi_resid(CP& p, int row, int col, f32x4 a, float scale) {
    float* hp = p.h + (size_t)row * DM + col;
    f32x4 hv = *(const f32x4*)hp;
    hv += a * scale;
    *(f32x4*)hp = hv;
    u32x2 w; w.x = pack2(hv[0], hv[1]); w.y = pack2(hv[2], hv[3]);
    *(u32x2*)(p.hb + (size_t)row * DM + col) = w;
    return hv[0] * hv[0] + hv[1] * hv[1] + hv[2] * hv[2] + hv[3] * hv[3];
}
DEV void epi_p(CP& p, int row, int col, f32x4 a, float rs) {
    a *= rs;
    u32x2 w; w.x = pack2(a[0], a[1]); w.y = pack2(a[2], a[3]);
    *(u32x2*)(p.big + (size_t)row * DIN + col) = w;
    if (col >= C_V && row < MTOK) {
        const int hh = (col - C_V) >> 6, d = (col - C_V) & 63;
        int b, pos;
        if (row < MMAIN) { b = row >> 11; pos = (row & 2047) + NMETA; } else { b = (row - MMAIN) >> 4; pos = (row - MMAIN) & 15; }
        bf16_t* vp = p.vt + ((size_t)((b * 6 + hh) * 64 + d)) * LPV + pos;
#pragma unroll
        for (int e = 0; e < 4; ++e) vp[(size_t)e * LPV] = f2bf(a[e]);
    }
}

template <int EPI>
DEV void gemm_v0(CP& p, const bf16_t* __restrict__ A, const bf16_t* __restrict__ Bt, int row_begin, int row_end, int N, int K, float scale, int bid, int nblk) {
    const int lane = tid_() & 63, wave = tid_() >> 6, fr = lane & 15, fq = lane >> 4;
    const int nt = N / 64, total = ((row_end - row_begin) / 32) * nt;
    for (int u = bid * 8 + wave; u < total; u += nblk * 8) {
        const int mu = u / nt, nu = u % nt, row0 = row_begin + mu * 32;
        const int cb = (EPI == EPI_SWIGLU) ? ((nu >> 2) * 256 + (nu & 3) * 32) : nu * 64;
        f32x4 acc[2][4];
#pragma unroll
        for (int i = 0; i < 2; ++i)
#pragma unroll
            for (int j = 0; j < 4; ++j) acc[i][j] = (f32x4){0.f, 0.f, 0.f, 0.f};
        const bf16_t* ap = A + (size_t)(row0 + fr) * K + fq * 8;
        const bf16_t* bp = Bt + (size_t)(cb + fr) * K + fq * 8;
#pragma unroll 2
        for (int k0 = 0; k0 < K; k0 += 32) {
            const bf16x8 a0 = *(const bf16x8*)(ap + k0), a1 = *(const bf16x8*)(ap + (size_t)16 * K + k0);
#pragma unroll
            for (int j = 0; j < 4; ++j) {
                const int co = (EPI == EPI_SWIGLU) ? ((j & 1) * 16 + (j >> 1) * 128) : j * 16;
                const bf16x8 b = *(const bf16x8*)(bp + (size_t)co * K + k0);
                acc[0][j] = __builtin_amdgcn_mfma_f32_16x16x32_bf16(b, a0, acc[0][j], 0, 0, 0);
                acc[1][j] = __builtin_amdgcn_mfma_f32_16x16x32_bf16(b, a1, acc[1][j], 0, 0, 0);
            }
        }
#pragma unroll
        for (int i = 0; i < 2; ++i) {
            const int row = row0 + 16 * i + fr;
            if (EPI == EPI_SWIGLU) {
                const float rs = row_rstd(p.part, row);
                const int colh = (nu >> 2) * 128 + (nu & 3) * 32 + 4 * fq;
                epi_swiglu(p, row, colh, acc[i][0], acc[i][2], rs);
                epi_swiglu(p, row, colh + 16, acc[i][1], acc[i][3], rs);
            } else if (EPI == EPI_RESID) {
                float ss = 0.f;
#pragma unroll
                for (int j = 0; j < 4; ++j) ss += epi_resid(p, row, cb + 16 * j + 4 * fq, acc[i][j], scale);
                ss += __shfl_xor(ss, 16); ss += __shfl_xor(ss, 32);
                if (fq == 0) p.part[(size_t)row * 16 + nu] = ss;
            } else {
                const float rs = row_rstd(p.part, row);
#pragma unroll
                for (int j = 0; j < 4; ++j) epi_p(p, row, cb + 16 * j + 4 * fq, acc[i][j], rs);
            }
        }
    }
}

template <int EPI>
DEV void gemm_meta(CP& p, const bf16_t* __restrict__ A, const bf16_t* __restrict__ Bt, int N, int K, float scale, int bid, int nblk, float* lds) {
    const int tid = tid_(), lane = tid & 63, wave = tid >> 6, fr = lane & 15, fq = lane >> 4;
    const int nt = N / 64, total = 4 * nt, kw = K / 8;
    float* red = lds + 8 * 8 * 64 * 4;
    for (int u = bid; u < total; u += nblk) {
        const int mu = u / nt, nu = u % nt, row0 = MMAIN + mu * 32;
        const int cb = (EPI == EPI_SWIGLU) ? ((nu >> 2) * 256 + (nu & 3) * 32) : nu * 64;
        f32x4 acc[2][4];
#pragma unroll
        for (int i = 0; i < 2; ++i)
#pragma unroll
            for (int j = 0; j < 4; ++j) acc[i][j] = (f32x4){0.f, 0.f, 0.f, 0.f};
        const bf16_t* ap = A + (size_t)(row0 + fr) * K + wave * kw + fq * 8;
        const bf16_t* bp = Bt + (size_t)(cb + fr) * K + wave * kw + fq * 8;
        for (int k0 = 0; k0 < kw; k0 += 32) {
            const bf16x8 a0 = *(const bf16x8*)(ap + k0), a1 = *(const bf16x8*)(ap + (size_t)16 * K + k0);
#pragma unroll
            for (int j = 0; j < 4; ++j) {
                const int co = (EPI == EPI_SWIGLU) ? ((j & 1) * 16 + (j >> 1) * 128) : j * 16;
                const bf16x8 bv = *(const bf16x8*)(bp + (size_t)co * K + k0);
                acc[0][j] = __builtin_amdgcn_mfma_f32_16x16x32_bf16(bv, a0, acc[0][j], 0, 0, 0);
                acc[1][j] = __builtin_amdgcn_mfma_f32_16x16x32_bf16(bv, a1, acc[1][j], 0, 0, 0);
            }
        }
#pragma unroll
        for (int i = 0; i < 2; ++i)
#pragma unroll
            for (int j = 0; j < 4; ++j) *(f32x4*)(lds + ((wave * 8 + i * 4 + j) * 64 + lane) * 4) = acc[i][j];
        __syncthreads();
        {
            f32x4 sum = (f32x4){0.f, 0.f, 0.f, 0.f};
#pragma unroll
            for (int w = 0; w < 8; ++w) sum += *(const f32x4*)(lds + ((w * 8 + wave) * 64 + lane) * 4);
            *(f32x4*)(red + (wave * 64 + lane) * 4) = sum;
        }
        __syncthreads();
        if (wave < 2) {
            const int i = wave, row = row0 + 16 * i + fr;
            f32x4 a[4];
#pragma unroll
            for (int j = 0; j < 4; ++j) a[j] = *(const f32x4*)(red + ((i * 4 + j) * 64 + lane) * 4);
            if (EPI == EPI_SWIGLU) {
                const float rs = row_rstd(p.part, row);
                const int colh = (nu >> 2) * 128 + (nu & 3) * 32 + 4 * fq;
                epi_swiglu(p, row, colh, a[0], a[2], rs);
                epi_swiglu(p, row, colh + 16, a[1], a[3], rs);
            } else if (EPI == EPI_RESID) {
                float ss = 0.f;
#pragma unroll
                for (int j = 0; j < 4; ++j) ss += epi_resid(p, row, cb + 16 * j + 4 * fq, a[j], scale);
                ss += __shfl_xor(ss, 16); ss += __shfl_xor(ss, 32);
                if (fq == 0) p.part[(size_t)row * 16 + nu] = ss;
            } else {
                const float rs = row_rstd(p.part, row);
#pragma unroll
                for (int j = 0; j < 4; ++j) epi_p(p, row, cb + 16 * j + 4 * fq, a[j], rs);
            }
        }
        __syncthreads();
    }
}

namespace pg8 {
#define PG8_LAS __attribute__((address_space(3)))
typedef unsigned short bf16_t;
typedef short bf16x8 __attribute__((ext_vector_type(8)));
typedef float f32x4 __attribute__((ext_vector_type(4)));
typedef unsigned u32x4 __attribute__((ext_vector_type(4)));
constexpr int BM = 256, BK = 64, HALF = 128, HTB = HALF * BK * 2  , STAGE_BYTES = 8 * HTB, NXCD = 8, WGM = 8;

__host__ __device__ __forceinline__ int lds_byte(int r, int c) { const int st = (r >> 4) * 2 + (c >> 5), rr = r & 15, cc = c & 31, ob = rr * 64 + cc * 2; return st * 1024 + (ob ^ (((ob >> 9) & 1) << 5)); }
__host__ __device__ __forceinline__ void stage_rc(int b, int& R, int& C) { const int st = b / 1024, sb = b % 1024, swz = sb ^ (((sb >> 9) & 1) << 5); R = (st >> 1) * 16 + swz / 64; C = (st & 1) * 32 + (swz % 64) / 2; }
__host__ __device__ __forceinline__ int perm32(int rho) { const int n = rho >> 4, i = rho & 15; return 8 * (i >> 2) + 4 * n + (i & 3); }

struct Unit { int pm, pn; };
struct Gemm { const bf16_t* A; const bf16_t* Bt; int M, N, K; };

struct StaticOrder {
    int nM, nN, nwg, G, c;
    __host__ __device__ void init(int M, int N, int G_, int c_) { nM = M / BM; nN = N / BM; nwg = nM * nN; G = G_; c = c_; }
    __host__ __device__ bool next(int i, Unit& u) const {
        const long L = (long)i * G + c; if (L >= nwg) return false;
        int wgid = (int)L; { const int q = nwg / NXCD, r = nwg % NXCD, xcd = wgid % NXCD, off = wgid / NXCD; wgid = (xcd < r ? xcd * (q + 1) : r * (q + 1) + (xcd - r) * q) + off; }
        const int nig = WGM * nN, gid = wgid / nig, fm = gid * WGM, gsz = (nM - fm) < WGM ? (nM - fm) : WGM;
        u.pm = fm + ((wgid % nig) % gsz); u.pn = (wgid % nig) / gsz; return true;
    }
    __device__ __forceinline__ void a_ready(const Unit&) const {}
    __device__ __forceinline__ void done(const Unit&) const {}
};
__device__ __forceinline__ unsigned cvt_pk_bf16(float lo, float hi) { unsigned r; asm volatile("v_cvt_pk_bf16_f32 %0, %1, %2" : "=v"(r) : "v"(lo), "v"(hi)); return r; }
template <class Epi, class Sched, bool STAMP = false>
__device__ __forceinline__ void gemm_phase(PG8_LAS unsigned char* lds, const Gemm g, const Sched& S, const Epi& E, unsigned long long* stamps) {
    const int tid = tid_(), wid = __builtin_amdgcn_readfirstlane(tid >> 6), lane = tid & 63, wr = wid >> 2, wc = wid & 3, fr = lane & 15, fq = lane >> 4;
    const int K = g.K, nt = K / BK;
    int ts_lo = 0, ts_hi = 0, nts = 0; const unsigned long long rt_entry = STAMP ? (unsigned long long)wall_clock64() : 0ull;
#define PG8_STAMP() do { if (STAMP && wid == 0 && nts < 64) { const unsigned long long _c = (unsigned long long)clock64(); \
        ts_lo = (lane == nts) ? (int)(unsigned)_c : ts_lo; ts_hi = (lane == nts) ? (int)(unsigned)(_c >> 32) : ts_hi; ++nts; } } while (0)
    PG8_STAMP();
    unsigned voffA[2], voffB[2];
#pragma unroll
    for (int i = 0; i < 2; ++i) { int R, C; stage_rc(tid * 16 + i * 8192, R, C); const int Rb = Epi::PERM ? ((R & ~31) + perm32(R & 31)) : R;
        voffA[i] = (unsigned)(R * K + C) * 2u; voffB[i] = (unsigned)(Rb * K + C) * 2u; }
    const size_t kstep = (size_t)(BK * 2);
    const size_t hstep = (size_t)HALF * K * 2;
    const size_t tstep = 2 * hstep;
    const unsigned ldsw = (unsigned)wid * 1024u;
    const int aoff = lds_byte(wr * 64 + fr, fq * 8), boff = lds_byte(wc * 32 + fr, fq * 8);
#define PG8_SA(b, h) (((b) * 2 + (h)) * HTB)
#define PG8_SB(b, h) ((4 + (b) * 2 + (h)) * HTB)
#define PG8_STAGE(bufoff, gbase, voff) do { _Pragma("unroll") for (int _i = 0; _i < 2; ++_i) \
        __builtin_amdgcn_global_load_lds((const unsigned*)((const char*)(gbase) + (voff)[_i]), (PG8_LAS unsigned*)(lds + (bufoff) + ldsw + _i * 8192), 16, 0, 0); } while (0)
#define PG8_LDA(dst, b, h) do { _Pragma("unroll") for (int m = 0; m < 4; ++m) _Pragma("unroll") for (int k = 0; k < 2; ++k) dst[m][k] = *(const PG8_LAS bf16x8*)(lds + PG8_SA(b, h) + aoff + m * 2048 + k * 1024); } while (0)
#define PG8_LDB(dst, b, h) do { _Pragma("unroll") for (int n = 0; n < 2; ++n) _Pragma("unroll") for (int k = 0; k < 2; ++k) dst[n][k] = *(const PG8_LAS bf16x8*)(lds + PG8_SB(b, h) + boff + n * 2048 + k * 1024); } while (0)
#define PG8_MMA(ai, bj, At, Bt) do { __builtin_amdgcn_s_setprio(1); _Pragma("unroll") for (int m = 0; m < 4; ++m) _Pragma("unroll") for (int n = 0; n < 2; ++n) _Pragma("unroll") for (int k = 0; k < 2; ++k) \
        acc[ai][bj][m][n] = __builtin_amdgcn_mfma_f32_16x16x32_bf16(Bt[n][k], At[m][k], acc[ai][bj][m][n], 0, 0, 0); __builtin_amdgcn_s_setprio(0); } while (0)
#define PG8_WAIT_V(n) asm volatile("s_waitcnt vmcnt(" #n ")" ::: "memory")
#define PG8_WAIT_L(n) asm volatile("s_waitcnt lgkmcnt(" #n ")" ::: "memory")
#define PG8_BAR __builtin_amdgcn_s_barrier()
#define PG8_SCHED __builtin_amdgcn_sched_barrier(0)
    Unit cur, nxt; int ui = 0;
    if (!S.next(0, cur)) return;
    f32x4 acc[2][2][4][2];
#pragma unroll
    for (int a = 0; a < 2; ++a)
#pragma unroll
        for (int b = 0; b < 2; ++b)
#pragma unroll
            for (int m = 0; m < 4; ++m)
#pragma unroll
                for (int n = 0; n < 2; ++n) acc[a][b][m][n] = (f32x4){0.f, 0.f, 0.f, 0.f};
    bf16x8 At[4][2], B0[2][2], B1[2][2];
    const char* cA = (const char*)g.A + (size_t)cur.pm * tstep; const char* cB = (const char*)g.Bt + (size_t)cur.pn * tstep;
    S.a_ready(cur);
    PG8_STAGE(PG8_SB(0, 0), cB, voffB); PG8_STAGE(PG8_SA(0, 0), cA, voffA); PG8_STAGE(PG8_SB(0, 1), cB + hstep, voffB); PG8_STAGE(PG8_SA(0, 1), cA + hstep, voffA);
    if (wr == 1) PG8_BAR;
    PG8_WAIT_V(4); PG8_BAR;
    PG8_STAGE(PG8_SB(1, 0), cB + kstep, voffB); PG8_STAGE(PG8_SA(1, 0), cA + kstep, voffA); PG8_STAGE(PG8_SB(1, 1), cB + hstep + kstep, voffB);
    PG8_WAIT_V(6); PG8_BAR;
    PG8_STAMP();
    for (;;) {
        const bool has_next = S.next(ui + 1, nxt);
        const char* nA = has_next ? (const char*)g.A + (size_t)nxt.pm * tstep : cA; const char* nB = has_next ? (const char*)g.Bt + (size_t)nxt.pn * tstep : cB;
        for (int t = 0; t < nt; t += 2) {
            const bool last = (t == nt - 2);
            const char* a1 = cA + (size_t)(t + 1) * kstep;
            const char* a2 = last ? nA : cA + (size_t)(t + 2) * kstep; const char* b2 = last ? nB : cB + (size_t)(t + 2) * kstep;
            const char* a3 = a2 + kstep; const char* b3 = b2 + kstep;
            if (last && has_next) S.a_ready(nxt);
            PG8_LDB(B0, 0, 0); PG8_SCHED; PG8_LDA(At, 0, 0); PG8_STAGE(PG8_SA(1, 1), a1 + hstep, voffA);
            PG8_WAIT_L(8); PG8_BAR; PG8_WAIT_L(0); PG8_MMA(0, 0, At, B0); PG8_BAR; PG8_SCHED;
            PG8_LDB(B1, 0, 1); PG8_STAGE(PG8_SB(0, 0), b2, voffB);
            PG8_BAR; PG8_WAIT_L(0); PG8_MMA(0, 1, At, B1); PG8_BAR;
            PG8_LDA(At, 0, 1); PG8_STAGE(PG8_SA(0, 0), a2, voffA);
            PG8_BAR; PG8_WAIT_L(0); PG8_MMA(1, 0, At, B0); PG8_BAR; PG8_SCHED;
            PG8_STAGE(PG8_SB(0, 1), b2 + hstep, voffB);
            PG8_WAIT_V(6); PG8_BAR; PG8_MMA(1, 1, At, B1); PG8_BAR;
            PG8_LDB(B0, 1, 0); PG8_SCHED; PG8_LDA(At, 1, 0); PG8_STAGE(PG8_SA(0, 1), a2 + hstep, voffA);
            PG8_WAIT_L(8); PG8_BAR; PG8_WAIT_L(0); PG8_MMA(0, 0, At, B0); PG8_BAR; PG8_SCHED;
            PG8_LDB(B1, 1, 1); PG8_STAGE(PG8_SB(1, 0), b3, voffB);
            PG8_BAR; PG8_WAIT_L(0); PG8_MMA(0, 1, At, B1); PG8_BAR;
            PG8_LDA(At, 1, 1); PG8_STAGE(PG8_SA(1, 0), a3, voffA);
            PG8_BAR; PG8_WAIT_L(0); PG8_MMA(1, 0, At, B0); PG8_BAR; PG8_SCHED;
            PG8_STAGE(PG8_SB(1, 1), b3 + hstep, voffB);
            PG8_WAIT_V(6); PG8_BAR; PG8_MMA(1, 1, At, B1); PG8_BAR;
        }
        PG8_STAMP();
        if constexpr (!Epi::AFTER_DRAIN) { E(acc, cur, wr, wc, fr, fq); S.done(cur); }
        PG8_STAMP();
        if (!has_next) break;
#pragma unroll
        for (int a = 0; a < 2; ++a)
#pragma unroll
            for (int b = 0; b < 2; ++b)
#pragma unroll
                for (int m = 0; m < 4; ++m)
#pragma unroll
                    for (int n = 0; n < 2; ++n) acc[a][b][m][n] = (f32x4){0.f, 0.f, 0.f, 0.f};
        cur = nxt; cA = nA; cB = nB; ++ui;
    }
    PG8_WAIT_V(0);
    if (wr == 0) PG8_BAR;
    PG8_BAR;
    if constexpr (Epi::AFTER_DRAIN) { E.fused(acc, cur, wr, wc, fr, fq, lds, wid, lane); S.done(cur); }
    PG8_STAMP();
    if (STAMP && wid == 0) { stamps[lane] = lane < nts ? (((unsigned long long)(unsigned)ts_hi << 32) | (unsigned)ts_lo) : 0ull;
        if (lane == 62) stamps[62] = rt_entry; if (lane == 63) stamps[63] = (unsigned long long)wall_clock64(); }
#undef PG8_STAMP
#undef PG8_SA
#undef PG8_SB
#undef PG8_STAGE
#undef PG8_LDA
#undef PG8_LDB
#undef PG8_MMA
#undef PG8_WAIT_V
#undef PG8_WAIT_L
#undef PG8_BAR
#undef PG8_SCHED
}
}

DEV float fsig(float x) { return __builtin_amdgcn_rcpf(1.f + __expf(-x)); }
DEV u32x4 pack8(f32x4 a, f32x4 b) { u32x4 w; w.x = pg8::cvt_pk_bf16(a[0], a[1]); w.y = pg8::cvt_pk_bf16(a[2], a[3]); w.z = pg8::cvt_pk_bf16(b[0], b[1]); w.w = pg8::cvt_pk_bf16(b[2], b[3]); return w; }

DEV float row_rstd_q(const float* part, int row, int fq) {
    const f32x4 a = *(const f32x4*)(part + (size_t)row * 16 + fq * 4);
    float ss = (a[0] + a[1]) + (a[2] + a[3]);
    ss += __shfl_xor(ss, 16); ss += __shfl_xor(ss, 32);
    return rsqrtf(ss * (1.0f / 1024.0f) + 1e-6f);
}
struct EpiSwiglu {
    static constexpr bool PERM = true, AFTER_DRAIN = false;
    bf16_t* hid; const float* part;
    __device__ __forceinline__ void operator()(const f32x4 (&acc)[2][2][4][2], const pg8::Unit& u, int wr, int wc, int fr, int fq) const {
#pragma unroll
        for (int ai = 0; ai < 2; ++ai)
#pragma unroll
            for (int m = 0; m < 4; ++m) {
                __builtin_amdgcn_sched_barrier(0);
                const int row = u.pm * 256 + ai * 128 + wr * 64 + m * 16 + fr;
                const float rs = row_rstd_q(part, row, fq);
                f32x4 o[2];
#pragma unroll
                for (int n = 0; n < 2; ++n)
#pragma unroll
                    for (int e = 0; e < 4; ++e) { const float g = acc[ai][0][m][n][e] * rs, up = acc[ai][1][m][n][e] * rs; o[n][e] = g * fsig(g) * up; }
                *(u32x4*)(hid + (size_t)row * DFF + u.pn * 128 + wc * 32 + fq * 8) = pack8(o[0], o[1]);
            }
    }
};
struct EpiResid {
    static constexpr bool PERM = true, AFTER_DRAIN = false;
    float* h; bf16_t* hb; float* part; float scale;
    __device__ __forceinline__ void operator()(const f32x4 (&acc)[2][2][4][2], const pg8::Unit& u, int wr, int wc, int fr, int fq) const {
#pragma unroll
        for (int ai = 0; ai < 2; ++ai)
#pragma unroll
            for (int m = 0; m < 4; ++m) {
                __builtin_amdgcn_sched_barrier(0);
                const int row = u.pm * 256 + ai * 128 + wr * 64 + m * 16 + fr;
                float ss = 0.f;
#pragma unroll
                for (int bj = 0; bj < 2; ++bj) {
                    const int col = u.pn * 256 + bj * 128 + wc * 32 + fq * 8;
                    float* hp = h + (size_t)row * DM + col;
                    f32x4 h0 = *(const f32x4*)hp, h1 = *(const f32x4*)(hp + 4);
                    h0 += acc[ai][bj][m][0] * scale; h1 += acc[ai][bj][m][1] * scale;
                    *(f32x4*)hp = h0; *(f32x4*)(hp + 4) = h1;
                    *(u32x4*)(hb + (size_t)row * DM + col) = pack8(h0, h1);
                    ss += (h0[0] * h0[0] + h0[1] * h0[1]) + (h0[2] * h0[2] + h0[3] * h0[3]) + (h1[0] * h1[0] + h1[1] * h1[1]) + (h1[2] * h1[2] + h1[3] * h1[3]);
                }
                ss += __shfl_xor(ss, 16); ss += __shfl_xor(ss, 32);
                if (fq == 0) part[(size_t)row * 16 + u.pn * 4 + wc] = ss;
            }
    }
};
struct EpiP {
    static constexpr bool PERM = true, AFTER_DRAIN = false;
    bf16_t* big; bf16_t* vt; const float* part;
    __device__ __forceinline__ void operator()(const f32x4 (&acc)[2][2][4][2], const pg8::Unit& u, int wr, int wc, int fr, int fq) const {
#pragma unroll
        for (int ai = 0; ai < 2; ++ai)
#pragma unroll
            for (int m = 0; m < 4; ++m) {
                __builtin_amdgcn_sched_barrier(0);
                const int row = u.pm * 256 + ai * 128 + wr * 64 + m * 16 + fr;
                const float rs = row_rstd_q(part, row, fq);
#pragma unroll
                for (int bj = 0; bj < 2; ++bj) {
                    const int col = u.pn * 256 + bj * 128 + wc * 32 + fq * 8;
                    const f32x4 a0 = acc[ai][bj][m][0] * rs, a1 = acc[ai][bj][m][1] * rs;
                    const u32x4 w = pack8(a0, a1);
                    *(u32x4*)(big + (size_t)row * DIN + col) = w;
                    if (col >= C_V && row < MTOK) {
                        const int hh = (col - C_V) >> 6, d = (col - C_V) & 63;
                        int b, pos;
                        if (row < MMAIN) { b = row >> 11; pos = (row & 2047) + NMETA; } else { b = (row - MMAIN) >> 4; pos = (row - MMAIN) & 15; }
                        bf16_t* vp = vt + ((size_t)((b * 6 + hh) * 64 + d)) * LPV + pos;
#pragma unroll
                        for (int e = 0; e < 4; ++e) { vp[(size_t)(2 * e) * LPV] = (bf16_t)(w[e] & 0xFFFFu); vp[(size_t)(2 * e + 1) * LPV] = (bf16_t)(w[e] >> 16); }
                    }
                }
            }
    }
};
template <class Epi>
DEV void gemm_big(const bf16_t* A, const bf16_t* Bt, int M, int N, int K, const Epi& E, int bid, int nblk, unsigned char* smem) {
    pg8::StaticOrder S; S.init(M, N, nblk, bid);
    const pg8::Gemm g{A, Bt, M, N, K};
    pg8::gemm_phase<Epi, pg8::StaticOrder, false>((PG8_LAS unsigned char*)smem, g, S, E, nullptr);
}

DEV void phase_conv(CP& p, int l, int bid, int nblk, float* lds) {
    float* cS = lds;
    float* yS = lds + 46 * 256;
    const int tid = tid_(), ch = tid & 255, half = tid >> 8, lane = tid & 63, wave = tid >> 6;
    float wreg[31];
#pragma unroll
    for (int j = 0; j < 31; ++j) wreg[j] = p.conv_w[(size_t)l * 31 * 256 + j * 256 + ch];
    const float cb = p.conv_b[l * 256 + ch];
    for (int it = bid; it < NB * 129; it += nblk) {
        const int b = it / 129, p0 = (it % 129) * 16;
        __syncthreads();
#pragma unroll
        for (int q = 0; q < 3; ++q) {
            const int e = tid + q * 512;
            if (e < 46 * 32) {
                const int pp = e >> 5, c8 = (e & 31) * 8, pos = p0 - 30 + pp;
                f32x4 o0 = (f32x4){0.f, 0.f, 0.f, 0.f}, o1 = o0;
                if (pos >= 0) {
                    const bf16_t* rp = p.big + (size_t)row_of(b, pos) * DIN + c8;
                    const u32x4 vw = *(const u32x4*)rp, gw = *(const u32x4*)(rp + 256);
#pragma unroll
                    for (int j = 0; j < 2; ++j) {
                        o0[2 * j] = __uint_as_float(vw[j] << 16) * fsig(__uint_as_float(gw[j] << 16));
                        o0[2 * j + 1] = __uint_as_float(vw[j] & 0xFFFF0000u) * fsig(__uint_as_float(gw[j] & 0xFFFF0000u));
                        o1[2 * j] = __uint_as_float(vw[2 + j] << 16) * fsig(__uint_as_float(gw[2 + j] << 16));
                        o1[2 * j + 1] = __uint_as_float(vw[2 + j] & 0xFFFF0000u) * fsig(__uint_as_float(gw[2 + j] & 0xFFFF0000u));
                    }
                }
                *(f32x4*)(cS + pp * 256 + c8) = o0; *(f32x4*)(cS + pp * 256 + c8 + 4) = o1;
            }
        }
        __syncthreads();
#pragma unroll
        for (int i = 0; i < 8; ++i) {
            const int ii = half * 8 + i;
            float acc = cb;
#pragma unroll
            for (int j = 0; j < 31; ++j) acc += wreg[j] * cS[(ii + j) * 256 + ch];
            yS[ii * 256 + ch] = acc;
        }
        __syncthreads();
#pragma unroll
        for (int q = 0; q < 2; ++q) {
            const int ii = wave * 2 + q;
            const f32x4 v = *(const f32x4*)(yS + ii * 256 + lane * 4);
            const float mu = wave_sum_fast((v[0] + v[1]) + (v[2] + v[3])) * (1.f / 256.f);
            const f32x4 d = v - mu;
            const float var = wave_sum_fast(d[0] * d[0] + d[1] * d[1] + d[2] * d[2] + d[3] * d[3]) * (1.f / 256.f);
            const float rs = rsqrtf(var + 1e-5f);
            const f32x4 g = *(const f32x4*)(p.conv_ln_g + l * 256 + lane * 4), bb = *(const f32x4*)(p.conv_ln_b + l * 256 + lane * 4);
            float o[4];
#pragma unroll
            for (int e = 0; e < 4; ++e) { const float yn = d[e] * rs * g[e] + bb[e]; o[e] = yn * sigm(yn); }
            u32x2 w; w.x = pack2(o[0], o[1]); w.y = pack2(o[2], o[3]);
            *(u32x2*)(p.y + (size_t)row_of(b, p0 + ii) * DM + lane * 4) = w;
        }
    }
}

DEV void phase_rwkv_prep(CP& p, int l, int bid, int nblk, float* lds) {
    bf16_t* X = (bf16_t*)lds;
    constexpr int XS = 264;
    const int tid = tid_(), lane = tid & 63, wave = tid >> 6, fr = lane & 15, fq = lane >> 4;
    const float* mu = p.rwkv_mu + (size_t)l * 1408;
    for (int it = bid; it < MTOK / 64; it += nblk) {
        __syncthreads();
        {
            const int rr = tid >> 3, c0 = (tid & 7) * 32, row = it * 64 + rr;
            int b, pos;
            if (row < MMAIN) { b = row >> 11; pos = (row & 2047) + NMETA; } else { b = (row - MMAIN) >> 4; pos = (row - MMAIN) & 15; }
            const bf16_t* cp = p.big + (size_t)row * DIN + C_RW + 1152 + c0;
            const bf16_t* pp = p.big + (size_t)row_of(b, pos > 0 ? pos - 1 : 0) * DIN + C_RW + 1152 + c0;
#pragma unroll
            for (int q = 0; q < 4; ++q) {
                const u32x4 cw = *(const u32x4*)(cp + q * 8);
                u32x4 pw = *(const u32x4*)(pp + q * 8);
                if (pos == 0) pw = (u32x4){0u, 0u, 0u, 0u};
                const int c = c0 + q * 8;
                const f32x4 m0 = *(const f32x4*)(mu + 1152 + c), m1 = *(const f32x4*)(mu + 1152 + c + 4);
                float xs[8];
#pragma unroll
                for (int j = 0; j < 4; ++j) {
                    const float a0 = __uint_as_float(cw[j] << 16), a1 = __uint_as_float(cw[j] & 0xFFFF0000u);
                    const float q0 = __uint_as_float(pw[j] << 16), q1 = __uint_as_float(pw[j] & 0xFFFF0000u);
                    const float ma = j < 2 ? m0[2 * j] : m1[2 * j - 4], mb = j < 2 ? m0[2 * j + 1] : m1[2 * j - 3];
                    xs[2 * j] = a0 + ma * (q0 - a0); xs[2 * j + 1] = a1 + mb * (q1 - a1);
                }
#pragma unroll
                for (int j = 0; j < 8; ++j) { if (c < 64) xs[j] = tanhf(xs[j]); else if (c >= 128) xs[j] = fsig(xs[j]); }
                u32x4 w; w.x = cvt2(xs[0], xs[1]); w.y = cvt2(xs[2], xs[3]); w.z = cvt2(xs[4], xs[5]); w.w = cvt2(xs[6], xs[7]);
                *(u32x4*)(X + rr * XS + c) = w;
            }
        }
        __syncthreads();
        const int rt = wave & 3, chalf = wave >> 2;
        bf16x8 af[8];
#pragma unroll
        for (int ks = 0; ks < 8; ++ks) af[ks] = *(const bf16x8*)(X + (rt * 16 + fr) * XS + ks * 32 + fq * 8);
        const int row = it * 64 + rt * 16 + fr;
        int prow; bool has_prev;
        {
            int b, pos;
            if (row < MMAIN) { b = row >> 11; pos = (row & 2047) + NMETA; } else { b = (row - MMAIN) >> 4; pos = (row - MMAIN) & 15; }
            has_prev = pos > 0; prow = row_of(b, has_prev ? pos - 1 : 0);
        }
        float ssq = 0.f, ctp = 0.f;
        for (int nt = chalf * 12; nt < chalf * 12 + 12; ++nt) {
            const bf16_t* wb = p.Wl + (size_t)(nt * 16 + fr) * 64 + fq * 8;
            const bf16_t* ab = p.Wl + DRW * 64 + (size_t)(nt * 16 + fr) * 64 + fq * 8;
            const bf16_t* gb = p.Wl + DRW * 128 + (size_t)(nt * 16 + fr) * 128 + fq * 8;
            f32x4 cw = (f32x4){0.f, 0.f, 0.f, 0.f}, ca = cw, cg = cw;
#pragma unroll
            for (int ks = 0; ks < 2; ++ks) {
                cw = __builtin_amdgcn_mfma_f32_16x16x32_bf16(*(const bf16x8*)(wb + ks * 32), af[ks], cw, 0, 0, 0);
                ca = __builtin_amdgcn_mfma_f32_16x16x32_bf16(*(const bf16x8*)(ab + ks * 32), af[2 + ks], ca, 0, 0, 0);
            }
#pragma unroll
            for (int ks = 0; ks < 4; ++ks) cg = __builtin_amdgcn_mfma_f32_16x16x32_bf16(*(const bf16x8*)(gb + ks * 32), af[4 + ks], cg, 0, 0, 0);
            const int col = nt * 16 + 4 * fq;
            const f32x4 w0 = *(const f32x4*)(p.rwkv_w0 + l * DRW + col), a0 = *(const f32x4*)(p.rwkv_a0 + l * DRW + col);
            f32x4 olw, oaa;
#pragma unroll
            for (int j = 0; j < 4; ++j) {
                const float xw = -(w0[j] + cw[j]);
                const float sp = fmaxf(xw, 0.f) + __logf(1.f + __expf(-fabsf(xw)));
                olw[j] = -__expf(-sp - 0.5f);
                oaa[j] = fsig(a0[j] + ca[j]);
            }
            const size_t o = (size_t)row * DRW + col;
            *(f32x4*)(p.lw + o) = olw; *(f32x4*)(p.aa + o) = oaa; *(f32x4*)(p.gg + o) = cg;
            {
                const u32x2 rc = *(const u32x2*)(p.big + (size_t)row * DIN + C_RW + col), kc = *(const u32x2*)(p.big + (size_t)row * DIN + C_RW + 384 + col);
                u32x2 rp = *(const u32x2*)(p.big + (size_t)prow * DIN + C_RW + col), kq = *(const u32x2*)(p.big + (size_t)prow * DIN + C_RW + 384 + col);
                if (!has_prev) { rp = (u32x2){0u, 0u}; kq = (u32x2){0u, 0u}; }
                const f32x4 mr4 = *(const f32x4*)(mu + col), mk4 = *(const f32x4*)(mu + 384 + col);
                const f32x4 kk4 = *(const f32x4*)(p.rwkv_kk + l * DRW + col), ka4 = *(const f32x4*)(p.rwkv_ka + l * DRW + col), rk4 = *(const f32x4*)(p.rwkv_rk + l * DRW + col);
#pragma unroll
                for (int j = 0; j < 4; ++j) {
                    const unsigned rcw = rc[j >> 1], kcw = kc[j >> 1], rpw = rp[j >> 1], kpw = kq[j >> 1];
                    const float r0 = (j & 1) ? __uint_as_float(rcw & 0xFFFF0000u) : __uint_as_float(rcw << 16);
                    const float k0 = (j & 1) ? __uint_as_float(kcw & 0xFFFF0000u) : __uint_as_float(kcw << 16);
                    const float r1 = (j & 1) ? __uint_as_float(rpw & 0xFFFF0000u) : __uint_as_float(rpw << 16);
                    const float k1 = (j & 1) ? __uint_as_float(kpw & 0xFFFF0000u) : __uint_as_float(kpw << 16);
                    const float r = r0 + mr4[j] * (r1 - r0), k = k0 + mk4[j] * (k1 - k0);
                    const float kkr = k * kk4[j];
                    ssq += kkr * kkr;
                    ctp += r * (k * (1.f + (oaa[j] - 1.f) * ka4[j])) * rk4[j];
                }
                if ((nt & 3) == 3) {
                    ssq += __shfl_xor(ssq, 16); ssq += __shfl_xor(ssq, 32);
                    ctp += __shfl_xor(ctp, 16); ctp += __shfl_xor(ctp, 32);
                    if (fq == 0) { p.inorm[(size_t)row * 8 + (nt >> 2)] = __builtin_amdgcn_rsqf(fmaxf(ssq, 1e-24f)); p.ct[(size_t)row * 8 + (nt >> 2)] = ctp; }
                    ssq = 0.f; ctp = 0.f;
                }
            }
        }
    }
}

DEV void phase_rwkv_scan(CP& p, int l, int bid, int nblk, float* lds) {
    float* rS = lds;
    float* wS = rS + 1024;
    float* kS = wS + 1024;
    float* vS = kS + 1024;
    float* nS = vS + 1024;
    float* bS = nS + 1024;
    float* gS = bS + 1024;
    float* oS = gS + 1024;
    float* cS = oS + 1024;
    const int tid = tid_(), lane = tid & 63, wave = tid >> 6;
    const int vi = tid >> 3, ks = tid & 7;
    const float* mu = p.rwkv_mu + (size_t)l * 1408;
    for (int it = bid; it < NB * 6; it += nblk) {
        const int b = it / 6, hh = it % 6;
        float S[8];
#pragma unroll
        for (int i = 0; i < 8; ++i) S[i] = 0.f;
        const int hc = hh * 64 + lane;
        const float mr = mu[hc], mk = mu[384 + hc], mv = mu[768 + hc];
        const float kkw = p.rwkv_kk[l * DRW + hc], kaw = p.rwkv_ka[l * DRW + hc], rkw = p.rwkv_rk[l * DRW + hc];
        const float lng = p.rwkv_ln_g[l * DRW + hc], lnb = p.rwkv_ln_b[l * DRW + hc];
        for (int ck = 0; ck < 129; ++ck) {
            const int p0 = ck * 16;
            __syncthreads();
#pragma unroll
            for (int q = 0; q < 2; ++q) {
                const int tk = wave * 2 + q, pos = p0 + tk;
                const int row = row_of(b, pos);
                const bf16_t* cur = p.big + (size_t)row * DIN + C_RW + hc;
                float r = bf2f(cur[0]), k = bf2f(cur[384]), v = bf2f(cur[768]);
                float pr = 0.f, pk = 0.f, pv = 0.f;
                if (pos > 0) { const bf16_t* prv = p.big + (size_t)row_of(b, pos - 1) * DIN + C_RW + hc; pr = bf2f(prv[0]); pk = bf2f(prv[384]); pv = bf2f(prv[768]); }
                r += mr * (pr - r); k += mk * (pk - k); v += mv * (pv - v);
                const size_t o = (size_t)row * DRW + hc;
                const float a = p.aa[o], w = expf(p.lw[o]), g = p.gg[o];
                const float kkr = k * kkw;
                const float nrm = fmaxf(sqrtf(wave_sum(kkr * kkr)), 1e-12f);
                const float kk = kkr / nrm;
                const float kp = k * (1.f + (a - 1.f) * kaw);
                const float ct = wave_sum(r * kp * rkw);
                const int e = tk * 64 + lane;
                rS[e] = r; wS[e] = w; kS[e] = kp; vS[e] = v; nS[e] = kk; bS[e] = kk * a; gS[e] = g;
                if (lane == 0) cS[tk] = ct;
            }
            __syncthreads();
            for (int tk = 0; tk < 16; ++tk) {
                const int e = tk * 64 + ks * 8;
                const f32x4 n0 = *(const f32x4*)(nS + e), n1 = *(const f32x4*)(nS + e + 4);
                float sa = 0.f;
#pragma unroll
                for (int i = 0; i < 4; ++i) { sa -= S[i] * n0[i]; sa -= S[4 + i] * n1[i]; }
                sa += __shfl_xor(sa, 1); sa += __shfl_xor(sa, 2); sa += __shfl_xor(sa, 4);
                const f32x4 w0 = *(const f32x4*)(wS + e), w1 = *(const f32x4*)(wS + e + 4);
                const f32x4 b0 = *(const f32x4*)(bS + e), b1 = *(const f32x4*)(bS + e + 4);
                const f32x4 k0 = *(const f32x4*)(kS + e), k1 = *(const f32x4*)(kS + e + 4);
                const f32x4 r0 = *(const f32x4*)(rS + e), r1 = *(const f32x4*)(rS + e + 4);
                const float vv = vS[tk * 64 + vi];
                float o = 0.f;
#pragma unroll
                for (int i = 0; i < 4; ++i) {
                    S[i] = S[i] * w0[i] + sa * b0[i] + vv * k0[i];
                    S[4 + i] = S[4 + i] * w1[i] + sa * b1[i] + vv * k1[i];
                    o += S[i] * r0[i]; o += S[4 + i] * r1[i];
                }
                o += __shfl_xor(o, 1); o += __shfl_xor(o, 2); o += __shfl_xor(o, 4);
                if (ks == 0) oS[tk * 64 + vi] = o;
            }
            __syncthreads();
#pragma unroll
            for (int q = 0; q < 2; ++q) {
                const int tk = wave * 2 + q, e = tk * 64 + lane;
                const float o = oS[e];
                const float m = wave_sum(o) * (1.f / 64.f);
                const float d = o - m;
                const float var = wave_sum(d * d) * (1.f / 64.f);
                float yv = d * rsqrtf(var + 64e-5f) * lng + lnb;
                yv = (yv + cS[tk] * vS[e]) * gS[e];
                p.y[(size_t)row_of(b, p0 + tk) * DM + 256 + hc] = f2bf(yv);
            }
        }
    }
}

constexpr int TCH = 32, NCH = 65;
struct ScanRegs { unsigned short r[8], k[8], v[8]; unsigned short pr, pk, pv; float a[8], lw[8], inr[8]; };
DEV void scan_issue(CP& p, ScanRegs& R, int b, int hc, int c, int lwv) {
#pragma unroll
    for (int q = 0; q < 8; ++q) {
        const int pos = c * TCH + lwv * 8 + q;
        R.r[q] = 0; R.k[q] = 0; R.v[q] = 0; R.a[q] = 0.f; R.lw[q] = 0.f; R.inr[q] = 0.f;
        if (pos < LT) {
            const int row = row_of(b, pos);
            const bf16_t* cur = p.big + (size_t)row * DIN + C_RW + hc;
            R.r[q] = cur[0]; R.k[q] = cur[384]; R.v[q] = cur[768];
            R.a[q] = p.aa[(size_t)row * DRW + hc]; R.lw[q] = p.lw[(size_t)row * DRW + hc]; R.inr[q] = p.inorm[(size_t)row * 8 + (hc >> 6)];
        }
    }
    const int pp = c * TCH + lwv * 8 - 1;
    R.pr = 0; R.pk = 0; R.pv = 0;
    if (pp >= 0) { const bf16_t* prv = p.big + (size_t)row_of(b, pp) * DIN + C_RW + hc; R.pr = prv[0]; R.pk = prv[384]; R.pv = prv[768]; }
}
DEV void phase_rwkv_scan2(CP& p, int l, int item, float* lds) {
    const int tid = tid_(), lane = tid & 63;
    const int b = item / 24, hh = (item >> 2) % 6, rq = item & 3;
    constexpr int CB = 10752, OPB = 2 * CB;
    if (tid >= 256) {
        const int lt = tid - 256, lwv = lt >> 6, hc = hh * 64 + lane;
        const float* mu = p.rwkv_mu + (size_t)l * 1408;
        const float mr = mu[hc], mk = mu[384 + hc], mv = mu[768 + hc];
        const float kkw = p.rwkv_kk[l * DRW + hc], kaw = p.rwkv_ka[l * DRW + hc];
        ScanRegs R;
        scan_issue(p, R, b, hc, 0, lwv);
        for (int c = 0; c <= NCH + 1; ++c) {
            if (c < NCH) {
                float* buf = lds + (c & 1) * CB;
                float pr = bf2f(R.pr), pk = bf2f(R.pk), pv = bf2f(R.pv);
#pragma unroll
                for (int q = 0; q < 8; ++q) {
                    const int tk = lwv * 8 + q;
                    const float r0 = bf2f(R.r[q]), k0 = bf2f(R.k[q]), v0 = bf2f(R.v[q]);
                    const float r = r0 + mr * (pr - r0), k = k0 + mk * (pk - k0), v = v0 + mv * (pv - v0);
                    pr = r0; pk = k0; pv = v0;
                    const float a = R.a[q], w = __expf(R.lw[q]);
                    const float kk = k * kkw * R.inr[q];
                    const float kp = k * (1.f + (a - 1.f) * kaw);
                    const int e = tk * 64 + lane;
                    buf[e] = r; buf[2048 + e] = w; buf[4096 + e] = kp; buf[6144 + e] = kk; buf[8192 + e] = kk * a;
                    if ((lane >> 4) == rq) buf[10240 + tk * 16 + (lane & 15)] = v;
                }
                if (c + 1 < NCH) scan_issue(p, R, b, hc, c + 1, lwv);
            }
            if (c >= 2) {
                const int cc = c - 2;
                const float* op = lds + OPB + (cc & 1) * 8192;
#pragma unroll
                for (int q = 0; q < 2; ++q) {
                    const int oi = lt * 2 + q, tk = oi >> 4, vi = oi & 15;
                    const f32x4 a0 = *(const f32x4*)(op + tk * 256 + vi * 16), a1 = *(const f32x4*)(op + tk * 256 + vi * 16 + 4);
                    const f32x4 a2 = *(const f32x4*)(op + tk * 256 + vi * 16 + 8), a3 = *(const f32x4*)(op + tk * 256 + vi * 16 + 12);
                    const f32x4 sm = (a0 + a1) + (a2 + a3);
                    const int pos = cc * TCH + tk;
                    if (pos < LT) p.oraw[(size_t)row_of(b, pos) * DRW + hh * 64 + rq * 16 + vi] = (sm[0] + sm[1]) + (sm[2] + sm[3]);
                }
            }
            asm volatile("s_waitcnt lgkmcnt(0)" ::: "memory");
            __builtin_amdgcn_s_barrier();
            asm volatile("" ::: "memory");
        }
    } else {
        const int vi = tid >> 4, ks = tid & 15;
        float S0 = 0.f, S1 = 0.f, S2 = 0.f, S3 = 0.f;
        asm volatile("s_waitcnt lgkmcnt(0)" ::: "memory"); __builtin_amdgcn_s_barrier(); asm volatile("" ::: "memory");
        for (int c = 0; c <= NCH; ++c) {
            if (c < NCH) {
                const float* buf = lds + (c & 1) * CB;
                float* op = lds + OPB + (c & 1) * 8192 + tid;
                const int nst = (LT - c * TCH) < TCH ? (LT - c * TCH) : TCH;
#define SCAN_LOAD(R4, W4, K4, N4, B4, VV, TK) { const int e_ = ((TK) & 31) * 64 + ks * 4; R4 = *(const f32x4*)(buf + e_); W4 = *(const f32x4*)(buf + 2048 + e_); K4 = *(const f32x4*)(buf + 4096 + e_); \
                N4 = *(const f32x4*)(buf + 6144 + e_); B4 = *(const f32x4*)(buf + 8192 + e_); VV = buf[10240 + ((TK) & 31) * 16 + vi]; }
#define SCAN_STEP(R4, W4, K4, N4, B4, VV, TK) { \
                float sa = (S0 * N4[0] + S1 * N4[1]) + (S2 * N4[2] + S3 * N4[3]); \
                const float t0 = S0 * W4[0] + VV * K4[0], t1 = S1 * W4[1] + VV * K4[1], t2 = S2 * W4[2] + VV * K4[2], t3 = S3 * W4[3] + VV * K4[3]; \
                sa = -dpp_sum16(sa); \
                S0 = t0 + sa * B4[0]; S1 = t1 + sa * B4[1]; S2 = t2 + sa * B4[2]; S3 = t3 + sa * B4[3]; \
                op[(TK) * 256] = (S0 * R4[0] + S1 * R4[1]) + (S2 * R4[2] + S3 * R4[3]); }
                f32x4 rA, wA, kA, nA, bA, rB, wB, kB, nB, bB; float vA, vB;
                SCAN_LOAD(rA, wA, kA, nA, bA, vA, 0);
                for (int tk = 0; tk < nst; tk += 2) {
                    SCAN_LOAD(rB, wB, kB, nB, bB, vB, tk + 1);
                    SCAN_STEP(rA, wA, kA, nA, bA, vA, tk);
                    SCAN_LOAD(rA, wA, kA, nA, bA, vA, tk + 2);
                    SCAN_STEP(rB, wB, kB, nB, bB, vB, tk + 1);
                }
#undef SCAN_LOAD
#undef SCAN_STEP
            }
            asm volatile("s_waitcnt lgkmcnt(0)" ::: "memory");
            __builtin_amdgcn_s_barrier();
            asm volatile("" ::: "memory");
        }
    }
}
DEV void phase_rwkv_post(CP& p, int l, int bid, int nblk) {
    const int tid = tid_(), lane = tid & 63, wave = tid >> 6;
    const float* mu = p.rwkv_mu + (size_t)l * 1408;
    for (int tok = bid * 8 + wave; tok < NB * LT; tok += nblk * 8) {
        const int b = tok / LT, pos = tok % LT;
        const int row = row_of(b, pos), prow = row_of(b, pos > 0 ? pos - 1 : 0);
        float o[6], v0[6], pv[6], g[6], ct[6];
#pragma unroll
        for (int hh = 0; hh < 6; ++hh) {
            const int hc = hh * 64 + lane;
            o[hh] = p.oraw[(size_t)row * DRW + hc];
            v0[hh] = bf2f(p.big[(size_t)row * DIN + C_RW + 768 + hc]);
            pv[hh] = bf2f(p.big[(size_t)prow * DIN + C_RW + 768 + hc]);
            g[hh] = p.gg[(size_t)row * DRW + hc];
            ct[hh] = p.ct[(size_t)row * 8 + hh];
        }
#pragma unroll
        for (int hh = 0; hh < 6; ++hh) {
            const int hc = hh * 64 + lane;
            const float pvv = pos > 0 ? pv[hh] : 0.f;
            const float v = v0[hh] + mu[768 + hc] * (pvv - v0[hh]);
            const float m = wave_sum_fast(o[hh]) * (1.f / 64.f);
            const float d = o[hh] - m;
            const float var = wave_sum_fast(d * d) * (1.f / 64.f);
            float yv = d * rsqrtf(var + 64e-5f) * p.rwkv_ln_g[l * DRW + hc] + p.rwkv_ln_b[l * DRW + hc];
            yv = (yv + ct[hh] * v) * g[hh];
            p.y[(size_t)row * DM + 256 + hc] = f2bf(yv);
        }
    }
}

DEV void phase_sb(CP& p, int l, int bid, int nblk, float* lds) {
    float* Ks = lds;
    float* Vs = lds + 2048;
    const int tid = tid_(), qi = tid >> 1, hf = tid & 1;
    for (int it = bid; it < NB * 6 * 9; it += nblk) {
        const int qt = it % 9, bh = it / 9, b = bh / 6, hh = bh % 6;
        const int t = qt * 256 + qi;
        const bool valid = t < LT;
        const int myrow = row_of(b, valid ? t : 0);
        float q[64], acc[32];
        {
            const bf16_t* qp = p.big + (size_t)myrow * DIN + C_Q + hh * 64;
#pragma unroll
            for (int i = 0; i < 8; ++i) {
                const u32x4 w = *(const u32x4*)(qp + i * 8);
#pragma unroll
                for (int e = 0; e < 4; ++e) { q[i * 8 + 2 * e] = __uint_as_float(w[e] << 16) * 0.125f; q[i * 8 + 2 * e + 1] = __uint_as_float(w[e] & 0xFFFF0000u) * 0.125f; }
            }
        }
#pragma unroll
        for (int d = 0; d < 32; ++d) acc[d] = 0.f;
        float carry = 0.f;
        int thi = qt * 256 + 254; if (thi > LT - 2) thi = LT - 2;
        for (int kt = thi >> 5; kt >= 0; --kt) {
            __syncthreads();
            {
                const int which = tid >> 8, key = (tid & 255) >> 3, part = tid & 7, s = kt * 32 + key;
                float f[8];
#pragma unroll
                for (int e = 0; e < 8; ++e) f[e] = 0.f;
                if (s < LT) {
                    const u32x4 w = *(const u32x4*)(p.big + (size_t)row_of(b, s) * DIN + (which ? C_V : C_K) + hh * 64 + part * 8);
#pragma unroll
                    for (int e = 0; e < 4; ++e) { f[2 * e] = __uint_as_float(w[e] << 16); f[2 * e + 1] = __uint_as_float(w[e] & 0xFFFF0000u); }
                }
                float* dst = (which ? Vs : Ks) + key * 64 + part * 8;
                *(f32x4*)dst = (f32x4){f[0], f[1], f[2], f[3]};
                *(f32x4*)(dst + 4) = (f32x4){f[4], f[5], f[6], f[7]};
            }
            __syncthreads();
            for (int kk = 31; kk >= 0; --kk) {
                const int s = kt * 32 + kk;
                if (valid && s < t) {
                    float z0 = 0.f, z1 = 0.f;
#pragma unroll
                    for (int i = 0; i < 16; ++i) {
                        if ((i & 3) == 0) asm volatile("" ::: "memory");
                        const f32x4 kv = *(const f32x4*)(Ks + kk * 64 + i * 4);
                        z0 += q[i * 4] * kv[0]; z1 += q[i * 4 + 1] * kv[1]; z0 += q[i * 4 + 2] * kv[2]; z1 += q[i * 4 + 3] * kv[3];
                    }
                    const float z = z0 + z1;
                    const float ls = fminf(z, 0.f) - log1pf(expf(-fabsf(z)));
                    const float a = expf(ls + carry);
                    carry += ls - z;
#pragma unroll
                    for (int i = 0; i < 8; ++i) {
                        const f32x4 vv = *(const f32x4*)(Vs + kk * 64 + hf * 32 + i * 4);
                        acc[i * 4] += a * vv[0]; acc[i * 4 + 1] += a * vv[1]; acc[i * 4 + 2] += a * vv[2]; acc[i * 4 + 3] += a * vv[3];
                    }
                }
            }
            if (__syncthreads_and((!valid || carry < -110.f) ? 1 : 0)) break;
        }
        float ms = 0.f;
#pragma unroll
        for (int d = 0; d < 32; ++d) ms += acc[d] * acc[d];
        ms += __shfl_xor(ms, 1);
        if (valid) {
            const float rs = rsqrtf(ms * (1.f / 64.f) + 1e-6f);
            const float* g = p.sb_norm + l * 384 + hh * 64 + hf * 32;
            bf16_t* yp = p.y + (size_t)myrow * DM + 640 + hh * 64 + hf * 32;
#pragma unroll
            for (int i = 0; i < 4; ++i) {
                u32x4 w;
#pragma unroll
                for (int e = 0; e < 4; ++e) w[e] = pack2(acc[i * 8 + 2 * e] * rs * g[i * 8 + 2 * e], acc[i * 8 + 2 * e + 1] * rs * g[i * 8 + 2 * e + 1]);
                *(u32x4*)(yp + i * 8) = w;
            }
        }
    }
}

DEV void phase_sb_mfma(CP& p, int l, int bid, int nblk) {
    const int tid = tid_(), lane = tid & 63, wave = tid >> 6, r = lane & 31, h = lane >> 5;
    for (int it = bid * 8 + wave; it < NB * 6 * 65; it += nblk * 8) {
        const int qt = it % 65, bh = it / 65, b = bh / 6, hh = bh % 6;
        const int q0 = qt * 32, t = q0 + r;
        const bool valid = t < LT;
        const int myrow = row_of(b, valid ? t : LT - 1);
        bf16x8 qf[4];
        {
            const bf16_t* qp = p.big + (size_t)myrow * DIN + C_Q + hh * 64 + 8 * h;
#pragma unroll
            for (int ks = 0; ks < 4; ++ks) qf[ks] = *(const bf16x8*)(qp + 16 * ks);
        }
        f32x16 o0, o1;
#pragma unroll
        for (int i = 0; i < 16; ++i) { o0[i] = 0.f; o1[i] = 0.f; }
        float carry = 0.f;
        const bf16_t* vbase = p.vt + (size_t)((b * 6 + hh) * 64 + r) * LPV + 4 * h;
        bf16x8 kf[4];
        {
            const bf16_t* kp = p.big + (size_t)row_of(b, q0 + r) * DIN + C_K + hh * 64 + 8 * h;
#pragma unroll
            for (int ks = 0; ks < 4; ++ks) kf[ks] = *(const bf16x8*)(kp + 16 * ks);
        }
        for (int k0 = q0; k0 >= 0; k0 -= 32) {
            bf16x8 vf[2][2];
#pragma unroll
            for (int db = 0; db < 2; ++db)
#pragma unroll
                for (int s = 0; s < 2; ++s) {
                    const bf16_t* vp = vbase + (size_t)(db * 32) * LPV + k0 + 16 * s;
                    const s16x4 lo = *(const s16x4*)vp, hi = *(const s16x4*)(vp + 8);
                    vf[db][s] = __builtin_shufflevector(lo, hi, 0, 1, 2, 3, 4, 5, 6, 7);
                }
            bf16x8 kn[4];
            {
                const int kpos = k0 >= 32 ? k0 - 32 + r : r;
                const bf16_t* kp = p.big + (size_t)row_of(b, kpos) * DIN + C_K + hh * 64 + 8 * h;
#pragma unroll
                for (int ks = 0; ks < 4; ++ks) kn[ks] = *(const bf16x8*)(kp + 16 * ks);
            }
            f32x16 x;
#pragma unroll
            for (int i = 0; i < 16; ++i) x[i] = 0.f;
#pragma unroll
            for (int ks = 0; ks < 4; ++ks) x = __builtin_amdgcn_mfma_f32_32x32x16_bf16(kf[ks], qf[ks], x, 0, 0, 0);
            float lr[16], ls[16];
#pragma unroll
            for (int i = 0; i < 16; ++i) {
                const int key = k0 + (i & 3) + 8 * (i >> 2) + 4 * h;
                const float z = x[i] * 0.125f;
                const float sp = __logf(1.f + __expf(-fabsf(z)));
                const float lsi = fminf(z, 0.f) - sp;
                ls[i] = lsi;
                lr[i] = key < t ? lsi - z : 0.f;
            }
            float pw[16];
            float run = carry;
#pragma unroll
            for (int g = 3; g >= 0; --g) {
                const float G = (lr[4 * g] + lr[4 * g + 1]) + (lr[4 * g + 2] + lr[4 * g + 3]);
                const float Gp = __shfl_xor(G, 32);
                const float s3 = run + (h == 0 ? Gp : 0.f);
                const float s2 = s3 + lr[4 * g + 3], s1 = s2 + lr[4 * g + 2], s0 = s1 + lr[4 * g + 1];
                const int keyb = k0 + 8 * g + 4 * h;
                pw[4 * g + 3] = keyb + 3 < t ? __expf(ls[4 * g + 3] + s3) : 0.f;
                pw[4 * g + 2] = keyb + 2 < t ? __expf(ls[4 * g + 2] + s2) : 0.f;
                pw[4 * g + 1] = keyb + 1 < t ? __expf(ls[4 * g + 1] + s1) : 0.f;
                pw[4 * g + 0] = keyb + 0 < t ? __expf(ls[4 * g + 0] + s0) : 0.f;
                run += G + Gp;
            }
            carry = run;
            const bf16x8 pf0 = pack_frag(pw[0], pw[1], pw[2], pw[3], pw[4], pw[5], pw[6], pw[7]);
            const bf16x8 pf1 = pack_frag(pw[8], pw[9], pw[10], pw[11], pw[12], pw[13], pw[14], pw[15]);
            o0 = __builtin_amdgcn_mfma_f32_32x32x16_bf16(vf[0][0], pf0, o0, 0, 0, 0);
            o0 = __builtin_amdgcn_mfma_f32_32x32x16_bf16(vf[0][1], pf1, o0, 0, 0, 0);
            o1 = __builtin_amdgcn_mfma_f32_32x32x16_bf16(vf[1][0], pf0, o1, 0, 0, 0);
            o1 = __builtin_amdgcn_mfma_f32_32x32x16_bf16(vf[1][1], pf1, o1, 0, 0, 0);
#pragma unroll
            for (int ks = 0; ks < 4; ++ks) kf[ks] = kn[ks];
            if (__all((!valid || carry < -110.f) ? 1 : 0)) break;
        }
        float ss = 0.f;
#pragma unroll
        for (int i = 0; i < 16; ++i) ss += o0[i] * o0[i] + o1[i] * o1[i];
        ss += __shfl_xor(ss, 32);
        const float rs = rsqrtf(ss * (1.f / 64.f) + 1e-6f);
        if (valid) {
            const float* g = p.sb_norm + l * 384 + hh * 64 + 4 * h;
            bf16_t* yp = p.y + (size_t)myrow * DM + 640 + hh * 64 + 4 * h;
#pragma unroll
            for (int gq = 0; gq < 4; ++gq) {
                const f32x4 g0 = *(const f32x4*)(g + 8 * gq), g1 = *(const f32x4*)(g + 32 + 8 * gq);
                u32x2 w0, w1;
                w0.x = cvt2(o0[4 * gq] * rs * g0[0], o0[4 * gq + 1] * rs * g0[1]); w0.y = cvt2(o0[4 * gq + 2] * rs * g0[2], o0[4 * gq + 3] * rs * g0[3]);
                w1.x = cvt2(o1[4 * gq] * rs * g1[0], o1[4 * gq + 1] * rs * g1[1]); w1.y = cvt2(o1[4 * gq + 2] * rs * g1[2], o1[4 * gq + 3] * rs * g1[3]);
                *(u32x2*)(yp + 8 * gq) = w0;
                *(u32x2*)(yp + 32 + 8 * gq) = w1;
            }
        }
    }
}

DEV void phase_final(CP& p, int bid, int nblk) {
    const int lane = tid_() & 63, wave = tid_() >> 6;
    for (int r = bid * 8 + wave; r < MMAIN; r += nblk * 8) {
        const float rs = row_rstd(p.part, r);
#pragma unroll
        for (int i = 0; i < 4; ++i) {
            const int c = (i * 64 + lane) * 4;
            const f32x4 v = *(const f32x4*)(p.h + (size_t)r * DM + c), g = *(const f32x4*)(p.final_norm + c);
            *(f32x4*)(p.out + (size_t)r * DM + c) = v * rs * g;
        }
    }
}

#define XB_TMO      128
#define XB_XCNT(j)  (256  + 64 * (j))
#define XB_XSUB(j)  (1280 + 64 * (j))
#define XB_XGEN(j)  (2304 + 64 * (j))
#define XB_TOP      3328
#define XB_TOPGEN   3392
#define XCD_BAR_WORDS 3456
#define XB_SPIN_CAP (1u << 18)
#define XB_LAS __attribute__((address_space(3)))

__device__ __forceinline__ unsigned xb_ld(unsigned* p)              { return __hip_atomic_load(p, __ATOMIC_RELAXED, __HIP_MEMORY_SCOPE_AGENT); }
__device__ __forceinline__ unsigned xb_add(unsigned* p, unsigned v) { return __hip_atomic_fetch_add(p, v, __ATOMIC_RELAXED, __HIP_MEMORY_SCOPE_AGENT); }
__device__ __forceinline__ unsigned xb_xcc_id() { return (unsigned)__builtin_amdgcn_s_getreg((3 << 11) | 20) & 0xFu; }
#define XB_SPIN(cond, bar) do { unsigned _sp = 0; while (cond) { __builtin_amdgcn_s_sleep(1); \
    if ((++_sp & 255u) == 0u) { if (xb_ld(&(bar)[XB_TMO])) break; if (_sp > XB_SPIN_CAP) { atomicAdd(&(bar)[XB_TMO], 1u); break; } } } } while (0)

struct XcdBarrier {
    unsigned* bar; unsigned x;
    volatile XB_LAS unsigned* st;
};

__device__ __forceinline__ XcdBarrier xcd_barrier_post(unsigned* bar, volatile XB_LAS unsigned* st) {
    XcdBarrier b; b.bar = bar; b.x = xb_xcc_id(); b.st = st;
    if (threadIdx.x == 0) (void)xb_add(&bar[XB_XCNT(b.x)], 1u);
    return b;
}
__device__ __forceinline__ void xcd_barrier_complete(unsigned* bar, unsigned x, unsigned& nloc, unsigned& nx) {
    const unsigned G = gridDim.x * gridDim.y * gridDim.z;
    unsigned sum, cnt, mine, sp = 0u;
    for (;;) {
        sum = 0u; cnt = 0u; mine = 0u;
#pragma unroll
        for (unsigned j = 0; j < 16; ++j) { const unsigned c = xb_ld(&bar[XB_XCNT(j)]); sum += c; cnt += (c > 0u) ? 1u : 0u; mine = (j == x) ? c : mine; }
        if (sum == G) break;
        __builtin_amdgcn_s_sleep(1);
        if ((++sp & 255u) == 0u) { if (xb_ld(&bar[XB_TMO])) break; if (sp > XB_SPIN_CAP) { atomicAdd(&bar[XB_TMO], 1u); break; } }
    }
    nloc = mine > 0u ? mine : 1u; nx = cnt > 0u ? cnt : 1u;
}

__device__ __forceinline__ void xcd_barrier(const XcdBarrier& b) {
    asm volatile("s_waitcnt vmcnt(0)" ::: "memory");
    __syncthreads();
    if (threadIdx.x == 0) {
        unsigned* bar = b.bar;
        __builtin_amdgcn_s_waitcnt(0);
        unsigned nloc = b.st[0], nx = b.st[1];
        if (nloc == 0u) { xcd_barrier_complete(bar, b.x, nloc, nx); b.st[0] = nloc; b.st[1] = nx; }
        const unsigned old = xb_add(&bar[XB_XSUB(b.x)], 1u);
        const unsigned gen = old / nloc;
        if (old + 1u == (gen + 1u) * nloc) {
            __builtin_amdgcn_fence(__ATOMIC_RELEASE, "agent");
            asm volatile("s_waitcnt vmcnt(0)" ::: "memory");
            const unsigned og = xb_add(&bar[XB_TOP], 1u);
            const unsigned tg = og / nx;
            if (og + 1u == (tg + 1u) * nx) xb_add(&bar[XB_TOPGEN], 1u);
            else XB_SPIN(xb_ld(&bar[XB_TOPGEN]) == tg, bar);
            __builtin_amdgcn_fence(__ATOMIC_ACQUIRE, "agent");
            xb_add(&bar[XB_XGEN(b.x)], 1u);
            asm volatile("s_waitcnt vmcnt(0)" ::: "memory");
        } else {
            XB_SPIN(xb_ld(&bar[XB_XGEN(b.x)]) == gen, bar);
            __builtin_amdgcn_fence(__ATOMIC_ACQUIRE, "agent");
            asm volatile("s_waitcnt vmcnt(0)" ::: "memory");
        }
    }
    __syncthreads();
}


enum { PH_INIT = 0, PH_CONVERT, PH_G1A, PH_G2A, PH_G3, PH_CONV, PH_PREP, PH_SCAN, PH_SB, PH_G4, PH_G1B, PH_G2B, PH_FINAL };

DEV void run_phase(CP& p, int ph, int l, int bid, int nblk, float* lds) {
    switch (ph) {
    case PH_INIT: phase_init(p, bid, nblk); break;
    case PH_G1A: gemm_big(p.hb, p.W13a, MMAIN, 2 * DFF, DM, EpiSwiglu{p.big, p.part}, bid, nblk, (unsigned char*)lds);
        if (bid >= 128) gemm_meta<EPI_SWIGLU>(p, p.hb, p.W13a, 2 * DFF, DM, 0.f, bid - 128, nblk - 128, lds); break;
    case PH_G2A: gemm_big(p.big, p.W2a, MMAIN, DM, DFF, EpiResid{p.h, p.hb, p.part, 0.5f}, bid, nblk, (unsigned char*)lds);
        gemm_meta<EPI_RESID>(p, p.big, p.W2a, DM, DFF, 0.5f, bid, nblk, lds); break;
    case PH_G3: gemm_big(p.hb, p.Win, MMAIN, DIN, DM, EpiP{p.big, p.vt, p.part}, bid, nblk, (unsigned char*)lds);
        gemm_meta<EPI_P>(p, p.hb, p.Win, DIN, DM, 0.f, bid, nblk, lds); break;
    case PH_CONV: phase_conv(p, l, bid, nblk, lds); break;
    case PH_PREP: phase_rwkv_prep(p, l, bid, nblk, lds); break;
    case PH_SCAN: phase_rwkv_scan(p, l, bid, nblk, lds); break;
    case PH_SB: phase_sb_mfma(p, l, bid, nblk); break;
    case PH_G4: gemm_big(p.y, p.Wout, MMAIN, DM, DM, EpiResid{p.h, p.hb, p.part, 1.0f}, bid, nblk, (unsigned char*)lds);
        gemm_meta<EPI_RESID>(p, p.y, p.Wout, DM, DM, 1.0f, bid, nblk, lds); break;
    case PH_G1B: gemm_big(p.hb, p.W13b, MMAIN, 2 * DFF, DM, EpiSwiglu{p.big, p.part}, bid, nblk, (unsigned char*)lds);
        if (bid >= 128) gemm_meta<EPI_SWIGLU>(p, p.hb, p.W13b, 2 * DFF, DM, 0.f, bid - 128, nblk - 128, lds); break;
    case PH_G2B: gemm_big(p.big, p.W2b, MMAIN, DM, DFF, EpiResid{p.h, p.hb, p.part, 0.5f}, bid, nblk, (unsigned char*)lds);
        gemm_meta<EPI_RESID>(p, p.big, p.W2b, DM, DFF, 0.5f, bid, nblk, lds); break;
    case PH_FINAL: phase_final(p, bid, nblk); break;
    }
}

namespace cg = cooperative_groups;
constexpr int LDS_BYTES = 151552 + 16;

__global__ void __launch_bounds__(512) k_mega(P p) {
    extern __shared__ __attribute__((aligned(16))) unsigned char smem[];
    float* lds = (float*)smem;
    cg::grid_group grid = cg::this_grid();
    const int bid = blockIdx.x, nblk = gridDim.x;
    volatile XB_LAS unsigned* xst = (volatile XB_LAS unsigned*)((XB_LAS unsigned char*)smem + (LDS_BYTES - 16));
    if (threadIdx.x < 4) xst[threadIdx.x] = 0u;
    __syncthreads();
    const XcdBarrier xb = xcd_barrier_post(kargs()->bar, xst);
    phase_init(*kargs(), bid, nblk);
    phase_convert(*kargs(), 0, 0, bid, nblk, lds);
    if (nblk == 0x7fffffff) grid.sync();
    xcd_barrier(xb);
    for (int l = 0; l < 4; ++l) {
        run_phase(*kargs(), PH_G1A, l, bid, nblk, lds); xcd_barrier(xb);
        run_phase(*kargs(), PH_G2A, l, bid, nblk, lds); xcd_barrier(xb);
        run_phase(*kargs(), PH_G3, l, bid, nblk, lds); xcd_barrier(xb);
        run_phase(*kargs(), PH_CONV, l, bid, nblk, lds);
        run_phase(*kargs(), PH_PREP, l, bid, nblk, lds);
        xcd_barrier(xb);
        if (bid < 192) phase_rwkv_scan2(*kargs(), l, bid, lds);
        else {
            phase_sb_mfma(*kargs(), l, bid - 192, nblk - 192);
            __syncthreads();
            phase_convert(*kargs(), l, 1, bid - 192, nblk - 192, lds);
            if (l < 3) phase_convert(*kargs(), l + 1, 0, bid - 192, nblk - 192, lds);
        }
        xcd_barrier(xb);
        phase_rwkv_post(*kargs(), l, bid, nblk);
        xcd_barrier(xb);
        run_phase(*kargs(), PH_G4, l, bid, nblk, lds); xcd_barrier(xb);
        run_phase(*kargs(), PH_G1B, l, bid, nblk, lds); xcd_barrier(xb);
        run_phase(*kargs(), PH_G2B, l, bid, nblk, lds); xcd_barrier(xb);
    }
    phase_final(*kargs(), bid, nblk);
}

extern "C" void kernel_launch(void* const* d_in, const int* in_sizes, int n_in, void* d_out, int out_size, void* d_ws, size_t ws_size, hipStream_t stream) {
    static int grid_blocks = 0;
    if (grid_blocks == 0) {
        int dev = 0, cus = 0, per_cu = 0;
        hipGetDevice(&dev);
        hipDeviceGetAttribute(&cus, hipDeviceAttributeMultiprocessorCount, dev);
        if (hipFuncSetAttribute((const void*)k_mega, hipFuncAttributeMaxDynamicSharedMemorySize, LDS_BYTES) != hipSuccess) { fprintf(stderr, "hipFuncSetAttribute failed\n"); grid_blocks = -1; return; }
        if (hipOccupancyMaxActiveBlocksPerMultiprocessor(&per_cu, (const void*)k_mega, 512, LDS_BYTES) != hipSuccess || per_cu < 1) { fprintf(stderr, "occupancy query failed (%d)\n", per_cu); per_cu = 1; }
        (void)hipGetLastError();
        grid_blocks = cus * per_cu;
    }
    if (grid_blocks < 0) return;
    P p{};
    const float** f = (const float**)&p;
    for (int i = 0; i < 28; ++i) f[i] = (const float*)d_in[i];
    p.out = (float*)d_out;
    size_t off = 0;
    auto take = [&](size_t bytes) { void* r = (char*)d_ws + off; off += (bytes + 255) & ~(size_t)255; return r; };
    p.W13a = (bf16_t*)take((size_t)2 * DFF * DM * 2);
    p.W2a = (bf16_t*)take((size_t)DM * DFF * 2);
    p.Win = (bf16_t*)take((size_t)DIN * DM * 2);
    p.Wout = (bf16_t*)take((size_t)DM * DM * 2);
    p.W13b = (bf16_t*)take((size_t)2 * DFF * DM * 2);
    p.W2b = (bf16_t*)take((size_t)DM * DFF * 2);
    p.Wl = (bf16_t*)take((size_t)DRW * 256 * 2);
    p.h = (float*)take((size_t)MP * DM * 4);
    p.hb = (bf16_t*)take((size_t)MP * DM * 2);
    p.big = (bf16_t*)take((size_t)MP * DIN * 2);
    p.y = (bf16_t*)take((size_t)MP * DM * 2);
    p.vt = (bf16_t*)take((size_t)NB * 6 * 64 * LPV * 2);
    p.part = (float*)take((size_t)MP * 16 * 4);
    p.lw = (float*)take((size_t)MP * DRW * 4);
    p.aa = (float*)take((size_t)MP * DRW * 4);
    p.gg = (float*)take((size_t)MP * DRW * 4);
    p.oraw = (float*)take((size_t)MP * DRW * 4);
    p.ct = (float*)take((size_t)MP * 8 * 4);
    p.inorm = (float*)take((size_t)MP * 8 * 4);
    p.bar = (unsigned*)take((size_t)XCD_BAR_WORDS * 4);
    if (off > ws_size) { fprintf(stderr, "workspace too small: need %zu have %zu\n", off, ws_size); return; }
    if (hipMemsetAsync(p.bar, 0, (size_t)XCD_BAR_WORDS * 4, stream) != hipSuccess) { fprintf(stderr, "memset of barrier words failed\n"); return; }
    void* args[] = {&p};
    hipError_t e = hipLaunchCooperativeKernel((const void*)k_mega, dim3(grid_blocks), dim3(512), args, LDS_BYTES, stream);
    if (e != hipSuccess) fprintf(stderr, "cooperative launch failed: %s (grid %d)\n", hipGetErrorString(e), grid_blocks);
}
```

```cpp
#include <hip/hip_runtime.h>
#include <hip/hip_cooperative_groups.h>
#include <stdint.h>
#include <stdio.h>

typedef unsigned short bf16_t;
typedef short bf16x8 __attribute__((ext_vector_type(8)));
typedef float f32x4 __attribute__((ext_vector_type(4)));
typedef unsigned u32x4 __attribute__((ext_vector_type(4)));
typedef unsigned u32x2 __attribute__((ext_vector_type(2)));

#define DEV __device__ __forceinline__

constexpr int NB = 8, SEQ = 2048, NMETA = 16, LT = 2064, DM = 1024, DFF = 2816, DIN = 3072;
constexpr int MMAIN = 16384, MTOK = 16512, MP = 16640;
constexpr int DRW = 384, LPV = 2080;
constexpr int C_RW = 512, C_Q = 1920, C_K = 2304, C_V = 2688;

struct P {
    const float *x, *meta, *ffn1_norm, *ffn1_w13, *ffn1_w2, *mix_norm, *w_in, *conv_w, *conv_b, *conv_ln_g, *conv_ln_b,
        *rwkv_mu, *rwkv_w0, *rwkv_wB, *rwkv_a0, *rwkv_aB, *rwkv_gB, *rwkv_kk, *rwkv_ka, *rwkv_rk, *rwkv_ln_g, *rwkv_ln_b,
        *sb_norm, *w_out, *ffn2_norm, *ffn2_w13, *ffn2_w2, *final_norm;
    float* out;
    bf16_t *W13a, *W2a, *Win, *Wout, *W13b, *W2b, *Wl;
    float* h; bf16_t* hb; bf16_t* big; bf16_t* y; bf16_t* vt; float* part;
    float *lw, *aa, *ct, *inorm; bf16_t* gg16; unsigned char* pack;
    unsigned* bar;
};

typedef const __attribute__((address_space(4))) P CP;
DEV CP* kargs() { CP* k = (CP*)__builtin_amdgcn_kernarg_segment_ptr(); asm volatile("" : "+s"(k)); return k; }
DEV int tid_() { int t = threadIdx.x; asm volatile("" : "+v"(t)); return t; }
DEV float bf2f(bf16_t v) { return __uint_as_float(((unsigned)v) << 16); }
DEV bf16_t f2bf(float f) { unsigned u = __float_as_uint(f); u += 0x7FFFu + ((u >> 16) & 1u); return (bf16_t)(u >> 16); }
DEV unsigned pack2(float a, float b) { return (unsigned)f2bf(a) | ((unsigned)f2bf(b) << 16); }
DEV float wave_sum(float v) {
#pragma unroll
    for (int o = 32; o; o >>= 1) v += __shfl_xor(v, o);
    return v;
}
DEV float dpp_sum16(float x) {
    x += __builtin_bit_cast(float, __builtin_amdgcn_update_dpp(0, __builtin_bit_cast(int, x), 0xB1, 0xF, 0xF, false));
    x += __builtin_bit_cast(float, __builtin_amdgcn_update_dpp(0, __builtin_bit_cast(int, x), 0x4E, 0xF, 0xF, false));
    x += __builtin_bit_cast(float, __builtin_amdgcn_update_dpp(0, __builtin_bit_cast(int, x), 0x141, 0xF, 0xF, false));
    x += __builtin_bit_cast(float, __builtin_amdgcn_update_dpp(0, __builtin_bit_cast(int, x), 0x140, 0xF, 0xF, false));
    return x;
}
DEV float wave_sum_fast(float x) {
    x = dpp_sum16(x);
    const int xi = __builtin_bit_cast(int, x);
    return (__builtin_bit_cast(float, __builtin_amdgcn_readlane(xi, 0)) + __builtin_bit_cast(float, __builtin_amdgcn_readlane(xi, 16))) +
           (__builtin_bit_cast(float, __builtin_amdgcn_readlane(xi, 32)) + __builtin_bit_cast(float, __builtin_amdgcn_readlane(xi, 48)));
}
typedef float f32x16 __attribute__((ext_vector_type(16)));
typedef __bf16 bfv2 __attribute__((ext_vector_type(2)));
typedef float f32x2v __attribute__((ext_vector_type(2)));
typedef short s16x4 __attribute__((ext_vector_type(4)));
DEV unsigned cvt2(float a, float b) { return __builtin_bit_cast(unsigned, __builtin_convertvector((f32x2v){a, b}, bfv2)); }
DEV bf16x8 pack_frag(float a0, float a1, float a2, float a3, float a4, float a5, float a6, float a7) {
    u32x4 w; w.x = cvt2(a0, a1); w.y = cvt2(a2, a3); w.z = cvt2(a4, a5); w.w = cvt2(a6, a7);
    return __builtin_bit_cast(bf16x8, w);
}
DEV float sigm(float x) { return 1.f / (1.f + expf(-x)); }
DEV int row_of(int b, int pos) { return pos < NMETA ? MMAIN + b * NMETA + pos : b * SEQ + pos - NMETA; }
DEV float row_rstd(const float* part, int row) {
    const f32x4* pp = (const f32x4*)(part + (size_t)row * 16);
    f32x4 a = pp[0], b = pp[1], c = pp[2], d = pp[3];
    float ss = ((a[0] + a[1]) + (a[2] + a[3])) + ((b[0] + b[1]) + (b[2] + b[3])) + ((c[0] + c[1]) + (c[2] + c[3])) + ((d[0] + d[1]) + (d[2] + d[3]));
    return rsqrtf(ss * (1.0f / 1024.0f) + 1e-6f);
}

DEV void phase_init(CP& p, int bid, int nblk) {
    const int lane = tid_() & 63, wave = tid_() >> 6;
    for (int r = bid * 8 + wave; r < MP; r += nblk * 8) {
        const float* src = nullptr;
        if (r < MMAIN) src = p.x + (size_t)r * DM;
        else if (r < MTOK) src = p.meta + (size_t)((r - MMAIN) & 15) * DM;
        float ss = 0.f;
#pragma unroll
        for (int i = 0; i < 4; ++i) {
            const int c = (i * 64 + lane) * 4;
            f32x4 v = src ? *(const f32x4*)(src + c) : (f32x4){0.f, 0.f, 0.f, 0.f};
            *(f32x4*)(p.h + (size_t)r * DM + c) = v;
            u32x2 w; w.x = pack2(v[0], v[1]); w.y = pack2(v[2], v[3]);
            *(u32x2*)(p.hb + (size_t)r * DM + c) = w;
            ss += v[0] * v[0] + v[1] * v[1] + v[2] * v[2] + v[3] * v[3];
        }
        ss = wave_sum(ss);
        if (lane < 16) p.part[(size_t)r * 16 + lane] = lane == 0 ? ss : 0.f;
    }
    for (int i = bid * 512 + tid_(); i < NB * 6 * 64 * (LPV - LT); i += nblk * 512) p.vt[(size_t)(i >> 4) * LPV + LT + (i & 15)] = 0;
}

struct ConvDesc { const float* W; const float* g; bf16_t* dst; int K, N, swz, kt, nt; };
DEV ConvDesc conv_desc(CP& p, int l, int grp, int idx) {
    ConvDesc d;
    int t = idx;
    if (grp == 0) {
        if (t < 1408) { d.W = p.ffn1_w13 + (size_t)l * DM * 2 * DFF; d.g = p.ffn1_norm + l * DM; d.dst = p.W13a; d.K = DM; d.N = 2 * DFF; d.swz = 1; d.kt = t / 88; d.nt = t % 88; return d; }
        t -= 1408;
        if (t < 704) { d.W = p.ffn1_w2 + (size_t)l * DFF * DM; d.g = nullptr; d.dst = p.W2a; d.K = DFF; d.N = DM; d.swz = 0; d.kt = t / 16; d.nt = t % 16; return d; }
        t -= 704;
        if (t < 768) { d.W = p.w_in + (size_t)l * DM * DIN; d.g = p.mix_norm + l * DM; d.dst = p.Win; d.K = DM; d.N = DIN; d.swz = 0; d.kt = t / 48; d.nt = t % 48; return d; }
        t -= 768;
        d.g = nullptr; d.N = DRW; d.swz = 0;
        if (t < 6) { d.W = p.rwkv_wB + (size_t)l * 64 * DRW; d.dst = p.Wl; d.K = 64; d.kt = 0; d.nt = t; return d; }
        if (t < 12) { d.W = p.rwkv_aB + (size_t)l * 64 * DRW; d.dst = p.Wl + DRW * 64; d.K = 64; d.kt = 0; d.nt = t - 6; return d; }
        d.W = p.rwkv_gB + (size_t)l * 128 * DRW; d.dst = p.Wl + DRW * 128; d.K = 128; d.kt = (t - 12) / 6; d.nt = (t - 12) % 6; return d;
    }
    if (t < 256) { d.W = p.w_out + (size_t)l * DM * DM; d.g = nullptr; d.dst = p.Wout; d.K = DM; d.N = DM; d.swz = 0; d.kt = t / 16; d.nt = t % 16; return d; }
    t -= 256;
    if (t < 1408) { d.W = p.ffn2_w13 + (size_t)l * DM * 2 * DFF; d.g = p.ffn2_norm + l * DM; d.dst = p.W13b; d.K = DM; d.N = 2 * DFF; d.swz = 1; d.kt = t / 88; d.nt = t % 88; return d; }
    t -= 1408;
    d.W = p.ffn2_w2 + (size_t)l * DFF * DM; d.g = nullptr; d.dst = p.W2b; d.K = DFF; d.N = DM; d.swz = 0; d.kt = t / 16; d.nt = t % 16; return d;
}
constexpr int CONV_A = 2904, CONV_B = 2368;
DEV void conv_load(const ConvDesc& d, int tid, f32x4 (&v)[2]) {
#pragma unroll
    for (int i = 0; i < 2; ++i) {
        const int idx = tid + i * 512, kk = idx >> 4, n4 = (idx & 15) * 4;
        v[i] = *(const f32x4*)(d.W + (size_t)(d.kt * 64 + kk) * d.N + d.nt * 64 + n4);
        if (d.g) v[i] *= d.g[d.kt * 64 + kk];
    }
}
DEV void conv_tile_store(const ConvDesc& dc, int tid, const float* tile) {
    const int nn = tid >> 3, kc = (tid & 7) * 8;
    const int sc = dc.nt * 64 + nn;
    int nd = sc;
    if (dc.swz) { const int bj = sc >= DFF ? 1 : 0; const int j = sc - bj * DFF; nd = (j >> 7) * 256 + bj * 128 + (j & 127); }
    u32x4 w;
    w.x = cvt2(tile[(kc + 0) * 65 + nn], tile[(kc + 1) * 65 + nn]); w.y = cvt2(tile[(kc + 2) * 65 + nn], tile[(kc + 3) * 65 + nn]);
    w.z = cvt2(tile[(kc + 4) * 65 + nn], tile[(kc + 5) * 65 + nn]); w.w = cvt2(tile[(kc + 6) * 65 + nn], tile[(kc + 7) * 65 + nn]);
    *(u32x4*)(dc.dst + (size_t)nd * dc.K + dc.kt * 64 + kc) = w;
}
DEV void phase_convert(CP& p, int l, int grp, int bid, int nblk, float* tile) {
    const int tid = tid_(), total = grp == 0 ? CONV_A : CONV_B;
    if (bid >= total) return;
    f32x4 v0[2], v1[2], v2[2];
    { const ConvDesc d = conv_desc(p, l, grp, bid); conv_load(d, tid, v0); }
    if (bid + nblk < total) { const ConvDesc d = conv_desc(p, l, grp, bid + nblk); conv_load(d, tid, v1); }
    if (bid + 2 * nblk < total) { const ConvDesc d = conv_desc(p, l, grp, bid + 2 * nblk); conv_load(d, tid, v2); }
    for (int it = bid; it < total; it += nblk) {
#pragma unroll
        for (int i = 0; i < 2; ++i) {
            const int idx = tid + i * 512, kk = idx >> 4, n4 = (idx & 15) * 4;
#pragma unroll
            for (int j = 0; j < 4; ++j) tile[kk * 65 + n4 + j] = v0[i][j];
        }
        __syncthreads();
        v0[0] = v1[0]; v0[1] = v1[1]; v1[0] = v2[0]; v1[1] = v2[1];
        if (it + 3 * nblk < total) { const ConvDesc d = conv_desc(p, l, grp, it + 3 * nblk); conv_load(d, tid, v2); }
        { const ConvDesc dc = conv_desc(p, l, grp, it); conv_tile_store(dc, tid, tile); }
        __syncthreads();
    }
}

enum { EPI_SWIGLU = 0, EPI_RESID = 1, EPI_P = 2 };

DEV void epi_swiglu(CP& p, int row, int colh, f32x4 g, f32x4 u, float rs) {
    float o[4];
#pragma unroll
    for (int e = 0; e < 4; ++e) { const float gg = g[e] * rs, uu = u[e] * rs; o[e] = gg * sigm(gg) * uu; }
    u32x2 w; w.x = pack2(o[0], o[1]); w.y = pack2(o[2], o[3]);
    *(u32x2*)(p.big + (size_t)row * DFF + colh) = w;
}
DEV float epi_resid(CP& p, int row, int col, f32x4 a, float scale) {
    float* hp = p.h + (size_t)row * DM + col;
    f32x4 hv = *(const f32x4*)hp;
    hv += a * scale;
    *(f32x4*)hp = hv;
    u32x2 w; w.x = pack2(hv[0], hv[1]); w.y = pack2(hv[2], hv[3]);
    *(u32x2*)(p.hb + (size_t)row * DM + col) = w;
    return hv[0] * hv[0] + hv[1] * hv[1] + hv[2] * hv[2] + hv[3] * hv[3];
}
DEV void epi_p(CP& p, int row, int col, f32x4 a, float rs) {
    a *= rs;
    u32x2 w; w.x = pack2(a[0], a[1]); w.y = pack2(a[2], a[3]);
    *(u32x2*)(p.big + (size_t)row * DIN + col) = w;
    if (col >= C_V && row < MTOK) {
        const int hh = (col - C_V) >> 6, d = (col - C_V) & 63;
        int b, pos;
        if (row < MMAIN) { b = row >> 11; pos = (row & 2047) + NMETA; } else { b = (row - MMAIN) >> 4; pos = (row - MMAIN) & 15; }
        bf16_t* vp = p.vt + ((size_t)((b * 6 + hh) * 64 + d)) * LPV + pos;
#pragma unroll
        for (int e = 0; e < 4; ++e) vp[(size_t)e * LPV] = f2bf(a[e]);
    }
}

template <int EPI>
DEV void gemm_meta(CP& p, const bf16_t* __restrict__ A, const bf16_t* __restrict__ Bt, int N, int K, float scale, int bid, int nblk, float* lds) {
    const int tid = tid_(), lane = tid & 63, wave = tid >> 6, fr = lane & 15, fq = lane >> 4;
    const int nt = N / 64, total = 4 * nt, kw = K / 8;
    float* red = lds + 8 * 8 * 64 * 4;
    for (int u = bid; u < total; u += nblk) {
        const int mu = u / nt, nu = u % nt, row0 = MMAIN + mu * 32;
        const int cb = (EPI == EPI_SWIGLU) ? ((nu >> 2) * 256 + (nu & 3) * 32) : nu * 64;
        f32x4 acc[2][4];
#pragma unroll
        for (int i = 0; i < 2; ++i)
#pragma unroll
            for (int j = 0; j < 4; ++j) acc[i][j] = (f32x4){0.f, 0.f, 0.f, 0.f};
        const bf16_t* ap = A + (size_t)(row0 + fr) * K + wave * kw + fq * 8;
        const bf16_t* bp = Bt + (size_t)(cb + fr) * K + wave * kw + fq * 8;
        for (int k0 = 0; k0 < kw; k0 += 32) {
            const bf16x8 a0 = *(const bf16x8*)(ap + k0), a1 = *(const bf16x8*)(ap + (size_t)16 * K + k0);
#pragma unroll
            for (int j = 0; j < 4; ++j) {
                const int co = (EPI == EPI_SWIGLU) ? ((j & 1) * 16 + (j >> 1) * 128) : j * 16;
                const bf16x8 bv = *(const bf16x8*)(bp + (size_t)co * K + k0);
                acc[0][j] = __builtin_amdgcn_mfma_f32_16x16x32_bf16(bv, a0, acc[0][j], 0, 0, 0);
                acc[1][j] = __builtin_amdgcn_mfma_f32_16x16x32_bf16(bv, a1, acc[1][j], 0, 0, 0);
            }
        }
#pragma unroll
        for (int i = 0; i < 2; ++i)
#pragma unroll
            for (int j = 0; j < 4; ++j) *(f32x4*)(lds + ((wave * 8 + i * 4 + j) * 64 + lane) * 4) = acc[i][j];
        __syncthreads();
        {
            f32x4 sum = (f32x4){0.f, 0.f, 0.f, 0.f};
#pragma unroll
            for (int w = 0; w < 8; ++w) sum += *(const f32x4*)(lds + ((w * 8 + wave) * 64 + lane) * 4);
            *(f32x4*)(red + (wave * 64 + lane) * 4) = sum;
        }
        __syncthreads();
        if (wave < 2) {
            const int i = wave, row = row0 + 16 * i + fr;
            f32x4 a[4];
#pragma unroll
            for (int j = 0; j < 4; ++j) a[j] = *(const f32x4*)(red + ((i * 4 + j) * 64 + lane) * 4);
            if (EPI == EPI_SWIGLU) {
                const float rs = row_rstd(p.part, row);
                const int colh = (nu >> 2) * 128 + (nu & 3) * 32 + 4 * fq;
                epi_swiglu(p, row, colh, a[0], a[2], rs);
                epi_swiglu(p, row, colh + 16, a[1], a[3], rs);
            } else if (EPI == EPI_RESID) {
                float ss = 0.f;
#pragma unroll
                for (int j = 0; j < 4; ++j) ss += epi_resid(p, row, cb + 16 * j + 4 * fq, a[j], scale);
                ss += __shfl_xor(ss, 16); ss += __shfl_xor(ss, 32);
                if (fq == 0) p.part[(size_t)row * 16 + nu] = ss;
            } else {
                const float rs = row_rstd(p.part, row);
#pragma unroll
                for (int j = 0; j < 4; ++j) epi_p(p, row, cb + 16 * j + 4 * fq, a[j], rs);
            }
        }
        __syncthreads();
    }
}

namespace pg8 {
#define PG8_LAS __attribute__((address_space(3)))
typedef unsigned short bf16_t;
typedef short bf16x8 __attribute__((ext_vector_type(8)));
typedef float f32x4 __attribute__((ext_vector_type(4)));
typedef unsigned u32x4 __attribute__((ext_vector_type(4)));
constexpr int BM = 256, BK = 64, HALF = 128, HTB = HALF * BK * 2  , STAGE_BYTES = 8 * HTB, NXCD = 8, WGM = 8;

__host__ __device__ __forceinline__ int lds_byte(int r, int c) { const int st = (r >> 4) * 2 + (c >> 5), rr = r & 15, cc = c & 31, ob = rr * 64 + cc * 2; return st * 1024 + (ob ^ (((ob >> 9) & 1) << 5)); }
__host__ __device__ __forceinline__ void stage_rc(int b, int& R, int& C) { const int st = b / 1024, sb = b % 1024, swz = sb ^ (((sb >> 9) & 1) << 5); R = (st >> 1) * 16 + swz / 64; C = (st & 1) * 32 + (swz % 64) / 2; }
__host__ __device__ __forceinline__ int perm32(int rho) { const int n = rho >> 4, i = rho & 15; return 8 * (i >> 2) + 4 * n + (i & 3); }

struct Unit { int pm, pn; };
struct Gemm { const bf16_t* A; const bf16_t* Bt; int M, N, K; };

struct StaticOrder {
    int nM, nN, nwg, G, c;
    __host__ __device__ void init(int M, int N, int G_, int c_) { nM = M / BM; nN = N / BM; nwg = nM * nN; G = G_; c = c_; }
    __host__ __device__ bool next(int i, Unit& u) const {
        const long L = (long)i * G + c; if (L >= nwg) return false;
        int wgid = (int)L; { const int q = nwg / NXCD, r = nwg % NXCD, xcd = wgid % NXCD, off = wgid / NXCD; wgid = (xcd < r ? xcd * (q + 1) : r * (q + 1) + (xcd - r) * q) + off; }
        const int nig = WGM * nN, gid = wgid / nig, fm = gid * WGM, gsz = (nM - fm) < WGM ? (nM - fm) : WGM;
        u.pm = fm + ((wgid % nig) % gsz); u.pn = (wgid % nig) / gsz; return true;
    }
    __device__ __forceinline__ void a_ready(const Unit&) const {}
    __device__ __forceinline__ void done(const Unit&) const {}
};
__device__ __forceinline__ unsigned cvt_pk_bf16(float lo, float hi) { unsigned r; asm volatile("v_cvt_pk_bf16_f32 %0, %1, %2" : "=v"(r) : "v"(lo), "v"(hi)); return r; }
template <class Epi, class Sched, bool STAMP = false>
__device__ __forceinline__ void gemm_phase(PG8_LAS unsigned char* lds, const Gemm g, const Sched& S, const Epi& E, unsigned long long* stamps) {
    const int tid = tid_(), wid = __builtin_amdgcn_readfirstlane(tid >> 6), lane = tid & 63, wr = wid >> 2, wc = wid & 3, fr = lane & 15, fq = lane >> 4;
    const int K = g.K, nt = K / BK;
    int ts_lo = 0, ts_hi = 0, nts = 0; const unsigned long long rt_entry = STAMP ? (unsigned long long)wall_clock64() : 0ull;
#define PG8_STAMP() do { if (STAMP && wid == 0 && nts < 64) { const unsigned long long _c = (unsigned long long)clock64(); \
        ts_lo = (lane == nts) ? (int)(unsigned)_c : ts_lo; ts_hi = (lane == nts) ? (int)(unsigned)(_c >> 32) : ts_hi; ++nts; } } while (0)
    PG8_STAMP();
    unsigned voffA[2], voffB[2];
#pragma unroll
    for (int i = 0; i < 2; ++i) { int R, C; stage_rc(tid * 16 + i * 8192, R, C); const int Rb = Epi::PERM ? ((R & ~31) + perm32(R & 31)) : R;
        voffA[i] = (unsigned)(R * K + C) * 2u; voffB[i] = (unsigned)(Rb * K + C) * 2u; }
    const size_t kstep = (size_t)(BK * 2);
    const size_t hstep = (size_t)HALF * K * 2;
    const size_t tstep = 2 * hstep;
    const unsigned ldsw = (unsigned)wid * 1024u;
    const int aoff = lds_byte(wr * 64 + fr, fq * 8), boff = lds_byte(wc * 32 + fr, fq * 8);
#define PG8_SA(b, h) (((b) * 2 + (h)) * HTB)
#define PG8_SB(b, h) ((4 + (b) * 2 + (h)) * HTB)
#define PG8_STAGE(bufoff, gbase, voff) do { _Pragma("unroll") for (int _i = 0; _i < 2; ++_i) \
        __builtin_amdgcn_global_load_lds((const unsigned*)((const char*)(gbase) + (voff)[_i]), (PG8_LAS unsigned*)(lds + (bufoff) + ldsw + _i * 8192), 16, 0, 0); } while (0)
#define PG8_LDA(dst, b, h) do { _Pragma("unroll") for (int m = 0; m < 4; ++m) _Pragma("unroll") for (int k = 0; k < 2; ++k) dst[m][k] = *(const PG8_LAS bf16x8*)(lds + PG8_SA(b, h) + aoff + m * 2048 + k * 1024); } while (0)
#define PG8_LDB(dst, b, h) do { _Pragma("unroll") for (int n = 0; n < 2; ++n) _Pragma("unroll") for (int k = 0; k < 2; ++k) dst[n][k] = *(const PG8_LAS bf16x8*)(lds + PG8_SB(b, h) + boff + n * 2048 + k * 1024); } while (0)
#define PG8_MMA(ai, bj, At, Bt) do { __builtin_amdgcn_s_setprio(1); _Pragma("unroll") for (int m = 0; m < 4; ++m) _Pragma("unroll") for (int n = 0; n < 2; ++n) _Pragma("unroll") for (int k = 0; k < 2; ++k) \
        acc[ai][bj][m][n] = __builtin_amdgcn_mfma_f32_16x16x32_bf16(Bt[n][k], At[m][k], acc[ai][bj][m][n], 0, 0, 0); __builtin_amdgcn_s_setprio(0); } while (0)
#define PG8_WAIT_V(n) asm volatile("s_waitcnt vmcnt(" #n ")" ::: "memory")
#define PG8_WAIT_L(n) asm volatile("s_waitcnt lgkmcnt(" #n ")" ::: "memory")
#define PG8_BAR __builtin_amdgcn_s_barrier()
#define PG8_SCHED __builtin_amdgcn_sched_barrier(0)
    Unit cur, nxt; int ui = 0;
    if (!S.next(0, cur)) return;
    f32x4 acc[2][2][4][2];
#pragma unroll
    for (int a = 0; a < 2; ++a)
#pragma unroll
        for (int b = 0; b < 2; ++b)
#pragma unroll
            for (int m = 0; m < 4; ++m)
#pragma unroll
                for (int n = 0; n < 2; ++n) acc[a][b][m][n] = (f32x4){0.f, 0.f, 0.f, 0.f};
    bf16x8 At[4][2], B0[2][2], B1[2][2];
    const char* cA = (const char*)g.A + (size_t)cur.pm * tstep; const char* cB = (const char*)g.Bt + (size_t)cur.pn * tstep;
    S.a_ready(cur);
    PG8_STAGE(PG8_SB(0, 0), cB, voffB); PG8_STAGE(PG8_SA(0, 0), cA, voffA); PG8_STAGE(PG8_SB(0, 1), cB + hstep, voffB); PG8_STAGE(PG8_SA(0, 1), cA + hstep, voffA);
    if (wr == 1) PG8_BAR;
    PG8_WAIT_V(4); PG8_BAR;
    PG8_STAGE(PG8_SB(1, 0), cB + kstep, voffB); PG8_STAGE(PG8_SA(1, 0), cA + kstep, voffA); PG8_STAGE(PG8_SB(1, 1), cB + hstep + kstep, voffB);
    PG8_WAIT_V(6); PG8_BAR;
    PG8_STAMP();
    for (;;) {
        const bool has_next = S.next(ui + 1, nxt);
        const char* nA = has_next ? (const char*)g.A + (size_t)nxt.pm * tstep : cA; const char* nB = has_next ? (const char*)g.Bt + (size_t)nxt.pn * tstep : cB;
        for (int t = 0; t < nt; t += 2) {
            const bool last = (t == nt - 2);
            const char* a1 = cA + (size_t)(t + 1) * kstep;
            const char* a2 = last ? nA : cA + (size_t)(t + 2) * kstep; const char* b2 = last ? nB : cB + (size_t)(t + 2) * kstep;
            const char* a3 = a2 + kstep; const char* b3 = b2 + kstep;
            if (last && has_next) S.a_ready(nxt);
            PG8_LDB(B0, 0, 0); PG8_SCHED; PG8_LDA(At, 0, 0); PG8_STAGE(PG8_SA(1, 1), a1 + hstep, voffA);
            PG8_WAIT_L(8); PG8_BAR; PG8_WAIT_L(0); PG8_MMA(0, 0, At, B0); PG8_BAR; PG8_SCHED;
            PG8_LDB(B1, 0, 1); PG8_STAGE(PG8_SB(0, 0), b2, voffB);
            PG8_BAR; PG8_WAIT_L(0); PG8_MMA(0, 1, At, B1); PG8_BAR;
            PG8_LDA(At, 0, 1); PG8_STAGE(PG8_SA(0, 0), a2, voffA);
            PG8_BAR; PG8_WAIT_L(0); PG8_MMA(1, 0, At, B0); PG8_BAR; PG8_SCHED;
            PG8_STAGE(PG8_SB(0, 1), b2 + hstep, voffB);
            PG8_WAIT_V(6); PG8_BAR; PG8_MMA(1, 1, At, B1); PG8_BAR;
            PG8_LDB(B0, 1, 0); PG8_SCHED; PG8_LDA(At, 1, 0); PG8_STAGE(PG8_SA(0, 1), a2 + hstep, voffA);
            PG8_WAIT_L(8); PG8_BAR; PG8_WAIT_L(0); PG8_MMA(0, 0, At, B0); PG8_BAR; PG8_SCHED;
            PG8_LDB(B1, 1, 1); PG8_STAGE(PG8_SB(1, 0), b3, voffB);
            PG8_BAR; PG8_WAIT_L(0); PG8_MMA(0, 1, At, B1); PG8_BAR;
            PG8_LDA(At, 1, 1); PG8_STAGE(PG8_SA(1, 0), a3, voffA);
            PG8_BAR; PG8_WAIT_L(0); PG8_MMA(1, 0, At, B0); PG8_BAR; PG8_SCHED;
            PG8_STAGE(PG8_SB(1, 1), b3 + hstep, voffB);
            PG8_WAIT_V(6); PG8_BAR; PG8_MMA(1, 1, At, B1); PG8_BAR;
        }
        PG8_STAMP();
        if constexpr (!Epi::AFTER_DRAIN) { E(acc, cur, wr, wc, fr, fq); S.done(cur); }
        PG8_STAMP();
        if (!has_next) break;
#pragma unroll
        for (int a = 0; a < 2; ++a)
#pragma unroll
            for (int b = 0; b < 2; ++b)
#pragma unroll
                for (int m = 0; m < 4; ++m)
#pragma unroll
                    for (int n = 0; n < 2; ++n) acc[a][b][m][n] = (f32x4){0.f, 0.f, 0.f, 0.f};
        cur = nxt; cA = nA; cB = nB; ++ui;
    }
    PG8_WAIT_V(0);
    if (wr == 0) PG8_BAR;
    PG8_BAR;
    if constexpr (Epi::AFTER_DRAIN) { E.fused(acc, cur, wr, wc, fr, fq, lds, wid, lane); S.done(cur); }
    PG8_STAMP();
    if (STAMP && wid == 0) { stamps[lane] = lane < nts ? (((unsigned long long)(unsigned)ts_hi << 32) | (unsigned)ts_lo) : 0ull;
        if (lane == 62) stamps[62] = rt_entry; if (lane == 63) stamps[63] = (unsigned long long)wall_clock64(); }
#undef PG8_STAMP
#undef PG8_SA
#undef PG8_SB
#undef PG8_STAGE
#undef PG8_LDA
#undef PG8_LDB
#undef PG8_MMA
#undef PG8_WAIT_V
#undef PG8_WAIT_L
#undef PG8_BAR
#undef PG8_SCHED
}
}

DEV float fsig(float x) { return __builtin_amdgcn_rcpf(1.f + __expf(-x)); }
DEV u32x4 pack8(f32x4 a, f32x4 b) { u32x4 w; w.x = pg8::cvt_pk_bf16(a[0], a[1]); w.y = pg8::cvt_pk_bf16(a[2], a[3]); w.z = pg8::cvt_pk_bf16(b[0], b[1]); w.w = pg8::cvt_pk_bf16(b[2], b[3]); return w; }

DEV float row_rstd_q(const float* part, int row, int fq) {
    const f32x4 a = *(const f32x4*)(part + (size_t)row * 16 + fq * 4);
    float ss = (a[0] + a[1]) + (a[2] + a[3]);
    ss += __shfl_xor(ss, 16); ss += __shfl_xor(ss, 32);
    return rsqrtf(ss * (1.0f / 1024.0f) + 1e-6f);
}
struct EpiSwiglu {
    static constexpr bool PERM = true, AFTER_DRAIN = false;
    bf16_t* hid; const float* part;
    __device__ __forceinline__ void operator()(const f32x4 (&acc)[2][2][4][2], const pg8::Unit& u, int wr, int wc, int fr, int fq) const {
        float rsv[2][4];
#pragma unroll
        for (int ai = 0; ai < 2; ++ai)
#pragma unroll
            for (int m = 0; m < 4; ++m) rsv[ai][m] = row_rstd_q(part, u.pm * 256 + ai * 128 + wr * 64 + m * 16 + fr, fq);
#pragma unroll
        for (int ai = 0; ai < 2; ++ai)
#pragma unroll
            for (int m = 0; m < 4; ++m) {
                __builtin_amdgcn_sched_barrier(0);
                const int row = u.pm * 256 + ai * 128 + wr * 64 + m * 16 + fr;
                const float rs = rsv[ai][m];
                f32x4 o[2];
#pragma unroll
                for (int n = 0; n < 2; ++n)
#pragma unroll
                    for (int e = 0; e < 4; ++e) { const float g = acc[ai][0][m][n][e] * rs, up = acc[ai][1][m][n][e] * rs; o[n][e] = g * fsig(g) * up; }
                *(u32x4*)(hid + (size_t)row * DFF + u.pn * 128 + wc * 32 + fq * 8) = pack8(o[0], o[1]);
            }
    }
};
struct EpiResid {
    static constexpr bool PERM = true, AFTER_DRAIN = false;
    float* h; bf16_t* hb; float* part; float scale;
    __device__ __forceinline__ void operator()(const f32x4 (&acc)[2][2][4][2], const pg8::Unit& u, int wr, int wc, int fr, int fq) const {
#pragma unroll
        for (int ai = 0; ai < 2; ++ai) {
            __builtin_amdgcn_sched_barrier(0);
            f32x4 hv[4][2][2];
#pragma unroll
            for (int m = 0; m < 4; ++m)
#pragma unroll
                for (int bj = 0; bj < 2; ++bj) {
                    const float* hp = h + (size_t)(u.pm * 256 + ai * 128 + wr * 64 + m * 16 + fr) * DM + u.pn * 256 + bj * 128 + wc * 32 + fq * 8;
                    hv[m][bj][0] = *(const f32x4*)hp; hv[m][bj][1] = *(const f32x4*)(hp + 4);
                }
#pragma unroll
            for (int m = 0; m < 4; ++m) {
                const int row = u.pm * 256 + ai * 128 + wr * 64 + m * 16 + fr;
                float ss = 0.f;
#pragma unroll
                for (int bj = 0; bj < 2; ++bj) {
                    const int col = u.pn * 256 + bj * 128 + wc * 32 + fq * 8;
                    float* hp = h + (size_t)row * DM + col;
                    const f32x4 h0 = hv[m][bj][0] + acc[ai][bj][m][0] * scale, h1 = hv[m][bj][1] + acc[ai][bj][m][1] * scale;
                    *(f32x4*)hp = h0; *(f32x4*)(hp + 4) = h1;
                    *(u32x4*)(hb + (size_t)row * DM + col) = pack8(h0, h1);
                    ss += (h0[0] * h0[0] + h0[1] * h0[1]) + (h0[2] * h0[2] + h0[3] * h0[3]) + (h1[0] * h1[0] + h1[1] * h1[1]) + (h1[2] * h1[2] + h1[3] * h1[3]);
                }
                ss += __shfl_xor(ss, 16); ss += __shfl_xor(ss, 32);
                if (fq == 0) part[(size_t)row * 16 + u.pn * 4 + wc] = ss;
            }
        }
    }
};
struct EpiP {
    static constexpr bool PERM = true, AFTER_DRAIN = false;
    bf16_t* big; bf16_t* vt; const float* part;
    __device__ __forceinline__ void operator()(const f32x4 (&acc)[2][2][4][2], const pg8::Unit& u, int wr, int wc, int fr, int fq) const {
        float rsv[2][4];
#pragma unroll
        for (int ai = 0; ai < 2; ++ai)
#pragma unroll
            for (int m = 0; m < 4; ++m) rsv[ai][m] = row_rstd_q(part, u.pm * 256 + ai * 128 + wr * 64 + m * 16 + fr, fq);
#pragma unroll
        for (int ai = 0; ai < 2; ++ai)
#pragma unroll
            for (int m = 0; m < 4; ++m) {
                __builtin_amdgcn_sched_barrier(0);
                const int row = u.pm * 256 + ai * 128 + wr * 64 + m * 16 + fr;
                const float rs = rsv[ai][m];
#pragma unroll
                for (int bj = 0; bj < 2; ++bj) {
                    const int col = u.pn * 256 + bj * 128 + wc * 32 + fq * 8;
                    const f32x4 a0 = acc[ai][bj][m][0] * rs, a1 = acc[ai][bj][m][1] * rs;
                    const u32x4 w = pack8(a0, a1);
                    *(u32x4*)(big + (size_t)row * DIN + col) = w;
                    if (col >= C_V && row < MTOK) {
                        const int hh = (col - C_V) >> 6, d = (col - C_V) & 63;
                        int b, pos;
                        if (row < MMAIN) { b = row >> 11; pos = (row & 2047) + NMETA; } else { b = (row - MMAIN) >> 4; pos = (row - MMAIN) & 15; }
                        bf16_t* vp = vt + ((size_t)((b * 6 + hh) * 64 + d)) * LPV + pos;
#pragma unroll
                        for (int e = 0; e < 4; ++e) { vp[(size_t)(2 * e) * LPV] = (bf16_t)(w[e] & 0xFFFFu); vp[(size_t)(2 * e + 1) * LPV] = (bf16_t)(w[e] >> 16); }
                    }
                }
            }
    }
};
template <class Epi>
DEV void gemm_big(const bf16_t* A, const bf16_t* Bt, int M, int N, int K, const Epi& E, int bid, int nblk, unsigned char* smem) {
    pg8::StaticOrder S; S.init(M, N, nblk, bid);
    const pg8::Gemm g{A, Bt, M, N, K};
    pg8::gemm_phase<Epi, pg8::StaticOrder, false>((PG8_LAS unsigned char*)smem, g, S, E, nullptr);
}

DEV void phase_conv(CP& p, int l, int bid, int nblk, float* lds) {
    float* cS = lds;
    float* yS = lds + 46 * 256;
    const int tid = tid_(), ch = tid & 255, half = tid >> 8, lane = tid & 63, wave = tid >> 6;
    float wreg[31];
#pragma unroll
    for (int j = 0; j < 31; ++j) wreg[j] = p.conv_w[(size_t)l * 31 * 256 + j * 256 + ch];
    const float cb = p.conv_b[l * 256 + ch];
    for (int it = bid; it < NB * 129; it += nblk) {
        const int b = it / 129, p0 = (it % 129) * 16;
        __syncthreads();
#pragma unroll
        for (int q = 0; q < 3; ++q) {
            const int e = tid + q * 512;
            if (e < 46 * 32) {
                const int pp = e >> 5, c8 = (e & 31) * 8, pos = p0 - 30 + pp;
                f32x4 o0 = (f32x4){0.f, 0.f, 0.f, 0.f}, o1 = o0;
                if (pos >= 0) {
                    const bf16_t* rp = p.big + (size_t)row_of(b, pos) * DIN + c8;
                    const u32x4 vw = *(const u32x4*)rp, gw = *(const u32x4*)(rp + 256);
#pragma unroll
                    for (int j = 0; j < 2; ++j) {
                        o0[2 * j] = __uint_as_float(vw[j] << 16) * fsig(__uint_as_float(gw[j] << 16));
                        o0[2 * j + 1] = __uint_as_float(vw[j] & 0xFFFF0000u) * fsig(__uint_as_float(gw[j] & 0xFFFF0000u));
                        o1[2 * j] = __uint_as_float(vw[2 + j] << 16) * fsig(__uint_as_float(gw[2 + j] << 16));
                        o1[2 * j + 1] = __uint_as_float(vw[2 + j] & 0xFFFF0000u) * fsig(__uint_as_float(gw[2 + j] & 0xFFFF0000u));
                    }
                }
                *(f32x4*)(cS + pp * 256 + c8) = o0; *(f32x4*)(cS + pp * 256 + c8 + 4) = o1;
            }
        }
        __syncthreads();
#pragma unroll
        for (int i = 0; i < 8; ++i) {
            const int ii = half * 8 + i;
            float acc = cb;
#pragma unroll
            for (int j = 0; j < 31; ++j) acc += wreg[j] * cS[(ii + j) * 256 + ch];
            yS[ii * 256 + ch] = acc;
        }
        __syncthreads();
#pragma unroll
        for (int q = 0; q < 2; ++q) {
            const int ii = wave * 2 + q;
            const f32x4 v = *(const f32x4*)(yS + ii * 256 + lane * 4);
            const float mu = wave_sum_fast((v[0] + v[1]) + (v[2] + v[3])) * (1.f / 256.f);
            const f32x4 d = v - mu;
            const float var = wave_sum_fast(d[0] * d[0] + d[1] * d[1] + d[2] * d[2] + d[3] * d[3]) * (1.f / 256.f);
            const float rs = rsqrtf(var + 1e-5f);
            const f32x4 g = *(const f32x4*)(p.conv_ln_g + l * 256 + lane * 4), bb = *(const f32x4*)(p.conv_ln_b + l * 256 + lane * 4);
            float o[4];
#pragma unroll
            for (int e = 0; e < 4; ++e) { const float yn = d[e] * rs * g[e] + bb[e]; o[e] = yn * sigm(yn); }
            u32x2 w; w.x = pack2(o[0], o[1]); w.y = pack2(o[2], o[3]);
            *(u32x2*)(p.y + (size_t)row_of(b, p0 + ii) * DM + lane * 4) = w;
        }
    }
}

constexpr int PK_AN = 0, PK_RM = 3072, PK_TT = 6144, PK_KB = 7168, PK_VT = 11264, PK_GT = 13312, PK_GC = 15360, PK_CT = 15616, PK_BYTES = 15680;
DEV u32x4 pack8f(const float* x) { u32x4 w; w.x = cvt2(x[0], x[1]); w.y = cvt2(x[2], x[3]); w.z = cvt2(x[4], x[5]); w.w = cvt2(x[6], x[7]); return w; }
DEV void rwkv_pack_item(CP& p, int l, int r0, int hh, unsigned char* scr) {
    const int lane = tid_() & 63, fr = lane & 15, fq = lane >> 4, hc = hh * 64 + lane;
    int b, pos0;
    if (r0 < MMAIN) { b = r0 >> 11; pos0 = (r0 & 2047) + NMETA; } else { b = (r0 - MMAIN) >> 4; pos0 = 0; }
    unsigned char* pk = p.pack + (size_t)((b * 6 + hh) * 129 + (pos0 >> 4)) * PK_BYTES;
    bf16_t* sA = (bf16_t*)scr; bf16_t* sR = sA + 16 * 72; bf16_t* sB = sR + 16 * 72; bf16_t* sK = sB + 16 * 72;
    float* sN = (float*)(scr + 4 * 2304);
    const float* mu = p.rwkv_mu + (size_t)l * 1408;
    const float mr = mu[hc], mk = mu[384 + hc], mv = mu[768 + hc];
    const float kkw = p.rwkv_kk[l * DRW + hc], kaw = p.rwkv_ka[l * DRW + hc];
    float pr = 0.f, pkk = 0.f, pv = 0.f;
    if (pos0 > 0) { const bf16_t* q = p.big + (size_t)row_of(b, pos0 - 1) * DIN + C_RW + hc; pr = bf2f(q[0]); pkk = bf2f(q[384]); pv = bf2f(q[768]); }
    float bt[16], kt[16], vv[16], gv[16];
    float lg = 0.f;
#pragma unroll
    for (int hf = 0; hf < 2; ++hf) {
        unsigned short r0w[8], k0w[8], v0w[8], gw[8]; float lww[8], inw[8], aaw[8];
#pragma unroll
        for (int u = 0; u < 8; ++u) {
            const int row = r0 + hf * 8 + u;
            const bf16_t* q = p.big + (size_t)row * DIN + C_RW + hc;
            r0w[u] = q[0]; k0w[u] = q[384]; v0w[u] = q[768];
            lww[u] = p.lw[(size_t)row * DRW + hc]; gw[u] = p.gg16[(size_t)row * DRW + hc]; inw[u] = p.inorm[(size_t)row * 8 + hh]; aaw[u] = p.aa[(size_t)row * DRW + hc];
        }
#pragma unroll
        for (int u = 0; u < 8; ++u) {
            const int t = hf * 8 + u;
            const float r0v = bf2f(r0w[u]), k0v = bf2f(k0w[u]), v0v = bf2f(v0w[u]);
            const float r = r0v + mr * (pr - r0v), k = k0v + mk * (pkk - k0v), v = v0v + mv * (pv - v0v);
            pr = r0v; pkk = k0v; pv = v0v;
            const float a = aaw[u], lwv = lww[u];
            const float kk = k * kkw * inw[u];
            const float kp = k * (1.f + (a - 1.f) * kaw);
            const float gprev = __expf(lg);
            lg += lwv;
            const float gcur = __expf(lg), ginv = __expf(-lg);
            const float at = -kk * gprev, rt = r * gcur;
            bt[t] = kk * a * ginv; kt[t] = kp * ginv; vv[t] = v; gv[t] = bf2f(gw[u]);
            const bf16_t ab = f2bf(at), rb = f2bf(rt);
            ((bf16_t*)(pk + PK_AN))[t * 96 + lane] = ab; ((bf16_t*)(pk + PK_RM))[t * 96 + lane] = rb;
            sA[t * 72 + lane] = ab; sR[t * 72 + lane] = rb; sB[t * 72 + lane] = f2bf(bt[t]); sK[t * 72 + lane] = f2bf(kt[t]);
        }
    }
    ((float*)(pk + PK_GC))[lane] = __expf(lg);
    if (lane < 16) ((float*)(pk + PK_CT))[lane] = p.ct[(size_t)(r0 + lane) * 8 + hh];
    { u32x4* d = (u32x4*)(pk + PK_KB + lane * 64); d[0] = pack8f(kt); d[1] = pack8f(kt + 8); d[2] = pack8f(bt); d[3] = pack8f(bt + 8); }
    { u32x4* d = (u32x4*)(pk + PK_VT + lane * 32); d[0] = pack8f(vv); d[1] = pack8f(vv + 8); }
    { u32x4* d = (u32x4*)(pk + PK_GT + lane * 32); d[0] = pack8f(gv); d[1] = pack8f(gv + 8); }
    f32x4 nab = (f32x4){0.f, 0.f, 0.f, 0.f}, nak = nab, mrb = nab, mrk = nab;
#pragma unroll
    for (int ks = 0; ks < 2; ++ks) {
        const bf16x8 fb = *(const bf16x8*)(sB + fr * 72 + ks * 32 + fq * 8), fk = *(const bf16x8*)(sK + fr * 72 + ks * 32 + fq * 8);
        const bf16x8 fa = *(const bf16x8*)(sA + fr * 72 + ks * 32 + fq * 8), fc = *(const bf16x8*)(sR + fr * 72 + ks * 32 + fq * 8);
        nab = __builtin_amdgcn_mfma_f32_16x16x32_bf16(fb, fa, nab, 0, 0, 0);
        nak = __builtin_amdgcn_mfma_f32_16x16x32_bf16(fk, fa, nak, 0, 0, 0);
        mrb = __builtin_amdgcn_mfma_f32_16x16x32_bf16(fb, fc, mrb, 0, 0, 0);
        mrk = __builtin_amdgcn_mfma_f32_16x16x32_bf16(fk, fc, mrk, 0, 0, 0);
    }
#pragma unroll
    for (int i = 0; i < 4; ++i) {
        const int j = 4 * fq + i;
        if (!(j < fr)) { nab[i] = 0.f; nak[i] = 0.f; }
        if (!(j <= fr)) { mrb[i] = 0.f; mrk[i] = 0.f; }
        sN[j * 16 + fr] = nab[i];
    }
    { u32x2 w; w.x = cvt2(nak[0], nak[1]); w.y = cvt2(nak[2], nak[3]); *(u32x2*)(pk + PK_AN + fr * 192 + (64 + 4 * fq) * 2) = w; *(u32x2*)(pk + PK_AN + fr * 192 + (80 + 4 * fq) * 2) = (u32x2){0u, 0u}; }
    { u32x2 w; w.x = cvt2(mrk[0], mrk[1]); w.y = cvt2(mrk[2], mrk[3]); *(u32x2*)(pk + PK_RM + fr * 192 + (64 + 4 * fq) * 2) = w; }
    { u32x2 w; w.x = cvt2(mrb[0], mrb[1]); w.y = cvt2(mrb[2], mrb[3]); *(u32x2*)(pk + PK_RM + fr * 192 + (80 + 4 * fq) * 2) = w; }
    {
        const int c = lane & 15;
        float x[16];
#pragma unroll
        for (int j = 0; j < 16; ++j) x[j] = (j == c) ? 1.f : 0.f;
#pragma unroll
        for (int j = 14; j >= 0; --j) {
            float acc = 0.f;
#pragma unroll
            for (int t = j + 1; t < 16; ++t) acc += sN[j * 16 + t] * x[t];
            x[j] = (j < c) ? acc : x[j];
        }
        if (lane < 16) { u32x4* d = (u32x4*)(pk + PK_TT + c * 64); d[0] = pack8f(x); d[1] = pack8f(x + 8); d[2] = (u32x4){0u, 0u, 0u, 0u}; d[3] = (u32x4){0u, 0u, 0u, 0u}; }
    }
}

DEV void phase_rwkv_prep(CP& p, int l, int bid, int nblk, float* lds) {
    bf16_t* X = (bf16_t*)lds;
    constexpr int XS = 264;
    const int tid = tid_(), lane = tid & 63, wave = tid >> 6, fr = lane & 15, fq = lane >> 4;
    const float* mu = p.rwkv_mu + (size_t)l * 1408;
    for (int it = bid; it < MTOK / 64; it += nblk) {
        __syncthreads();
        {
            const int rr = tid >> 3, c0 = (tid & 7) * 32, row = it * 64 + rr;
            int b, pos;
            if (row < MMAIN) { b = row >> 11; pos = (row & 2047) + NMETA; } else { b = (row - MMAIN) >> 4; pos = (row - MMAIN) & 15; }
            const bf16_t* cp = p.big + (size_t)row * DIN + C_RW + 1152 + c0;
            const bf16_t* pp = p.big + (size_t)row_of(b, pos > 0 ? pos - 1 : 0) * DIN + C_RW + 1152 + c0;
#pragma unroll
            for (int q = 0; q < 4; ++q) {
                const u32x4 cw = *(const u32x4*)(cp + q * 8);
                u32x4 pw = *(const u32x4*)(pp + q * 8);
                if (pos == 0) pw = (u32x4){0u, 0u, 0u, 0u};
                const int c = c0 + q * 8;
                const f32x4 m0 = *(const f32x4*)(mu + 1152 + c), m1 = *(const f32x4*)(mu + 1152 + c + 4);
                float xs[8];
#pragma unroll
                for (int j = 0; j < 4; ++j) {
                    const float a0 = __uint_as_float(cw[j] << 16), a1 = __uint_as_float(cw[j] & 0xFFFF0000u);
                    const float q0 = __uint_as_float(pw[j] << 16), q1 = __uint_as_float(pw[j] & 0xFFFF0000u);
                    const float ma = j < 2 ? m0[2 * j] : m1[2 * j - 4], mb = j < 2 ? m0[2 * j + 1] : m1[2 * j - 3];
                    xs[2 * j] = a0 + ma * (q0 - a0); xs[2 * j + 1] = a1 + mb * (q1 - a1);
                }
#pragma unroll
                for (int j = 0; j < 8; ++j) { if (c < 64) xs[j] = tanhf(xs[j]); else if (c >= 128) xs[j] = fsig(xs[j]); }
                u32x4 w; w.x = cvt2(xs[0], xs[1]); w.y = cvt2(xs[2], xs[3]); w.z = cvt2(xs[4], xs[5]); w.w = cvt2(xs[6], xs[7]);
                *(u32x4*)(X + rr * XS + c) = w;
            }
        }
        __syncthreads();
        const int rt = wave & 3, chalf = wave >> 2;
        bf16x8 af[8];
#pragma unroll
        for (int ks = 0; ks < 8; ++ks) af[ks] = *(const bf16x8*)(X + (rt * 16 + fr) * XS + ks * 32 + fq * 8);
        const int row = it * 64 + rt * 16 + fr;
        int prow; bool has_prev;
        {
            int b, pos;
            if (row < MMAIN) { b = row >> 11; pos = (row & 2047) + NMETA; } else { b = (row - MMAIN) >> 4; pos = (row - MMAIN) & 15; }
            has_prev = pos > 0; prow = row_of(b, has_prev ? pos - 1 : 0);
        }
        float ssq = 0.f, ctp = 0.f;
        for (int nt = chalf * 12; nt < chalf * 12 + 12; ++nt) {
            const bf16_t* wb = p.Wl + (size_t)(nt * 16 + fr) * 64 + fq * 8;
            const bf16_t* ab = p.Wl + DRW * 64 + (size_t)(nt * 16 + fr) * 64 + fq * 8;
            const bf16_t* gb = p.Wl + DRW * 128 + (size_t)(nt * 16 + fr) * 128 + fq * 8;
            f32x4 cw = (f32x4){0.f, 0.f, 0.f, 0.f}, ca = cw, cg = cw;
#pragma unroll
            for (int ks = 0; ks < 2; ++ks) {
                cw = __builtin_amdgcn_mfma_f32_16x16x32_bf16(*(const bf16x8*)(wb + ks * 32), af[ks], cw, 0, 0, 0);
                ca = __builtin_amdgcn_mfma_f32_16x16x32_bf16(*(const bf16x8*)(ab + ks * 32), af[2 + ks], ca, 0, 0, 0);
            }
#pragma unroll
            for (int ks = 0; ks < 4; ++ks) cg = __builtin_amdgcn_mfma_f32_16x16x32_bf16(*(const bf16x8*)(gb + ks * 32), af[4 + ks], cg, 0, 0, 0);
            const int col = nt * 16 + 4 * fq;
            const f32x4 w0 = *(const f32x4*)(p.rwkv_w0 + l * DRW + col), a0 = *(const f32x4*)(p.rwkv_a0 + l * DRW + col);
            f32x4 olw, oaa;
#pragma unroll
            for (int j = 0; j < 4; ++j) {
                const float xw = -(w0[j] + cw[j]);
                const float sp = fmaxf(xw, 0.f) + __logf(1.f + __expf(-fabsf(xw)));
                olw[j] = -__expf(-sp - 0.5f);
                oaa[j] = fsig(a0[j] + ca[j]);
            }
            const size_t o = (size_t)row * DRW + col;
            *(f32x4*)(p.lw + o) = olw; *(f32x4*)(p.aa + o) = oaa; { u32x2 gw; gw.x = cvt2(cg[0], cg[1]); gw.y = cvt2(cg[2], cg[3]); *(u32x2*)(p.gg16 + o) = gw; }
            {
                const u32x2 rc = *(const u32x2*)(p.big + (size_t)row * DIN + C_RW + col), kc = *(const u32x2*)(p.big + (size_t)row * DIN + C_RW + 384 + col);
                u32x2 rp = *(const u32x2*)(p.big + (size_t)prow * DIN + C_RW + col), kq = *(const u32x2*)(p.big + (size_t)prow * DIN + C_RW + 384 + col);
                if (!has_prev) { rp = (u32x2){0u, 0u}; kq = (u32x2){0u, 0u}; }
                const f32x4 mr4 = *(const f32x4*)(mu + col), mk4 = *(const f32x4*)(mu + 384 + col);
                const f32x4 kk4 = *(const f32x4*)(p.rwkv_kk + l * DRW + col), ka4 = *(const f32x4*)(p.rwkv_ka + l * DRW + col), rk4 = *(const f32x4*)(p.rwkv_rk + l * DRW + col);
#pragma unroll
                for (int j = 0; j < 4; ++j) {
                    const unsigned rcw = rc[j >> 1], kcw = kc[j >> 1], rpw = rp[j >> 1], kpw = kq[j >> 1];
                    const float r0 = (j & 1) ? __uint_as_float(rcw & 0xFFFF0000u) : __uint_as_float(rcw << 16);
                    const float k0 = (j & 1) ? __uint_as_float(kcw & 0xFFFF0000u) : __uint_as_float(kcw << 16);
                    const float r1 = (j & 1) ? __uint_as_float(rpw & 0xFFFF0000u) : __uint_as_float(rpw << 16);
                    const float k1 = (j & 1) ? __uint_as_float(kpw & 0xFFFF0000u) : __uint_as_float(kpw << 16);
                    const float r = r0 + mr4[j] * (r1 - r0), k = k0 + mk4[j] * (k1 - k0);
                    const float kkr = k * kk4[j];
                    ssq += kkr * kkr;
                    ctp += r * (k * (1.f + (oaa[j] - 1.f) * ka4[j])) * rk4[j];
                }
                if ((nt & 3) == 3) {
                    ssq += __shfl_xor(ssq, 16); ssq += __shfl_xor(ssq, 32);
                    ctp += __shfl_xor(ctp, 16); ctp += __shfl_xor(ctp, 32);
                    if (fq == 0) { p.inorm[(size_t)row * 8 + (nt >> 2)] = __builtin_amdgcn_rsqf(fmaxf(ssq, 1e-24f)); p.ct[(size_t)row * 8 + (nt >> 2)] = ctp; }
                    ssq = 0.f; ctp = 0.f;
                }
            }
        }
    }
}
DEV void phase_rwkv_pack(CP& p, int l, int bid, int nblk, unsigned char* lds) {
    const int wave = tid_() >> 6;
    for (int it = bid * 8 + wave; it < (MTOK / 16) * 6; it += nblk * 8) rwkv_pack_item(p, l, (it / 6) * 16, it % 6, lds + wave * 10240);
}

constexpr int P2_BUF = 4 * PK_BYTES, P2_SUV = 2 * P2_BUF, P2_GB = P2_SUV + 4 * 3328, P2_ST = P2_GB + 4 * 1280;
DEV void phase_rwkv_chunk(CP& p, int l, int item, unsigned char* lds) {
    const int tid = tid_(), lane = tid & 63, wave = tid >> 6, fr = lane & 15, fq = lane >> 4;
    const int b = item / 6, hh = item % 6;
    const unsigned char* gpk = p.pack + (size_t)(item * 129) * PK_BYTES;
    constexpr int NSC = 33;
    if (wave >= 4) {
        const int lt = tid - 256;
        u32x4 ra[16], rb[16];
#define P2_ISSUE(R, SC) { const int nb_ = (((SC) * 4 + 4 <= 129) ? 4 : 1) * (PK_BYTES / 16); const u32x4* src_ = (const u32x4*)(gpk + (size_t)(SC) * P2_BUF); \
        _Pragma("unroll") for (int q = 0; q < 16; ++q) { const int ci = lt + q * 256; if (ci < nb_) R[q] = src_[ci]; } }
#define P2_WRITE(R, SC) { const int nb_ = (((SC) * 4 + 4 <= 129) ? 4 : 1) * (PK_BYTES / 16); u32x4* dst_ = (u32x4*)(lds + ((SC) & 1) * P2_BUF); \
        _Pragma("unroll") for (int q = 0; q < 16; ++q) { const int ci = lt + q * 256; if (ci < nb_) dst_[ci] = R[q]; } }
        P2_ISSUE(ra, 0); P2_ISSUE(rb, 1); P2_WRITE(ra, 0); P2_ISSUE(ra, 2);
        __syncthreads();
        for (int sc = 0; sc < NSC; sc += 2) {
            if (sc + 1 < NSC) { P2_WRITE(rb, sc + 1); if (sc + 3 < NSC) P2_ISSUE(rb, sc + 3); }
            __syncthreads();
            if (sc + 1 < NSC) {
                if (sc + 2 < NSC) { P2_WRITE(ra, sc + 2); if (sc + 4 < NSC) P2_ISSUE(ra, sc + 4); }
                __syncthreads();
            }
        }
#undef P2_ISSUE
#undef P2_WRITE
    } else {
        unsigned char* suv = lds + P2_SUV + wave * 3328;
        unsigned char* gb = lds + P2_GB + wave * 1280;
        float* stats = (float*)(lds + P2_ST);
        for (int i = lane; i < 3328 / 4; i += 64) ((unsigned*)suv)[i] = 0u;
        for (int i = lane; i < 1280 / 4; i += 64) ((unsigned*)gb)[i] = 0u;
        f32x4 ST[4];
#pragma unroll
        for (int mt = 0; mt < 4; ++mt) ST[mt] = (f32x4){0.f, 0.f, 0.f, 0.f};
        const int vrow = wave * 16 + fr;
        const float lng = p.rwkv_ln_g[l * DRW + hh * 64 + vrow], lnb = p.rwkv_ln_b[l * DRW + hh * 64 + vrow];
        f32x4 Osv[4], ctsv[4]; u32x2 vsv[4], gsv[4];
        __syncthreads();
        auto deferred = [&](int ps) {
                const int nch = (ps * 4 + 4 <= 129) ? 4 : 1;
#pragma unroll
                for (int ch = 0; ch < 4; ++ch) if (ch < nch) {
                    const int cidx = ps * 4 + ch;
                    const float* stp = stats + (((ps & 1) * 4 + ch) * 4) * 32;
#pragma unroll
                    for (int i = 0; i < 4; ++i) {
                        const int t = 4 * fq + i;
                        float s1 = 0.f, s2 = 0.f;
#pragma unroll
                        for (int w = 0; w < 4; ++w) { s1 += stp[w * 32 + t * 2]; s2 += stp[w * 32 + t * 2 + 1]; }
                        const float m = s1 * (1.f / 64.f), var = fmaxf(s2 * (1.f / 64.f) - m * m, 0.f);
                        const unsigned vw = vsv[ch][i >> 1], gw = gsv[ch][i >> 1];
                        const float vval = (i & 1) ? __uint_as_float(vw & 0xFFFF0000u) : __uint_as_float(vw << 16);
                        const float gval = (i & 1) ? __uint_as_float(gw & 0xFFFF0000u) : __uint_as_float(gw << 16);
                        float yv = (Osv[ch][i] - m) * rsqrtf(var + 64e-5f) * lng + lnb;
                        yv = (yv + ctsv[ch][i] * vval) * gval;
                        const int row = cidx == 0 ? MMAIN + b * NMETA + t : b * SEQ + cidx * 16 - NMETA + t;
                        p.y[(size_t)row * DM + 256 + hh * 64 + vrow] = f2bf(yv);
                    }
                }
        };
        for (int sc = 0; sc < NSC; ++sc) {
            if (sc > 0) deferred(sc - 1);
            {
                const int nch = (sc * 4 + 4 <= 129) ? 4 : 1;
#pragma unroll
                for (int ch = 0; ch < 4; ++ch) if (ch < nch) {
                    const unsigned char* pk = lds + (sc & 1) * P2_BUF + ch * PK_BYTES;
#pragma unroll
                    for (int mt = 0; mt < 4; ++mt) { u32x2 w; w.x = cvt2(ST[mt][0], ST[mt][1]); w.y = cvt2(ST[mt][2], ST[mt][3]); *(u32x2*)(suv + fr * 208 + (16 * mt + 4 * fq) * 2) = w; }
                    vsv[ch] = *(const u32x2*)(pk + PK_VT + vrow * 32 + 4 * fq * 2);
                    gsv[ch] = *(const u32x2*)(pk + PK_GT + vrow * 32 + 4 * fq * 2);
                    ctsv[ch] = *(const f32x4*)(pk + PK_CT + 4 * fq * 4);
                    *(u32x2*)(suv + fr * 208 + (64 + 4 * fq) * 2) = vsv[ch];
                    bf16x8 bs[3];
                    f32x4 G = (f32x4){0.f, 0.f, 0.f, 0.f};
#pragma unroll
                    for (int ks = 0; ks < 3; ++ks) {
                        bs[ks] = *(const bf16x8*)(suv + fr * 208 + (32 * ks + 8 * fq) * 2);
                        G = __builtin_amdgcn_mfma_f32_16x16x32_bf16(*(const bf16x8*)(pk + PK_AN + fr * 192 + (32 * ks + 8 * fq) * 2), bs[ks], G, 0, 0, 0);
                    }
                    { u32x2 w; w.x = cvt2(G[0], G[1]); w.y = cvt2(G[2], G[3]); *(u32x2*)(gb + fr * 80 + 4 * fq * 2) = w; }
                    f32x4 U = __builtin_amdgcn_mfma_f32_16x16x32_bf16(*(const bf16x8*)(pk + PK_TT + fr * 64 + 8 * fq * 2), *(const bf16x8*)(gb + fr * 80 + 8 * fq * 2), (f32x4){0.f, 0.f, 0.f, 0.f}, 0, 0, 0);
                    { u32x2 w; w.x = cvt2(U[0], U[1]); w.y = cvt2(U[2], U[3]); *(u32x2*)(suv + fr * 208 + (80 + 4 * fq) * 2) = w; }
                    const bf16x8 bvu = *(const bf16x8*)(suv + fr * 208 + (64 + 8 * fq) * 2);
                    f32x4 O = (f32x4){0.f, 0.f, 0.f, 0.f};
                    O = __builtin_amdgcn_mfma_f32_16x16x32_bf16(*(const bf16x8*)(pk + PK_RM + fr * 192 + (8 * fq) * 2), bs[0], O, 0, 0, 0);
                    O = __builtin_amdgcn_mfma_f32_16x16x32_bf16(*(const bf16x8*)(pk + PK_RM + fr * 192 + (32 + 8 * fq) * 2), bs[1], O, 0, 0, 0);
                    O = __builtin_amdgcn_mfma_f32_16x16x32_bf16(*(const bf16x8*)(pk + PK_RM + fr * 192 + (64 + 8 * fq) * 2), bvu, O, 0, 0, 0);
#pragma unroll
                    for (int mt = 0; mt < 4; ++mt) {
                        ST[mt] = __builtin_amdgcn_mfma_f32_16x16x32_bf16(*(const bf16x8*)(pk + PK_KB + (16 * mt + fr) * 64 + 8 * fq * 2), bvu, ST[mt], 0, 0, 0);
                        ST[mt] *= *(const f32x4*)(pk + PK_GC + (16 * mt + 4 * fq) * 4);
                    }
                    Osv[ch] = O;
                    float* stp = stats + (((sc & 1) * 4 + ch) * 4 + wave) * 32;
#pragma unroll
                    for (int i = 0; i < 4; ++i) {
                        const float s1 = dpp_sum16(O[i]), s2 = dpp_sum16(O[i] * O[i]);
                        if (fr == 0) { stp[(4 * fq + i) * 2] = s1; stp[(4 * fq + i) * 2 + 1] = s2; }
                    }
                }
            }
            __syncthreads();
        }
        deferred(NSC - 1);
    }
}

DEV void phase_pack_prefetch(CP& p, int item) {
    const u32x4* src = (const u32x4*)(p.pack + (size_t)(item * 129) * PK_BYTES);
    const int n = 129 * (PK_BYTES / 16), tid = tid_();
    u32x4 acc = (u32x4){0u, 0u, 0u, 0u};
    for (int i = tid; i < n; i += 512 * 4) {
        u32x4 a = src[i], b = (i + 512 < n) ? src[i + 512] : acc, c = (i + 1024 < n) ? src[i + 1024] : acc, d = (i + 1536 < n) ? src[i + 1536] : acc;
        acc ^= a; acc ^= b; acc ^= c; acc ^= d;
    }
    asm volatile("" :: "v"(acc.x), "v"(acc.y), "v"(acc.z), "v"(acc.w));
}
DEV void phase_sb_mfma(CP& p, int l, int bid, int nblk) {
    const int tid = tid_(), lane = tid & 63, wave = tid >> 6, r = lane & 31, h = lane >> 5;
    for (int it = bid * 8 + wave; it < NB * 6 * 65; it += nblk * 8) {
        const int qt = it % 65, bh = it / 65, b = bh / 6, hh = bh % 6;
        const int q0 = qt * 32, t = q0 + r;
        const bool valid = t < LT;
        const int myrow = row_of(b, valid ? t : LT - 1);
        bf16x8 qf[4];
        {
            const bf16_t* qp = p.big + (size_t)myrow * DIN + C_Q + hh * 64 + 8 * h;
#pragma unroll
            for (int ks = 0; ks < 4; ++ks) qf[ks] = *(const bf16x8*)(qp + 16 * ks);
        }
        f32x16 o0, o1;
#pragma unroll
        for (int i = 0; i < 16; ++i) { o0[i] = 0.f; o1[i] = 0.f; }
        float carry = 0.f;
        const bf16_t* vbase = p.vt + (size_t)((b * 6 + hh) * 64 + r) * LPV + 4 * h;
        bf16x8 kf[4];
        {
            const bf16_t* kp = p.big + (size_t)row_of(b, q0 + r) * DIN + C_K + hh * 64 + 8 * h;
#pragma unroll
            for (int ks = 0; ks < 4; ++ks) kf[ks] = *(const bf16x8*)(kp + 16 * ks);
        }
        for (int k0 = q0; k0 >= 0; k0 -= 32) {
            bf16x8 vf[2][2];
#pragma unroll
            for (int db = 0; db < 2; ++db)
#pragma unroll
                for (int s = 0; s < 2; ++s) {
                    const bf16_t* vp = vbase + (size_t)(db * 32) * LPV + k0 + 16 * s;
                    const s16x4 lo = *(const s16x4*)vp, hi = *(const s16x4*)(vp + 8);
                    vf[db][s] = __builtin_shufflevector(lo, hi, 0, 1, 2, 3, 4, 5, 6, 7);
                }
            bf16x8 kn[4];
            {
                const int kpos = k0 >= 32 ? k0 - 32 + r : r;
                const bf16_t* kp = p.big + (size_t)row_of(b, kpos) * DIN + C_K + hh * 64 + 8 * h;
#pragma unroll
                for (int ks = 0; ks < 4; ++ks) kn[ks] = *(const bf16x8*)(kp + 16 * ks);
            }
            f32x16 x;
#pragma unroll
            for (int i = 0; i < 16; ++i) x[i] = 0.f;
#pragma unroll
            for (int ks = 0; ks < 4; ++ks) x = __builtin_amdgcn_mfma_f32_32x32x16_bf16(kf[ks], qf[ks], x, 0, 0, 0);
            float lr[16], ls[16];
#pragma unroll
            for (int i = 0; i < 16; ++i) {
                const int key = k0 + (i & 3) + 8 * (i >> 2) + 4 * h;
                const float z = x[i] * 0.125f;
                const float sp = __logf(1.f + __expf(-fabsf(z)));
                const float lsi = fminf(z, 0.f) - sp;
                ls[i] = lsi;
                lr[i] = key < t ? lsi - z : 0.f;
            }
            float pw[16];
            float run = carry;
#pragma unroll
            for (int g = 3; g >= 0; --g) {
                const float G = (lr[4 * g] + lr[4 * g + 1]) + (lr[4 * g + 2] + lr[4 * g + 3]);
                const float Gp = __shfl_xor(G, 32);
                const float s3 = run + (h == 0 ? Gp : 0.f);
                const float s2 = s3 + lr[4 * g + 3], s1 = s2 + lr[4 * g + 2], s0 = s1 + lr[4 * g + 1];
                const int keyb = k0 + 8 * g + 4 * h;
                pw[4 * g + 3] = keyb + 3 < t ? __expf(ls[4 * g + 3] + s3) : 0.f;
                pw[4 * g + 2] = keyb + 2 < t ? __expf(ls[4 * g + 2] + s2) : 0.f;
                pw[4 * g + 1] = keyb + 1 < t ? __expf(ls[4 * g + 1] + s1) : 0.f;
                pw[4 * g + 0] = keyb + 0 < t ? __expf(ls[4 * g + 0] + s0) : 0.f;
                run += G + Gp;
            }
            carry = run;
            const bf16x8 pf0 = pack_frag(pw[0], pw[1], pw[2], pw[3], pw[4], pw[5], pw[6], pw[7]);
            const bf16x8 pf1 = pack_frag(pw[8], pw[9], pw[10], pw[11], pw[12], pw[13], pw[14], pw[15]);
            o0 = __builtin_amdgcn_mfma_f32_32x32x16_bf16(vf[0][0], pf0, o0, 0, 0, 0);
            o0 = __builtin_amdgcn_mfma_f32_32x32x16_bf16(vf[0][1], pf1, o0, 0, 0, 0);
            o1 = __builtin_amdgcn_mfma_f32_32x32x16_bf16(vf[1][0], pf0, o1, 0, 0, 0);
            o1 = __builtin_amdgcn_mfma_f32_32x32x16_bf16(vf[1][1], pf1, o1, 0, 0, 0);
#pragma unroll
            for (int ks = 0; ks < 4; ++ks) kf[ks] = kn[ks];
            if (__all((!valid || carry < -110.f) ? 1 : 0)) break;
        }
        float ss = 0.f;
#pragma unroll
        for (int i = 0; i < 16; ++i) ss += o0[i] * o0[i] + o1[i] * o1[i];
        ss += __shfl_xor(ss, 32);
        const float rs = rsqrtf(ss * (1.f / 64.f) + 1e-6f);
        if (valid) {
            const float* g = p.sb_norm + l * 384 + hh * 64 + 4 * h;
            bf16_t* yp = p.y + (size_t)myrow * DM + 640 + hh * 64 + 4 * h;
#pragma unroll
            for (int gq = 0; gq < 4; ++gq) {
                const f32x4 g0 = *(const f32x4*)(g + 8 * gq), g1 = *(const f32x4*)(g + 32 + 8 * gq);
                u32x2 w0, w1;
                w0.x = cvt2(o0[4 * gq] * rs * g0[0], o0[4 * gq + 1] * rs * g0[1]); w0.y = cvt2(o0[4 * gq + 2] * rs * g0[2], o0[4 * gq + 3] * rs * g0[3]);
                w1.x = cvt2(o1[4 * gq] * rs * g1[0], o1[4 * gq + 1] * rs * g1[1]); w1.y = cvt2(o1[4 * gq + 2] * rs * g1[2], o1[4 * gq + 3] * rs * g1[3]);
                *(u32x2*)(yp + 8 * gq) = w0;
                *(u32x2*)(yp + 32 + 8 * gq) = w1;
            }
        }
    }
}

DEV void phase_final(CP& p, int bid, int nblk) {
    const int lane = tid_() & 63, wave = tid_() >> 6;
    for (int r = bid * 8 + wave; r < MMAIN; r += nblk * 8) {
        const float rs = row_rstd(p.part, r);
#pragma unroll
        for (int i = 0; i < 4; ++i) {
            const int c = (i * 64 + lane) * 4;
            const f32x4 v = *(const f32x4*)(p.h + (size_t)r * DM + c), g = *(const f32x4*)(p.final_norm + c);
            *(f32x4*)(p.out + (size_t)r * DM + c) = v * rs * g;
        }
    }
}

#define XB_TMO      128
#define XB_XCNT(j)  (256  + 64 * (j))
#define XB_XSUB(j)  (1280 + 64 * (j))
#define XB_XGEN(j)  (2304 + 64 * (j))
#define XB_TOP      3328
#define XB_TOPGEN   3392
#define XCD_BAR_WORDS 3456
#define XB_SPIN_CAP (1u << 18)
#define XB_LAS __attribute__((address_space(3)))

__device__ __forceinline__ unsigned xb_ld(unsigned* p)              { return __hip_atomic_load(p, __ATOMIC_RELAXED, __HIP_MEMORY_SCOPE_AGENT); }
__device__ __forceinline__ unsigned xb_add(unsigned* p, unsigned v) { return __hip_atomic_fetch_add(p, v, __ATOMIC_RELAXED, __HIP_MEMORY_SCOPE_AGENT); }
__device__ __forceinline__ unsigned xb_xcc_id() { return (unsigned)__builtin_amdgcn_s_getreg((3 << 11) | 20) & 0xFu; }
#define XB_SPIN(cond, bar) do { unsigned _sp = 0; while (cond) { __builtin_amdgcn_s_sleep(1); \
    if ((++_sp & 255u) == 0u) { if (xb_ld(&(bar)[XB_TMO])) break; if (_sp > XB_SPIN_CAP) { atomicAdd(&(bar)[XB_TMO], 1u); break; } } } } while (0)

struct XcdBarrier {
    unsigned* bar; unsigned x;
    volatile XB_LAS unsigned* st;
};

__device__ __forceinline__ XcdBarrier xcd_barrier_post(unsigned* bar, volatile XB_LAS unsigned* st) {
    XcdBarrier b; b.bar = bar; b.x = xb_xcc_id(); b.st = st;
    if (threadIdx.x == 0) (void)xb_add(&bar[XB_XCNT(b.x)], 1u);
    return b;
}
__device__ __forceinline__ void xcd_barrier_complete(unsigned* bar, unsigned x, unsigned& nloc, unsigned& nx) {
    const unsigned G = gridDim.x * gridDim.y * gridDim.z;
    unsigned sum, cnt, mine, sp = 0u;
    for (;;) {
        sum = 0u; cnt = 0u; mine = 0u;
#pragma unroll
        for (unsigned j = 0; j < 16; ++j) { const unsigned c = xb_ld(&bar[XB_XCNT(j)]); sum += c; cnt += (c > 0u) ? 1u : 0u; mine = (j == x) ? c : mine; }
        if (sum == G) break;
        __builtin_amdgcn_s_sleep(1);
        if ((++sp & 255u) == 0u) { if (xb_ld(&bar[XB_TMO])) break; if (sp > XB_SPIN_CAP) { atomicAdd(&bar[XB_TMO], 1u); break; } }
    }
    nloc = mine > 0u ? mine : 1u; nx = cnt > 0u ? cnt : 1u;
}

__device__ __forceinline__ void xcd_barrier(const XcdBarrier& b) {
    asm volatile("s_waitcnt vmcnt(0)" ::: "memory");
    __syncthreads();
    if (threadIdx.x == 0) {
        unsigned* bar = b.bar;
        __builtin_amdgcn_s_waitcnt(0);
        unsigned nloc = b.st[0], nx = b.st[1];
        if (nloc == 0u) { xcd_barrier_complete(bar, b.x, nloc, nx); b.st[0] = nloc; b.st[1] = nx; }
        const unsigned old = xb_add(&bar[XB_XSUB(b.x)], 1u);
        const unsigned gen = old / nloc;
        if (old + 1u == (gen + 1u) * nloc) {
            __builtin_amdgcn_fence(__ATOMIC_RELEASE, "agent");
            asm volatile("s_waitcnt vmcnt(0)" ::: "memory");
            const unsigned og = xb_add(&bar[XB_TOP], 1u);
            const unsigned tg = og / nx;
            if (og + 1u == (tg + 1u) * nx) xb_add(&bar[XB_TOPGEN], 1u);
            else XB_SPIN(xb_ld(&bar[XB_TOPGEN]) == tg, bar);
            __builtin_amdgcn_fence(__ATOMIC_ACQUIRE, "agent");
            xb_add(&bar[XB_XGEN(b.x)], 1u);
            asm volatile("s_waitcnt vmcnt(0)" ::: "memory");
        } else {
            XB_SPIN(xb_ld(&bar[XB_XGEN(b.x)]) == gen, bar);
            __builtin_amdgcn_fence(__ATOMIC_ACQUIRE, "agent");
            asm volatile("s_waitcnt vmcnt(0)" ::: "memory");
        }
    }
    __syncthreads();
}


enum { PH_INIT = 0, PH_CONVERT, PH_G1A, PH_G2A, PH_G3, PH_CONV, PH_PREP, PH_SCAN, PH_SB, PH_G4, PH_G1B, PH_G2B, PH_FINAL };

DEV void run_phase(CP& p, int ph, int l, int bid, int nblk, float* lds) {
    switch (ph) {
    case PH_INIT: phase_init(p, bid, nblk); break;
    case PH_G1A: gemm_big(p.hb, p.W13a, MMAIN, 2 * DFF, DM, EpiSwiglu{p.big, p.part}, bid, nblk, (unsigned char*)lds);
        if (bid >= 128) gemm_meta<EPI_SWIGLU>(p, p.hb, p.W13a, 2 * DFF, DM, 0.f, bid - 128, nblk - 128, lds); break;
    case PH_G2A: gemm_big(p.big, p.W2a, MMAIN, DM, DFF, EpiResid{p.h, p.hb, p.part, 0.5f}, bid, nblk, (unsigned char*)lds);
        gemm_meta<EPI_RESID>(p, p.big, p.W2a, DM, DFF, 0.5f, bid, nblk, lds); break;
    case PH_G3: gemm_big(p.hb, p.Win, MMAIN, DIN, DM, EpiP{p.big, p.vt, p.part}, bid, nblk, (unsigned char*)lds);
        gemm_meta<EPI_P>(p, p.hb, p.Win, DIN, DM, 0.f, bid, nblk, lds); break;
    case PH_CONV: phase_conv(p, l, bid, nblk, lds); break;
    case PH_PREP: phase_rwkv_prep(p, l, bid, nblk, lds); break;
    case PH_G4: gemm_big(p.y, p.Wout, MMAIN, DM, DM, EpiResid{p.h, p.hb, p.part, 1.0f}, bid, nblk, (unsigned char*)lds);
        gemm_meta<EPI_RESID>(p, p.y, p.Wout, DM, DM, 1.0f, bid, nblk, lds); break;
    case PH_G1B: gemm_big(p.hb, p.W13b, MMAIN, 2 * DFF, DM, EpiSwiglu{p.big, p.part}, bid, nblk, (unsigned char*)lds);
        if (bid >= 128) gemm_meta<EPI_SWIGLU>(p, p.hb, p.W13b, 2 * DFF, DM, 0.f, bid - 128, nblk - 128, lds); break;
    case PH_G2B: gemm_big(p.big, p.W2b, MMAIN, DM, DFF, EpiResid{p.h, p.hb, p.part, 0.5f}, bid, nblk, (unsigned char*)lds);
        gemm_meta<EPI_RESID>(p, p.big, p.W2b, DM, DFF, 0.5f, bid, nblk, lds); break;
    case PH_FINAL: phase_final(p, bid, nblk); break;
    }
}

namespace cg = cooperative_groups;
constexpr int NSIDE = 136;
constexpr int LDS_BYTES = 151552 + 16;

__global__ void __launch_bounds__(512) k_mega(P p) {
    extern __shared__ __attribute__((aligned(16))) unsigned char smem[];
    float* lds = (float*)smem;
    cg::grid_group grid = cg::this_grid();
    const int bid0 = blockIdx.x, nblk = gridDim.x;
    volatile XB_LAS unsigned* xst = (volatile XB_LAS unsigned*)((XB_LAS unsigned char*)smem + (LDS_BYTES - 16));
    if (threadIdx.x < 4) xst[threadIdx.x] = 0u;
    __syncthreads();
    (void)xcd_barrier_post(kargs()->bar, xst);
#define XBAR() { XcdBarrier xb_; xb_.bar = kargs()->bar; xb_.x = xb_xcc_id(); xb_.st = xst; xcd_barrier(xb_); }
    phase_init(*kargs(), bid0, nblk);
    phase_convert(*kargs(), 0, 0, bid0, nblk, lds);
    if (nblk == 0x7fffffff) grid.sync();
    XBAR();
    for (int l = 0; l < 4; ++l) {
        int bid = bid0; asm volatile("" : "+s"(bid));
        run_phase(*kargs(), PH_G1A, l, bid, nblk, lds); XBAR();
        run_phase(*kargs(), PH_G2A, l, bid, nblk, lds); XBAR();
        run_phase(*kargs(), PH_G3, l, bid, nblk, lds); XBAR();
        run_phase(*kargs(), PH_PREP, l, bid, nblk, lds);
        XBAR();
        phase_rwkv_pack(*kargs(), l, bid, nblk, smem);
        XBAR();
        if (bid < 48) phase_rwkv_chunk(*kargs(), l, bid, smem);
        else if (bid < 48 + NSIDE) {
            phase_sb_mfma(*kargs(), l, bid - 48, NSIDE);
            __syncthreads();
            phase_conv(*kargs(), l, bid - 48, NSIDE, lds);
            phase_convert(*kargs(), l, 1, bid - 48, NSIDE, lds);
            if (l < 3) phase_convert(*kargs(), l + 1, 0, bid - 48, NSIDE, lds);
        } else if (bid < 48 + NSIDE + 48) phase_pack_prefetch(*kargs(), bid - 48 - NSIDE);
        XBAR();
        run_phase(*kargs(), PH_G4, l, bid, nblk, lds); XBAR();
        run_phase(*kargs(), PH_G1B, l, bid, nblk, lds); XBAR();
        run_phase(*kargs(), PH_G2B, l, bid, nblk, lds); XBAR();
    }
    phase_final(*kargs(), bid0, nblk);
}
#undef XBAR

extern "C" void kernel_launch(void* const* d_in, const int* in_sizes, int n_in, void* d_out, int out_size, void* d_ws, size_t ws_size, hipStream_t stream) {
    static int grid_blocks = 0;
    if (grid_blocks == 0) {
        int dev = 0, cus = 0, per_cu = 0;
        hipGetDevice(&dev);
        hipDeviceGetAttribute(&cus, hipDeviceAttributeMultiprocessorCount, dev);
        if (hipFuncSetAttribute((const void*)k_mega, hipFuncAttributeMaxDynamicSharedMemorySize, LDS_BYTES) != hipSuccess) { fprintf(stderr, "hipFuncSetAttribute failed\n"); grid_blocks = -1; return; }
        if (hipOccupancyMaxActiveBlocksPerMultiprocessor(&per_cu, (const void*)k_mega, 512, LDS_BYTES) != hipSuccess || per_cu < 1) { fprintf(stderr, "occupancy query failed (%d)\n", per_cu); per_cu = 1; }
        (void)hipGetLastError();
        grid_blocks = cus * per_cu;
    }
    if (grid_blocks < 0) return;
    P p{};
    const float** f = (const float**)&p;
    for (int i = 0; i < 28; ++i) f[i] = (const float*)d_in[i];
    p.out = (float*)d_out;
    size_t off = 0;
    auto take = [&](size_t bytes) { void* r = (char*)d_ws + off; off += (bytes + 255) & ~(size_t)255; return r; };
    p.W13a = (bf16_t*)take((size_t)2 * DFF * DM * 2);
    p.W2a = (bf16_t*)take((size_t)DM * DFF * 2);
    p.Win = (bf16_t*)take((size_t)DIN * DM * 2);
    p.Wout = (bf16_t*)take((size_t)DM * DM * 2);
    p.W13b = (bf16_t*)take((size_t)2 * DFF * DM * 2);
    p.W2b = (bf16_t*)take((size_t)DM * DFF * 2);
    p.Wl = (bf16_t*)take((size_t)DRW * 256 * 2);
    p.h = (float*)take((size_t)MP * DM * 4);
    p.hb = (bf16_t*)take((size_t)MP * DM * 2);
    p.big = (bf16_t*)take((size_t)MP * DIN * 2);
    p.y = (bf16_t*)take((size_t)MP * DM * 2);
    p.vt = (bf16_t*)take((size_t)NB * 6 * 64 * LPV * 2);
    p.part = (float*)take((size_t)MP * 16 * 4);
    p.lw = (float*)p.hb;
    p.aa = (float*)p.y;
    p.gg16 = (bf16_t*)take((size_t)MP * DRW * 2);
    p.pack = (unsigned char*)take((size_t)NB * 6 * 129 * PK_BYTES);
    p.ct = (float*)take((size_t)MP * 8 * 4);
    p.inorm = (float*)take((size_t)MP * 8 * 4);
    p.bar = (unsigned*)take((size_t)XCD_BAR_WORDS * 4);
    if (off > ws_size) { fprintf(stderr, "workspace too small: need %zu have %zu\n", off, ws_size); return; }
    if (hipMemsetAsync(p.bar, 0, (size_t)XCD_BAR_WORDS * 4, stream) != hipSuccess) { fprintf(stderr, "memset of barrier words failed\n"); return; }
    void* args[] = {&p};
    hipError_t e = hipLaunchCooperativeKernel((const void*)k_mega, dim3(grid_blocks), dim3(512), args, LDS_BYTES, stream);
    if (e != hipSuccess) fprintf(stderr, "cooperative launch failed: %s (grid %d)\n", hipGetErrorString(e), grid_blocks);
}
```

```cpp
#include <hip/hip_runtime.h>
#include <hip/hip_cooperative_groups.h>
#include <stdint.h>
#include <stdio.h>

typedef unsigned short bf16_t;
typedef short bf16x8 __attribute__((ext_vector_type(8)));
typedef float f32x4 __attribute__((ext_vector_type(4)));
typedef unsigned u32x4 __attribute__((ext_vector_type(4)));
typedef unsigned u32x2 __attribute__((ext_vector_type(2)));

#define DEV __device__ __forceinline__

constexpr int NB = 8, SEQ = 2048, NMETA = 16, LT = 2064, DM = 1024, DFF = 2816, DIN = 3072;
constexpr int MMAIN = 16384, MTOK = 16512, MP = 16640;
constexpr int DRW = 384, LPV = 2080;
constexpr int C_RW = 512, C_Q = 1920, C_K = 2304, C_V = 2688;

struct P {
    const float *x, *meta, *ffn1_norm, *ffn1_w13, *ffn1_w2, *mix_norm, *w_in, *conv_w, *conv_b, *conv_ln_g, *conv_ln_b,
        *rwkv_mu, *rwkv_w0, *rwkv_wB, *rwkv_a0, *rwkv_aB, *rwkv_gB, *rwkv_kk, *rwkv_ka, *rwkv_rk, *rwkv_ln_g, *rwkv_ln_b,
        *sb_norm, *w_out, *ffn2_norm, *ffn2_w13, *ffn2_w2, *final_norm;
    float* out;
    bf16_t *W13a, *W2a, *Win, *Wout, *W13b, *W2b, *Wl;
    float* h; bf16_t* hb; bf16_t* big; bf16_t* y; bf16_t* vt; float* part;
    float *lw, *aa, *ct, *inorm; bf16_t* gg16; unsigned char* pack;
    unsigned* bar;
};

typedef const __attribute__((address_space(4))) P CP;
DEV CP* kargs() { CP* k = (CP*)__builtin_amdgcn_kernarg_segment_ptr(); asm volatile("" : "+s"(k)); return k; }
DEV int tid_() { int t = threadIdx.x; asm volatile("" : "+v"(t)); return t; }
DEV float bf2f(bf16_t v) { return __uint_as_float(((unsigned)v) << 16); }
DEV bf16_t f2bf(float f) { unsigned u = __float_as_uint(f); u += 0x7FFFu + ((u >> 16) & 1u); return (bf16_t)(u >> 16); }
DEV unsigned pack2(float a, float b) { return (unsigned)f2bf(a) | ((unsigned)f2bf(b) << 16); }
DEV float wave_sum(float v) {
#pragma unroll
    for (int o = 32; o; o >>= 1) v += __shfl_xor(v, o);
    return v;
}
DEV float dpp_sum16(float x) {
    x += __builtin_bit_cast(float, __builtin_amdgcn_update_dpp(0, __builtin_bit_cast(int, x), 0xB1, 0xF, 0xF, false));
    x += __builtin_bit_cast(float, __builtin_amdgcn_update_dpp(0, __builtin_bit_cast(int, x), 0x4E, 0xF, 0xF, false));
    x += __builtin_bit_cast(float, __builtin_amdgcn_update_dpp(0, __builtin_bit_cast(int, x), 0x141, 0xF, 0xF, false));
    x += __builtin_bit_cast(float, __builtin_amdgcn_update_dpp(0, __builtin_bit_cast(int, x), 0x140, 0xF, 0xF, false));
    return x;
}
DEV float wave_sum_fast(float x) {
    x = dpp_sum16(x);
    const int xi = __builtin_bit_cast(int, x);
    return (__builtin_bit_cast(float, __builtin_amdgcn_readlane(xi, 0)) + __builtin_bit_cast(float, __builtin_amdgcn_readlane(xi, 16))) +
           (__builtin_bit_cast(float, __builtin_amdgcn_readlane(xi, 32)) + __builtin_bit_cast(float, __builtin_amdgcn_readlane(xi, 48)));
}
typedef float f32x16 __attribute__((ext_vector_type(16)));
typedef __bf16 bfv2 __attribute__((ext_vector_type(2)));
typedef float f32x2v __attribute__((ext_vector_type(2)));
typedef short s16x4 __attribute__((ext_vector_type(4)));
DEV unsigned cvt2(float a, float b) { return __builtin_bit_cast(unsigned, __builtin_convertvector((f32x2v){a, b}, bfv2)); }
DEV bf16x8 pack_frag(float a0, float a1, float a2, float a3, float a4, float a5, float a6, float a7) {
    u32x4 w; w.x = cvt2(a0, a1); w.y = cvt2(a2, a3); w.z = cvt2(a4, a5); w.w = cvt2(a6, a7);
    return __builtin_bit_cast(bf16x8, w);
}
DEV float sigm(float x) { return 1.f / (1.f + expf(-x)); }
DEV int row_of(int b, int pos) { return pos < NMETA ? MMAIN + b * NMETA + pos : b * SEQ + pos - NMETA; }
DEV float row_rstd(const float* part, int row) {
    const f32x4* pp = (const f32x4*)(part + (size_t)row * 16);
    f32x4 a = pp[0], b = pp[1], c = pp[2], d = pp[3];
    float ss = ((a[0] + a[1]) + (a[2] + a[3])) + ((b[0] + b[1]) + (b[2] + b[3])) + ((c[0] + c[1]) + (c[2] + c[3])) + ((d[0] + d[1]) + (d[2] + d[3]));
    return rsqrtf(ss * (1.0f / 1024.0f) + 1e-6f);
}

DEV void phase_init(CP& p, int bid, int nblk) {
    const int lane = tid_() & 63, wave = tid_() >> 6;
    for (int r = bid * 8 + wave; r < MP; r += nblk * 8) {
        const float* src = nullptr;
        if (r < MMAIN) src = p.x + (size_t)r * DM;
        else if (r < MTOK) src = p.meta + (size_t)((r - MMAIN) & 15) * DM;
        float ss = 0.f;
#pragma unroll
        for (int i = 0; i < 4; ++i) {
            const int c = (i * 64 + lane) * 4;
            f32x4 v = src ? *(const f32x4*)(src + c) : (f32x4){0.f, 0.f, 0.f, 0.f};
            *(f32x4*)(p.h + (size_t)r * DM + c) = v;
            u32x2 w; w.x = pack2(v[0], v[1]); w.y = pack2(v[2], v[3]);
            *(u32x2*)(p.hb + (size_t)r * DM + c) = w;
            ss += v[0] * v[0] + v[1] * v[1] + v[2] * v[2] + v[3] * v[3];
        }
        ss = wave_sum(ss);
        if (lane < 16) p.part[(size_t)r * 16 + lane] = lane == 0 ? ss : 0.f;
    }
    for (int i = bid * 512 + tid_(); i < NB * 6 * 64 * (LPV - LT); i += nblk * 512) p.vt[(size_t)(i >> 4) * LPV + LT + (i & 15)] = 0;
}

struct ConvDesc { const float* W; const float* g; bf16_t* dst; int K, N, swz, kt, nt; };
DEV ConvDesc conv_desc(CP& p, int l, int grp, int idx) {
    ConvDesc d;
    int t = idx;
    if (grp == 2) { if (t < 2368) grp = 1; else { t -= 2368; grp = 0; l += 1; } }
    if (grp == 0) {
        if (t < 1408) { d.W = p.ffn1_w13 + (size_t)l * DM * 2 * DFF; d.g = p.ffn1_norm + l * DM; d.dst = p.W13a; d.K = DM; d.N = 2 * DFF; d.swz = 1; d.kt = t / 88; d.nt = t % 88; return d; }
        t -= 1408;
        if (t < 704) { d.W = p.ffn1_w2 + (size_t)l * DFF * DM; d.g = nullptr; d.dst = p.W2a; d.K = DFF; d.N = DM; d.swz = 0; d.kt = t / 16; d.nt = t % 16; return d; }
        t -= 704;
        if (t < 768) { d.W = p.w_in + (size_t)l * DM * DIN; d.g = p.mix_norm + l * DM; d.dst = p.Win; d.K = DM; d.N = DIN; d.swz = 0; d.kt = t / 48; d.nt = t % 48; return d; }
        t -= 768;
        d.g = nullptr; d.N = DRW; d.swz = 0;
        if (t < 6) { d.W = p.rwkv_wB + (size_t)l * 64 * DRW; d.dst = p.Wl; d.K = 64; d.kt = 0; d.nt = t; return d; }
        if (t < 12) { d.W = p.rwkv_aB + (size_t)l * 64 * DRW; d.dst = p.Wl + DRW * 64; d.K = 64; d.kt = 0; d.nt = t - 6; return d; }
        d.W = p.rwkv_gB + (size_t)l * 128 * DRW; d.dst = p.Wl + DRW * 128; d.K = 128; d.kt = (t - 12) / 6; d.nt = (t - 12) % 6; return d;
    }
    if (t < 256) { d.W = p.w_out + (size_t)l * DM * DM; d.g = nullptr; d.dst = p.Wout; d.K = DM; d.N = DM; d.swz = 0; d.kt = t / 16; d.nt = t % 16; return d; }
    t -= 256;
    if (t < 1408) { d.W = p.ffn2_w13 + (size_t)l * DM * 2 * DFF; d.g = p.ffn2_norm + l * DM; d.dst = p.W13b; d.K = DM; d.N = 2 * DFF; d.swz = 1; d.kt = t / 88; d.nt = t % 88; return d; }
    t -= 1408;
    d.W = p.ffn2_w2 + (size_t)l * DFF * DM; d.g = nullptr; d.dst = p.W2b; d.K = DFF; d.N = DM; d.swz = 0; d.kt = t / 16; d.nt = t % 16; return d;
}
constexpr int CONV_A = 2904, CONV_B = 2368;
DEV void conv_load(const ConvDesc& d, int tid, f32x4 (&v)[2]) {
#pragma unroll
    for (int i = 0; i < 2; ++i) {
        const int idx = tid + i * 512, kk = idx >> 4, n4 = (idx & 15) * 4;
        v[i] = *(const f32x4*)(d.W + (size_t)(d.kt * 64 + kk) * d.N + d.nt * 64 + n4);
        if (d.g) v[i] *= d.g[d.kt * 64 + kk];
    }
}
DEV void conv_tile_store(const ConvDesc& dc, int tid, const float* tile) {
    const int nn = tid >> 3, kc = (tid & 7) * 8;
    const int sc = dc.nt * 64 + nn;
    int nd = sc;
    if (dc.swz) { const int bj = sc >= DFF ? 1 : 0; const int j = sc - bj * DFF; nd = (j >> 7) * 256 + bj * 128 + (j & 127); }
    u32x4 w;
    w.x = cvt2(tile[(kc + 0) * 65 + nn], tile[(kc + 1) * 65 + nn]); w.y = cvt2(tile[(kc + 2) * 65 + nn], tile[(kc + 3) * 65 + nn]);
    w.z = cvt2(tile[(kc + 4) * 65 + nn], tile[(kc + 5) * 65 + nn]); w.w = cvt2(tile[(kc + 6) * 65 + nn], tile[(kc + 7) * 65 + nn]);
    *(u32x4*)(dc.dst + (size_t)nd * dc.K + dc.kt * 64 + kc) = w;
}
DEV void phase_convert(CP& p, int l, int grp, int bid, int nblk, float* tile, int lo = 0, int hi = -1) {
    const int tid = tid_(), total = hi >= 0 ? hi : (grp == 0 ? CONV_A : CONV_B);
    bid += lo;
    if (bid >= total) return;
    f32x4 v0[2], v1[2], v2[2];
    { const ConvDesc d = conv_desc(p, l, grp, bid); conv_load(d, tid, v0); }
    if (bid + nblk < total) { const ConvDesc d = conv_desc(p, l, grp, bid + nblk); conv_load(d, tid, v1); }
    if (bid + 2 * nblk < total) { const ConvDesc d = conv_desc(p, l, grp, bid + 2 * nblk); conv_load(d, tid, v2); }
    for (int it = bid; it < total; it += nblk) {
#pragma unroll
        for (int i = 0; i < 2; ++i) {
            const int idx = tid + i * 512, kk = idx >> 4, n4 = (idx & 15) * 4;
#pragma unroll
            for (int j = 0; j < 4; ++j) tile[kk * 65 + n4 + j] = v0[i][j];
        }
        __syncthreads();
        v0[0] = v1[0]; v0[1] = v1[1]; v1[0] = v2[0]; v1[1] = v2[1];
        if (it + 3 * nblk < total) { const ConvDesc d = conv_desc(p, l, grp, it + 3 * nblk); conv_load(d, tid, v2); }
        { const ConvDesc dc = conv_desc(p, l, grp, it); conv_tile_store(dc, tid, tile); }
        __syncthreads();
    }
}

enum { EPI_SWIGLU = 0, EPI_RESID = 1, EPI_P = 2 };

DEV void epi_swiglu(CP& p, int row, int colh, f32x4 g, f32x4 u, float rs) {
    float o[4];
#pragma unroll
    for (int e = 0; e < 4; ++e) { const float gg = g[e] * rs, uu = u[e] * rs; o[e] = gg * sigm(gg) * uu; }
    u32x2 w; w.x = pack2(o[0], o[1]); w.y = pack2(o[2], o[3]);
    *(u32x2*)(p.big + (size_t)row * DFF + colh) = w;
}
DEV float epi_resid(CP& p, int row, int col, f32x4 a, float scale) {
    float* hp = p.h + (size_t)row * DM + col;
    f32x4 hv = *(const f32x4*)hp;
    hv += a * scale;
    *(f32x4*)hp = hv;
    u32x2 w; w.x = pack2(hv[0], hv[1]); w.y = pack2(hv[2], hv[3]);
    *(u32x2*)(p.hb + (size_t)row * DM + col) = w;
    return hv[0] * hv[0] + hv[1] * hv[1] + hv[2] * hv[2] + hv[3] * hv[3];
}
DEV void epi_p(CP& p, int row, int col, f32x4 a, float rs) {
    a *= rs;
    u32x2 w; w.x = pack2(a[0], a[1]); w.y = pack2(a[2], a[3]);
    *(u32x2*)(p.big + (size_t)row * DIN + col) = w;
    if (col >= C_V && row < MTOK) {
        const int hh = (col - C_V) >> 6, d = (col - C_V) & 63;
        int b, pos;
        if (row < MMAIN) { b = row >> 11; pos = (row & 2047) + NMETA; } else { b = (row - MMAIN) >> 4; pos = (row - MMAIN) & 15; }
        bf16_t* vp = p.vt + ((size_t)((b * 6 + hh) * 64 + d)) * LPV + pos;
#pragma unroll
        for (int e = 0; e < 4; ++e) vp[(size_t)e * LPV] = f2bf(a[e]);
    }
}

template <int EPI>
DEV void gemm_meta(CP& p, const bf16_t* __restrict__ A, const bf16_t* __restrict__ Bt, int N, int K, float scale, int bid, int nblk, float* lds) {
    const int tid = tid_(), lane = tid & 63, wave = tid >> 6, fr = lane & 15, fq = lane >> 4;
    const int nt = N / 64, total = 4 * nt, kw = K / 8;
    float* red = lds + 8 * 8 * 64 * 4;
    for (int u = bid; u < total; u += nblk) {
        const int mu = u / nt, nu = u % nt, row0 = MMAIN + mu * 32;
        const int cb = (EPI == EPI_SWIGLU) ? ((nu >> 2) * 256 + (nu & 3) * 32) : nu * 64;
        f32x4 acc[2][4];
#pragma unroll
        for (int i = 0; i < 2; ++i)
#pragma unroll
            for (int j = 0; j < 4; ++j) acc[i][j] = (f32x4){0.f, 0.f, 0.f, 0.f};
        const bf16_t* ap = A + (size_t)(row0 + fr) * K + wave * kw + fq * 8;
        const bf16_t* bp = Bt + (size_t)(cb + fr) * K + wave * kw + fq * 8;
        for (int k0 = 0; k0 < kw; k0 += 32) {
            const bf16x8 a0 = *(const bf16x8*)(ap + k0), a1 = *(const bf16x8*)(ap + (size_t)16 * K + k0);
#pragma unroll
            for (int j = 0; j < 4; ++j) {
                const int co = (EPI == EPI_SWIGLU) ? ((j & 1) * 16 + (j >> 1) * 128) : j * 16;
                const bf16x8 bv = *(const bf16x8*)(bp + (size_t)co * K + k0);
                acc[0][j] = __builtin_amdgcn_mfma_f32_16x16x32_bf16(bv, a0, acc[0][j], 0, 0, 0);
                acc[1][j] = __builtin_amdgcn_mfma_f32_16x16x32_bf16(bv, a1, acc[1][j], 0, 0, 0);
            }
        }
#pragma unroll
        for (int i = 0; i < 2; ++i)
#pragma unroll
            for (int j = 0; j < 4; ++j) *(f32x4*)(lds + ((wave * 8 + i * 4 + j) * 64 + lane) * 4) = acc[i][j];
        __syncthreads();
        {
            f32x4 sum = (f32x4){0.f, 0.f, 0.f, 0.f};
#pragma unroll
            for (int w = 0; w < 8; ++w) sum += *(const f32x4*)(lds + ((w * 8 + wave) * 64 + lane) * 4);
            *(f32x4*)(red + (wave * 64 + lane) * 4) = sum;
        }
        __syncthreads();
        if (wave < 2) {
            const int i = wave, row = row0 + 16 * i + fr;
            f32x4 a[4];
#pragma unroll
            for (int j = 0; j < 4; ++j) a[j] = *(const f32x4*)(red + ((i * 4 + j) * 64 + lane) * 4);
            if (EPI == EPI_SWIGLU) {
                const float rs = row_rstd(p.part, row);
                const int colh = (nu >> 2) * 128 + (nu & 3) * 32 + 4 * fq;
                epi_swiglu(p, row, colh, a[0], a[2], rs);
                epi_swiglu(p, row, colh + 16, a[1], a[3], rs);
            } else if (EPI == EPI_RESID) {
                float ss = 0.f;
#pragma unroll
                for (int j = 0; j < 4; ++j) ss += epi_resid(p, row, cb + 16 * j + 4 * fq, a[j], scale);
                ss += __shfl_xor(ss, 16); ss += __shfl_xor(ss, 32);
                if (fq == 0) p.part[(size_t)row * 16 + nu] = ss;
            } else {
                const float rs = row_rstd(p.part, row);
#pragma unroll
                for (int j = 0; j < 4; ++j) epi_p(p, row, cb + 16 * j + 4 * fq, a[j], rs);
            }
        }
        __syncthreads();
    }
}

namespace pg8 {
#define PG8_LAS __attribute__((address_space(3)))
typedef unsigned short bf16_t;
typedef short bf16x8 __attribute__((ext_vector_type(8)));
typedef float f32x4 __attribute__((ext_vector_type(4)));
typedef unsigned u32x4 __attribute__((ext_vector_type(4)));
constexpr int BM = 256, BK = 64, HALF = 128, HTB = HALF * BK * 2  , STAGE_BYTES = 8 * HTB, NXCD = 8, WGM = 8;

__host__ __device__ __forceinline__ int lds_byte(int r, int c) { const int st = (r >> 4) * 2 + (c >> 5), rr = r & 15, cc = c & 31, ob = rr * 64 + cc * 2; return st * 1024 + (ob ^ (((ob >> 9) & 1) << 5)); }
__host__ __device__ __forceinline__ void stage_rc(int b, int& R, int& C) { const int st = b / 1024, sb = b % 1024, swz = sb ^ (((sb >> 9) & 1) << 5); R = (st >> 1) * 16 + swz / 64; C = (st & 1) * 32 + (swz % 64) / 2; }
__host__ __device__ __forceinline__ int perm32(int rho) { const int n = rho >> 4, i = rho & 15; return 8 * (i >> 2) + 4 * n + (i & 3); }

struct Unit { int pm, pn; };
struct Gemm { const bf16_t* A; const bf16_t* Bt; int M, N, K; };

struct StaticOrder {
    int nM, nN, nwg, G, c;
    __host__ __device__ void init(int M, int N, int G_, int c_) { nM = M / BM; nN = N / BM; nwg = nM * nN; G = G_; c = c_; }
    __host__ __device__ bool next(int i, Unit& u) const {
        const long L = (long)i * G + c; if (L >= nwg) return false;
        int wgid = (int)L; { const int q = nwg / NXCD, r = nwg % NXCD, xcd = wgid % NXCD, off = wgid / NXCD; wgid = (xcd < r ? xcd * (q + 1) : r * (q + 1) + (xcd - r) * q) + off; }
        const int nig = WGM * nN, gid = wgid / nig, fm = gid * WGM, gsz = (nM - fm) < WGM ? (nM - fm) : WGM;
        u.pm = fm + ((wgid % nig) % gsz); u.pn = (wgid % nig) / gsz; return true;
    }
    __device__ __forceinline__ void a_ready(const Unit&) const {}
    __device__ __forceinline__ void done(const Unit&) const {}
};
__device__ __forceinline__ unsigned cvt_pk_bf16(float lo, float hi) { unsigned r; asm volatile("v_cvt_pk_bf16_f32 %0, %1, %2" : "=v"(r) : "v"(lo), "v"(hi)); return r; }
template <class Epi, class Sched, bool STAMP = false>
__device__ __forceinline__ void gemm_phase(PG8_LAS unsigned char* lds, const Gemm g, const Sched& S, const Epi& E, unsigned long long* stamps) {
    const int tid = tid_(), wid = __builtin_amdgcn_readfirstlane(tid >> 6), lane = tid & 63, wr = wid >> 2, wc = wid & 3, fr = lane & 15, fq = lane >> 4;
    const int K = g.K, nt = K / BK;
    int ts_lo = 0, ts_hi = 0, nts = 0; const unsigned long long rt_entry = STAMP ? (unsigned long long)wall_clock64() : 0ull;
#define PG8_STAMP() do { if (STAMP && wid == 0 && nts < 64) { const unsigned long long _c = (unsigned long long)clock64(); \
        ts_lo = (lane == nts) ? (int)(unsigned)_c : ts_lo; ts_hi = (lane == nts) ? (int)(unsigned)(_c >> 32) : ts_hi; ++nts; } } while (0)
    PG8_STAMP();
    unsigned voffA[2], voffB[2];
#pragma unroll
    for (int i = 0; i < 2; ++i) { int R, C; stage_rc(tid * 16 + i * 8192, R, C); const int Rb = Epi::PERM ? ((R & ~31) + perm32(R & 31)) : R;
        voffA[i] = (unsigned)(R * K + C) * 2u; voffB[i] = (unsigned)(Rb * K + C) * 2u; }
    const size_t kstep = (size_t)(BK * 2);
    const size_t hstep = (size_t)HALF * K * 2;
    const size_t tstep = 2 * hstep;
    const unsigned ldsw = (unsigned)wid * 1024u;
    const int aoff = lds_byte(wr * 64 + fr, fq * 8), boff = lds_byte(wc * 32 + fr, fq * 8);
#define PG8_SA(b, h) (((b) * 2 + (h)) * HTB)
#define PG8_SB(b, h) ((4 + (b) * 2 + (h)) * HTB)
#define PG8_STAGE(bufoff, gbase, voff) do { _Pragma("unroll") for (int _i = 0; _i < 2; ++_i) \
        __builtin_amdgcn_global_load_lds((const unsigned*)((const char*)(gbase) + (voff)[_i]), (PG8_LAS unsigned*)(lds + (bufoff) + ldsw + _i * 8192), 16, 0, 0); } while (0)
#define PG8_LDA(dst, b, h) do { _Pragma("unroll") for (int m = 0; m < 4; ++m) _Pragma("unroll") for (int k = 0; k < 2; ++k) dst[m][k] = *(const PG8_LAS bf16x8*)(lds + PG8_SA(b, h) + aoff + m * 2048 + k * 1024); } while (0)
#define PG8_LDB(dst, b, h) do { _Pragma("unroll") for (int n = 0; n < 2; ++n) _Pragma("unroll") for (int k = 0; k < 2; ++k) dst[n][k] = *(const PG8_LAS bf16x8*)(lds + PG8_SB(b, h) + boff + n * 2048 + k * 1024); } while (0)
#define PG8_MMA(ai, bj, At, Bt) do { __builtin_amdgcn_s_setprio(1); _Pragma("unroll") for (int m = 0; m < 4; ++m) _Pragma("unroll") for (int n = 0; n < 2; ++n) _Pragma("unroll") for (int k = 0; k < 2; ++k) \
        acc[ai][bj][m][n] = __builtin_amdgcn_mfma_f32_16x16x32_bf16(Bt[n][k], At[m][k], acc[ai][bj][m][n], 0, 0, 0); __builtin_amdgcn_s_setprio(0); } while (0)
#define PG8_WAIT_V(n) asm volatile("s_waitcnt vmcnt(" #n ")" ::: "memory")
#define PG8_WAIT_L(n) asm volatile("s_waitcnt lgkmcnt(" #n ")" ::: "memory")
#define PG8_BAR __builtin_amdgcn_s_barrier()
#define PG8_SCHED __builtin_amdgcn_sched_barrier(0)
    Unit cur, nxt; int ui = 0;
    if (!S.next(0, cur)) return;
    f32x4 acc[2][2][4][2];
#pragma unroll
    for (int a = 0; a < 2; ++a)
#pragma unroll
        for (int b = 0; b < 2; ++b)
#pragma unroll
            for (int m = 0; m < 4; ++m)
#pragma unroll
                for (int n = 0; n < 2; ++n) acc[a][b][m][n] = (f32x4){0.f, 0.f, 0.f, 0.f};
    bf16x8 At[4][2], B0[2][2], B1[2][2];
    const char* cA = (const char*)g.A + (size_t)cur.pm * tstep; const char* cB = (const char*)g.Bt + (size_t)cur.pn * tstep;
    S.a_ready(cur);
    PG8_STAGE(PG8_SB(0, 0), cB, voffB); PG8_STAGE(PG8_SA(0, 0), cA, voffA); PG8_STAGE(PG8_SB(0, 1), cB + hstep, voffB); PG8_STAGE(PG8_SA(0, 1), cA + hstep, voffA);
    if (wr == 1) PG8_BAR;
    PG8_WAIT_V(4); PG8_BAR;
    PG8_STAGE(PG8_SB(1, 0), cB + kstep, voffB); PG8_STAGE(PG8_SA(1, 0), cA + kstep, voffA); PG8_STAGE(PG8_SB(1, 1), cB + hstep + kstep, voffB);
    PG8_WAIT_V(6); PG8_BAR;
    PG8_STAMP();
    for (;;) {
        const bool has_next = S.next(ui + 1, nxt);
        const char* nA = has_next ? (const char*)g.A + (size_t)nxt.pm * tstep : cA; const char* nB = has_next ? (const char*)g.Bt + (size_t)nxt.pn * tstep : cB;
        for (int t = 0; t < nt; t += 2) {
            const bool last = (t == nt - 2);
            const char* a1 = cA + (size_t)(t + 1) * kstep;
            const char* a2 = last ? nA : cA + (size_t)(t + 2) * kstep; const char* b2 = last ? nB : cB + (size_t)(t + 2) * kstep;
            const char* a3 = a2 + kstep; const char* b3 = b2 + kstep;
            if (last && has_next) S.a_ready(nxt);
            PG8_LDB(B0, 0, 0); PG8_SCHED; PG8_LDA(At, 0, 0); PG8_STAGE(PG8_SA(1, 1), a1 + hstep, voffA);
            PG8_WAIT_L(8); PG8_BAR; PG8_WAIT_L(0); PG8_MMA(0, 0, At, B0); PG8_BAR; PG8_SCHED;
            PG8_LDB(B1, 0, 1); PG8_STAGE(PG8_SB(0, 0), b2, voffB);
            PG8_BAR; PG8_WAIT_L(0); PG8_MMA(0, 1, At, B1); PG8_BAR;
            PG8_LDA(At, 0, 1); PG8_STAGE(PG8_SA(0, 0), a2, voffA);
            PG8_BAR; PG8_WAIT_L(0); PG8_MMA(1, 0, At, B0); PG8_BAR; PG8_SCHED;
            PG8_STAGE(PG8_SB(0, 1), b2 + hstep, voffB);
            PG8_WAIT_V(6); PG8_BAR; PG8_MMA(1, 1, At, B1); PG8_BAR;
            PG8_LDB(B0, 1, 0); PG8_SCHED; PG8_LDA(At, 1, 0); PG8_STAGE(PG8_SA(0, 1), a2 + hstep, voffA);
            PG8_WAIT_L(8); PG8_BAR; PG8_WAIT_L(0); PG8_MMA(0, 0, At, B0); PG8_BAR; PG8_SCHED;
            PG8_LDB(B1, 1, 1); PG8_STAGE(PG8_SB(1, 0), b3, voffB);
            PG8_BAR; PG8_WAIT_L(0); PG8_MMA(0, 1, At, B1); PG8_BAR;
            PG8_LDA(At, 1, 1); PG8_STAGE(PG8_SA(1, 0), a3, voffA);
            PG8_BAR; PG8_WAIT_L(0); PG8_MMA(1, 0, At, B0); PG8_BAR; PG8_SCHED;
            PG8_STAGE(PG8_SB(1, 1), b3 + hstep, voffB);
            PG8_WAIT_V(6); PG8_BAR; PG8_MMA(1, 1, At, B1); PG8_BAR;
        }
        PG8_STAMP();
        if constexpr (!Epi::AFTER_DRAIN) { E(acc, cur, wr, wc, fr, fq); S.done(cur); }
        PG8_STAMP();
        if (!has_next) break;
#pragma unroll
        for (int a = 0; a < 2; ++a)
#pragma unroll
            for (int b = 0; b < 2; ++b)
#pragma unroll
                for (int m = 0; m < 4; ++m)
#pragma unroll
                    for (int n = 0; n < 2; ++n) acc[a][b][m][n] = (f32x4){0.f, 0.f, 0.f, 0.f};
        cur = nxt; cA = nA; cB = nB; ++ui;
    }
    PG8_WAIT_V(0);
    if (wr == 0) PG8_BAR;
    PG8_BAR;
    if constexpr (Epi::AFTER_DRAIN) { E.fused(acc, cur, wr, wc, fr, fq, lds, wid, lane); S.done(cur); }
    PG8_STAMP();
    if (STAMP && wid == 0) { stamps[lane] = lane < nts ? (((unsigned long long)(unsigned)ts_hi << 32) | (unsigned)ts_lo) : 0ull;
        if (lane == 62) stamps[62] = rt_entry; if (lane == 63) stamps[63] = (unsigned long long)wall_clock64(); }
#undef PG8_STAMP
#undef PG8_SA
#undef PG8_SB
#undef PG8_STAGE
#undef PG8_LDA
#undef PG8_LDB
#undef PG8_MMA
#undef PG8_WAIT_V
#undef PG8_WAIT_L
#undef PG8_BAR
#undef PG8_SCHED
}
}

DEV float fsig(float x) { return __builtin_amdgcn_rcpf(1.f + __expf(-x)); }
DEV u32x4 pack8(f32x4 a, f32x4 b) { u32x4 w; w.x = pg8::cvt_pk_bf16(a[0], a[1]); w.y = pg8::cvt_pk_bf16(a[2], a[3]); w.z = pg8::cvt_pk_bf16(b[0], b[1]); w.w = pg8::cvt_pk_bf16(b[2], b[3]); return w; }

DEV float row_rstd_q(const float* part, int row, int fq) {
    const f32x4 a = *(const f32x4*)(part + (size_t)row * 16 + fq * 4);
    float ss = (a[0] + a[1]) + (a[2] + a[3]);
    ss += __shfl_xor(ss, 16); ss += __shfl_xor(ss, 32);
    return rsqrtf(ss * (1.0f / 1024.0f) + 1e-6f);
}
struct EpiSwiglu {
    static constexpr bool PERM = true, AFTER_DRAIN = false;
    bf16_t* hid; const float* part;
    __device__ __forceinline__ void operator()(const f32x4 (&acc)[2][2][4][2], const pg8::Unit& u, int wr, int wc, int fr, int fq) const {
        float rsv[2][4];
#pragma unroll
        for (int ai = 0; ai < 2; ++ai)
#pragma unroll
            for (int m = 0; m < 4; ++m) rsv[ai][m] = row_rstd_q(part, u.pm * 256 + ai * 128 + wr * 64 + m * 16 + fr, fq);
#pragma unroll
        for (int ai = 0; ai < 2; ++ai)
#pragma unroll
            for (int m = 0; m < 4; ++m) {
                __builtin_amdgcn_sched_barrier(0);
                const int row = u.pm * 256 + ai * 128 + wr * 64 + m * 16 + fr;
                const float rs = rsv[ai][m];
                f32x4 o[2];
#pragma unroll
                for (int n = 0; n < 2; ++n)
#pragma unroll
                    for (int e = 0; e < 4; ++e) { const float g = acc[ai][0][m][n][e] * rs, up = acc[ai][1][m][n][e] * rs; o[n][e] = g * fsig(g) * up; }
                *(u32x4*)(hid + (size_t)row * DFF + u.pn * 128 + wc * 32 + fq * 8) = pack8(o[0], o[1]);
            }
    }
};
struct EpiResid {
    static constexpr bool PERM = true, AFTER_DRAIN = false;
    float* h; bf16_t* hb; float* part; float scale;
    __device__ __forceinline__ void operator()(const f32x4 (&acc)[2][2][4][2], const pg8::Unit& u, int wr, int wc, int fr, int fq) const {
#pragma unroll
        for (int ai = 0; ai < 2; ++ai) {
            __builtin_amdgcn_sched_barrier(0);
            f32x4 hv[4][2][2];
#pragma unroll
            for (int m = 0; m < 4; ++m)
#pragma unroll
                for (int bj = 0; bj < 2; ++bj) {
                    const float* hp = h + (size_t)(u.pm * 256 + ai * 128 + wr * 64 + m * 16 + fr) * DM + u.pn * 256 + bj * 128 + wc * 32 + fq * 8;
                    hv[m][bj][0] = *(const f32x4*)hp; hv[m][bj][1] = *(const f32x4*)(hp + 4);
                }
#pragma unroll
            for (int m = 0; m < 4; ++m) {
                const int row = u.pm * 256 + ai * 128 + wr * 64 + m * 16 + fr;
                float ss = 0.f;
#pragma unroll
                for (int bj = 0; bj < 2; ++bj) {
                    const int col = u.pn * 256 + bj * 128 + wc * 32 + fq * 8;
                    float* hp = h + (size_t)row * DM + col;
                    const f32x4 h0 = hv[m][bj][0] + acc[ai][bj][m][0] * scale, h1 = hv[m][bj][1] + acc[ai][bj][m][1] * scale;
                    *(f32x4*)hp = h0; *(f32x4*)(hp + 4) = h1;
                    *(u32x4*)(hb + (size_t)row * DM + col) = pack8(h0, h1);
                    ss += (h0[0] * h0[0] + h0[1] * h0[1]) + (h0[2] * h0[2] + h0[3] * h0[3]) + (h1[0] * h1[0] + h1[1] * h1[1]) + (h1[2] * h1[2] + h1[3] * h1[3]);
                }
                ss += __shfl_xor(ss, 16); ss += __shfl_xor(ss, 32);
                if (fq == 0) part[(size_t)row * 16 + u.pn * 4 + wc] = ss;
            }
        }
    }
};
struct EpiP {
    static constexpr bool PERM = true, AFTER_DRAIN = false;
    bf16_t* big; bf16_t* vt; const float* part;
    __device__ __forceinline__ void operator()(const f32x4 (&acc)[2][2][4][2], const pg8::Unit& u, int wr, int wc, int fr, int fq) const {
        float rsv[2][4];
#pragma unroll
        for (int ai = 0; ai < 2; ++ai)
#pragma unroll
            for (int m = 0; m < 4; ++m) rsv[ai][m] = row_rstd_q(part, u.pm * 256 + ai * 128 + wr * 64 + m * 16 + fr, fq);
#pragma unroll
        for (int ai = 0; ai < 2; ++ai)
#pragma unroll
            for (int m = 0; m < 4; ++m) {
                __builtin_amdgcn_sched_barrier(0);
                const int row = u.pm * 256 + ai * 128 + wr * 64 + m * 16 + fr;
                const float rs = rsv[ai][m];
#pragma unroll
                for (int bj = 0; bj < 2; ++bj) {
                    const int col = u.pn * 256 + bj * 128 + wc * 32 + fq * 8;
                    const f32x4 a0 = acc[ai][bj][m][0] * rs, a1 = acc[ai][bj][m][1] * rs;
                    const u32x4 w = pack8(a0, a1);
                    *(u32x4*)(big + (size_t)row * DIN + col) = w;
                    if (col >= C_V && row < MTOK) {
                        const int hh = (col - C_V) >> 6, d = (col - C_V) & 63;
                        int b, pos;
                        if (row < MMAIN) { b = row >> 11; pos = (row & 2047) + NMETA; } else { b = (row - MMAIN) >> 4; pos = (row - MMAIN) & 15; }
                        bf16_t* vp = vt + ((size_t)((b * 6 + hh) * 64 + d)) * LPV + pos;
#pragma unroll
                        for (int e = 0; e < 4; ++e) { vp[(size_t)(2 * e) * LPV] = (bf16_t)(w[e] & 0xFFFFu); vp[(size_t)(2 * e + 1) * LPV] = (bf16_t)(w[e] >> 16); }
                    }
                }
            }
    }
};
template <class Epi>
DEV void gemm_big(const bf16_t* A, const bf16_t* Bt, int M, int N, int K, const Epi& E, int bid, int nblk, unsigned char* smem) {
    pg8::StaticOrder S; S.init(M, N, nblk, bid);
    const pg8::Gemm g{A, Bt, M, N, K};
    pg8::gemm_phase<Epi, pg8::StaticOrder, false>((PG8_LAS unsigned char*)smem, g, S, E, nullptr);
}

DEV void phase_conv(CP& p, int l, int bid, int nblk, float* lds) {
    float* cS = lds;
    float* yS = lds + 46 * 256;
    const int tid = tid_(), ch = tid & 255, half = tid >> 8, lane = tid & 63, wave = tid >> 6;
    float wreg[31];
#pragma unroll
    for (int j = 0; j < 31; ++j) wreg[j] = p.conv_w[(size_t)l * 31 * 256 + j * 256 + ch];
    const float cb = p.conv_b[l * 256 + ch];
    for (int it = bid; it < NB * 129; it += nblk) {
        const int b = it / 129, p0 = (it % 129) * 16;
        __syncthreads();
#pragma unroll
        for (int q = 0; q < 3; ++q) {
            const int e = tid + q * 512;
            if (e < 46 * 32) {
                const int pp = e >> 5, c8 = (e & 31) * 8, pos = p0 - 30 + pp;
                f32x4 o0 = (f32x4){0.f, 0.f, 0.f, 0.f}, o1 = o0;
                if (pos >= 0) {
                    const bf16_t* rp = p.big + (size_t)row_of(b, pos) * DIN + c8;
                    const u32x4 vw = *(const u32x4*)rp, gw = *(const u32x4*)(rp + 256);
#pragma unroll
                    for (int j = 0; j < 2; ++j) {
                        o0[2 * j] = __uint_as_float(vw[j] << 16) * fsig(__uint_as_float(gw[j] << 16));
                        o0[2 * j + 1] = __uint_as_float(vw[j] & 0xFFFF0000u) * fsig(__uint_as_float(gw[j] & 0xFFFF0000u));
                        o1[2 * j] = __uint_as_float(vw[2 + j] << 16) * fsig(__uint_as_float(gw[2 + j] << 16));
                        o1[2 * j + 1] = __uint_as_float(vw[2 + j] & 0xFFFF0000u) * fsig(__uint_as_float(gw[2 + j] & 0xFFFF0000u));
                    }
                }
                *(f32x4*)(cS + pp * 256 + c8) = o0; *(f32x4*)(cS + pp * 256 + c8 + 4) = o1;
            }
        }
        __syncthreads();
#pragma unroll
        for (int i = 0; i < 8; ++i) {
            const int ii = half * 8 + i;
            float acc = cb;
#pragma unroll
            for (int j = 0; j < 31; ++j) acc += wreg[j] * cS[(ii + j) * 256 + ch];
            yS[ii * 256 + ch] = acc;
        }
        __syncthreads();
#pragma unroll
        for (int q = 0; q < 2; ++q) {
            const int ii = wave * 2 + q;
            const f32x4 v = *(const f32x4*)(yS + ii * 256 + lane * 4);
            const float mu = wave_sum_fast((v[0] + v[1]) + (v[2] + v[3])) * (1.f / 256.f);
            const f32x4 d = v - mu;
            const float var = wave_sum_fast(d[0] * d[0] + d[1] * d[1] + d[2] * d[2] + d[3] * d[3]) * (1.f / 256.f);
            const float rs = rsqrtf(var + 1e-5f);
            const f32x4 g = *(const f32x4*)(p.conv_ln_g + l * 256 + lane * 4), bb = *(const f32x4*)(p.conv_ln_b + l * 256 + lane * 4);
            float o[4];
#pragma unroll
            for (int e = 0; e < 4; ++e) { const float yn = d[e] * rs * g[e] + bb[e]; o[e] = yn * sigm(yn); }
            u32x2 w; w.x = pack2(o[0], o[1]); w.y = pack2(o[2], o[3]);
            *(u32x2*)(p.y + (size_t)row_of(b, p0 + ii) * DM + lane * 4) = w;
        }
    }
}

constexpr int PK_AN = 0, PK_RM = 3072, PK_TT = 6144, PK_KB = 7168, PK_VT = 11264, PK_GT = 13312, PK_GC = 15360, PK_CT = 15616, PK_BYTES = 15680;
DEV u32x4 pack8f(const float* x) { u32x4 w; w.x = cvt2(x[0], x[1]); w.y = cvt2(x[2], x[3]); w.z = cvt2(x[4], x[5]); w.w = cvt2(x[6], x[7]); return w; }
DEV void rwkv_pack_item(CP& p, int l, int r0, int hh, unsigned char* scr) {
    const int lane = tid_() & 63, fr = lane & 15, fq = lane >> 4, hc = hh * 64 + lane;
    int b, pos0;
    if (r0 < MMAIN) { b = r0 >> 11; pos0 = (r0 & 2047) + NMETA; } else { b = (r0 - MMAIN) >> 4; pos0 = 0; }
    unsigned char* pk = p.pack + (size_t)((b * 6 + hh) * 129 + (pos0 >> 4)) * PK_BYTES;
    bf16_t* sA = (bf16_t*)scr; bf16_t* sR = sA + 16 * 72; bf16_t* sB = sR + 16 * 72; bf16_t* sK = sB + 16 * 72;
    float* sN = (float*)(scr + 4 * 2304);
    const float* mu = p.rwkv_mu + (size_t)l * 1408;
    const float mr = mu[hc], mk = mu[384 + hc], mv = mu[768 + hc];
    const float kkw = p.rwkv_kk[l * DRW + hc], kaw = p.rwkv_ka[l * DRW + hc];
    float pr = 0.f, pkk = 0.f, pv = 0.f;
    if (pos0 > 0) { const bf16_t* q = p.big + (size_t)row_of(b, pos0 - 1) * DIN + C_RW + hc; pr = bf2f(q[0]); pkk = bf2f(q[384]); pv = bf2f(q[768]); }
    float bt[16], kt[16], vv[16], gv[16];
    float lg = 0.f;
#pragma unroll
    for (int hf = 0; hf < 2; ++hf) {
        unsigned short r0w[8], k0w[8], v0w[8], gw[8]; float lww[8], inw[8], aaw[8];
#pragma unroll
        for (int u = 0; u < 8; ++u) {
            const int row = r0 + hf * 8 + u;
            const bf16_t* q = p.big + (size_t)row * DIN + C_RW + hc;
            r0w[u] = q[0]; k0w[u] = q[384]; v0w[u] = q[768];
            lww[u] = p.lw[(size_t)row * DRW + hc]; gw[u] = p.gg16[(size_t)row * DRW + hc]; inw[u] = p.inorm[(size_t)row * 8 + hh]; aaw[u] = p.aa[(size_t)row * DRW + hc];
        }
#pragma unroll
        for (int u = 0; u < 8; ++u) {
            const int t = hf * 8 + u;
            const float r0v = bf2f(r0w[u]), k0v = bf2f(k0w[u]), v0v = bf2f(v0w[u]);
            const float r = r0v + mr * (pr - r0v), k = k0v + mk * (pkk - k0v), v = v0v + mv * (pv - v0v);
            pr = r0v; pkk = k0v; pv = v0v;
            const float a = aaw[u], lwv = lww[u];
            const float kk = k * kkw * inw[u];
            const float kp = k * (1.f + (a - 1.f) * kaw);
            const float gprev = __expf(lg);
            lg += lwv;
            const float gcur = __expf(lg), ginv = __expf(-lg);
            const float at = -kk * gprev, rt = r * gcur;
            bt[t] = kk * a * ginv; kt[t] = kp * ginv; vv[t] = v; gv[t] = bf2f(gw[u]);
            const bf16_t ab = f2bf(at), rb = f2bf(rt);
            ((bf16_t*)(pk + PK_AN))[t * 96 + lane] = ab; ((bf16_t*)(pk + PK_RM))[t * 96 + lane] = rb;
            sA[t * 72 + lane] = ab; sR[t * 72 + lane] = rb; sB[t * 72 + lane] = f2bf(bt[t]); sK[t * 72 + lane] = f2bf(kt[t]);
        }
    }
    ((float*)(pk + PK_GC))[lane] = __expf(lg);
    if (lane < 16) ((float*)(pk + PK_CT))[lane] = p.ct[(size_t)(r0 + lane) * 8 + hh];
    { u32x4* d = (u32x4*)(pk + PK_KB + lane * 64); d[0] = pack8f(kt); d[1] = pack8f(kt + 8); d[2] = pack8f(bt); d[3] = pack8f(bt + 8); }
    { u32x4* d = (u32x4*)(pk + PK_VT + lane * 32); d[0] = pack8f(vv); d[1] = pack8f(vv + 8); }
    { u32x4* d = (u32x4*)(pk + PK_GT + lane * 32); d[0] = pack8f(gv); d[1] = pack8f(gv + 8); }
    f32x4 nab = (f32x4){0.f, 0.f, 0.f, 0.f}, nak = nab, mrb = nab, mrk = nab;
#pragma unroll
    for (int ks = 0; ks < 2; ++ks) {
        const bf16x8 fb = *(const bf16x8*)(sB + fr * 72 + ks * 32 + fq * 8), fk = *(const bf16x8*)(sK + fr * 72 + ks * 32 + fq * 8);
        const bf16x8 fa = *(const bf16x8*)(sA + fr * 72 + ks * 32 + fq * 8), fc = *(const bf16x8*)(sR + fr * 72 + ks * 32 + fq * 8);
        nab = __builtin_amdgcn_mfma_f32_16x16x32_bf16(fb, fa, nab, 0, 0, 0);
        nak = __builtin_amdgcn_mfma_f32_16x16x32_bf16(fk, fa, nak, 0, 0, 0);
        mrb = __builtin_amdgcn_mfma_f32_16x16x32_bf16(fb, fc, mrb, 0, 0, 0);
        mrk = __builtin_amdgcn_mfma_f32_16x16x32_bf16(fk, fc, mrk, 0, 0, 0);
    }
#pragma unroll
    for (int i = 0; i < 4; ++i) {
        const int j = 4 * fq + i;
        if (!(j < fr)) { nab[i] = 0.f; nak[i] = 0.f; }
        if (!(j <= fr)) { mrb[i] = 0.f; mrk[i] = 0.f; }
        sN[j * 16 + fr] = nab[i];
    }
    { u32x2 w; w.x = cvt2(nak[0], nak[1]); w.y = cvt2(nak[2], nak[3]); *(u32x2*)(pk + PK_AN + fr * 192 + (64 + 4 * fq) * 2) = w; *(u32x2*)(pk + PK_AN + fr * 192 + (80 + 4 * fq) * 2) = (u32x2){0u, 0u}; }
    { u32x2 w; w.x = cvt2(mrk[0], mrk[1]); w.y = cvt2(mrk[2], mrk[3]); *(u32x2*)(pk + PK_RM + fr * 192 + (64 + 4 * fq) * 2) = w; }
    { u32x2 w; w.x = cvt2(mrb[0], mrb[1]); w.y = cvt2(mrb[2], mrb[3]); *(u32x2*)(pk + PK_RM + fr * 192 + (80 + 4 * fq) * 2) = w; }
    {
        const int c = lane & 15;
        float x[16];
#pragma unroll
        for (int j = 0; j < 16; ++j) x[j] = (j == c) ? 1.f : 0.f;
#pragma unroll
        for (int j = 14; j >= 0; --j) {
            float acc = 0.f;
#pragma unroll
            for (int t = j + 1; t < 16; ++t) acc += sN[j * 16 + t] * x[t];
            x[j] = (j < c) ? acc : x[j];
        }
        if (lane < 16) { u32x4* d = (u32x4*)(pk + PK_TT + c * 64); d[0] = pack8f(x); d[1] = pack8f(x + 8); d[2] = (u32x4){0u, 0u, 0u, 0u}; d[3] = (u32x4){0u, 0u, 0u, 0u}; }
    }
}

DEV void phase_rwkv_prep(CP& p, int l, int bid, int nblk, float* lds) {
    bf16_t* X = (bf16_t*)lds;
    constexpr int XS = 264;
    const int tid = tid_(), lane = tid & 63, wave = tid >> 6, fr = lane & 15, fq = lane >> 4;
    const float* mu = p.rwkv_mu + (size_t)l * 1408;
    for (int it = bid; it < MTOK / 64; it += nblk) {
        __syncthreads();
        {
            const int rr = tid >> 3, c0 = (tid & 7) * 32, row = it * 64 + rr;
            int b, pos;
            if (row < MMAIN) { b = row >> 11; pos = (row & 2047) + NMETA; } else { b = (row - MMAIN) >> 4; pos = (row - MMAIN) & 15; }
            const bf16_t* cp = p.big + (size_t)row * DIN + C_RW + 1152 + c0;
            const bf16_t* pp = p.big + (size_t)row_of(b, pos > 0 ? pos - 1 : 0) * DIN + C_RW + 1152 + c0;
#pragma unroll
            for (int q = 0; q < 4; ++q) {
                const u32x4 cw = *(const u32x4*)(cp + q * 8);
                u32x4 pw = *(const u32x4*)(pp + q * 8);
                if (pos == 0) pw = (u32x4){0u, 0u, 0u, 0u};
                const int c = c0 + q * 8;
                const f32x4 m0 = *(const f32x4*)(mu + 1152 + c), m1 = *(const f32x4*)(mu + 1152 + c + 4);
                float xs[8];
#pragma unroll
                for (int j = 0; j < 4; ++j) {
                    const float a0 = __uint_as_float(cw[j] << 16), a1 = __uint_as_float(cw[j] & 0xFFFF0000u);
                    const float q0 = __uint_as_float(pw[j] << 16), q1 = __uint_as_float(pw[j] & 0xFFFF0000u);
                    const float ma = j < 2 ? m0[2 * j] : m1[2 * j - 4], mb = j < 2 ? m0[2 * j + 1] : m1[2 * j - 3];
                    xs[2 * j] = a0 + ma * (q0 - a0); xs[2 * j + 1] = a1 + mb * (q1 - a1);
                }
#pragma unroll
                for (int j = 0; j < 8; ++j) { if (c < 64) xs[j] = tanhf(xs[j]); else if (c >= 128) xs[j] = fsig(xs[j]); }
                u32x4 w; w.x = cvt2(xs[0], xs[1]); w.y = cvt2(xs[2], xs[3]); w.z = cvt2(xs[4], xs[5]); w.w = cvt2(xs[6], xs[7]);
                *(u32x4*)(X + rr * XS + c) = w;
            }
        }
        __syncthreads();
        const int rt = wave & 3, chalf = wave >> 2;
        bf16x8 af[8];
#pragma unroll
        for (int ks = 0; ks < 8; ++ks) af[ks] = *(const bf16x8*)(X + (rt * 16 + fr) * XS + ks * 32 + fq * 8);
        const int row = it * 64 + rt * 16 + fr;
        int prow; bool has_prev;
        {
            int b, pos;
            if (row < MMAIN) { b = row >> 11; pos = (row & 2047) + NMETA; } else { b = (row - MMAIN) >> 4; pos = (row - MMAIN) & 15; }
            has_prev = pos > 0; prow = row_of(b, has_prev ? pos - 1 : 0);
        }
        float ssq = 0.f, ctp = 0.f;
        for (int nt = chalf * 12; nt < chalf * 12 + 12; ++nt) {
            const bf16_t* wb = p.Wl + (size_t)(nt * 16 + fr) * 64 + fq * 8;
            const bf16_t* ab = p.Wl + DRW * 64 + (size_t)(nt * 16 + fr) * 64 + fq * 8;
            const bf16_t* gb = p.Wl + DRW * 128 + (size_t)(nt * 16 + fr) * 128 + fq * 8;
            f32x4 cw = (f32x4){0.f, 0.f, 0.f, 0.f}, ca = cw, cg = cw;
#pragma unroll
            for (int ks = 0; ks < 2; ++ks) {
                cw = __builtin_amdgcn_mfma_f32_16x16x32_bf16(*(const bf16x8*)(wb + ks * 32), af[ks], cw, 0, 0, 0);
                ca = __builtin_amdgcn_mfma_f32_16x16x32_bf16(*(const bf16x8*)(ab + ks * 32), af[2 + ks], ca, 0, 0, 0);
            }
#pragma unroll
            for (int ks = 0; ks < 4; ++ks) cg = __builtin_amdgcn_mfma_f32_16x16x32_bf16(*(const bf16x8*)(gb + ks * 32), af[4 + ks], cg, 0, 0, 0);
            const int col = nt * 16 + 4 * fq;
            const f32x4 w0 = *(const f32x4*)(p.rwkv_w0 + l * DRW + col), a0 = *(const f32x4*)(p.rwkv_a0 + l * DRW + col);
            f32x4 olw, oaa;
#pragma unroll
            for (int j = 0; j < 4; ++j) {
                const float xw = -(w0[j] + cw[j]);
                const float sp = fmaxf(xw, 0.f) + __logf(1.f + __expf(-fabsf(xw)));
                olw[j] = -__expf(-sp - 0.5f);
                oaa[j] = fsig(a0[j] + ca[j]);
            }
            const size_t o = (size_t)row * DRW + col;
            *(f32x4*)(p.lw + o) = olw; *(f32x4*)(p.aa + o) = oaa; { u32x2 gw; gw.x = cvt2(cg[0], cg[1]); gw.y = cvt2(cg[2], cg[3]); *(u32x2*)(p.gg16 + o) = gw; }
            {
                const u32x2 rc = *(const u32x2*)(p.big + (size_t)row * DIN + C_RW + col), kc = *(const u32x2*)(p.big + (size_t)row * DIN + C_RW + 384 + col);
                u32x2 rp = *(const u32x2*)(p.big + (size_t)prow * DIN + C_RW + col), kq = *(const u32x2*)(p.big + (size_t)prow * DIN + C_RW + 384 + col);
                if (!has_prev) { rp = (u32x2){0u, 0u}; kq = (u32x2){0u, 0u}; }
                const f32x4 mr4 = *(const f32x4*)(mu + col), mk4 = *(const f32x4*)(mu + 384 + col);
                const f32x4 kk4 = *(const f32x4*)(p.rwkv_kk + l * DRW + col), ka4 = *(const f32x4*)(p.rwkv_ka + l * DRW + col), rk4 = *(const f32x4*)(p.rwkv_rk + l * DRW + col);
#pragma unroll
                for (int j = 0; j < 4; ++j) {
                    const unsigned rcw = rc[j >> 1], kcw = kc[j >> 1], rpw = rp[j >> 1], kpw = kq[j >> 1];
                    const float r0 = (j & 1) ? __uint_as_float(rcw & 0xFFFF0000u) : __uint_as_float(rcw << 16);
                    const float k0 = (j & 1) ? __uint_as_float(kcw & 0xFFFF0000u) : __uint_as_float(kcw << 16);
                    const float r1 = (j & 1) ? __uint_as_float(rpw & 0xFFFF0000u) : __uint_as_float(rpw << 16);
                    const float k1 = (j & 1) ? __uint_as_float(kpw & 0xFFFF0000u) : __uint_as_float(kpw << 16);
                    const float r = r0 + mr4[j] * (r1 - r0), k = k0 + mk4[j] * (k1 - k0);
                    const float kkr = k * kk4[j];
                    ssq += kkr * kkr;
                    ctp += r * (k * (1.f + (oaa[j] - 1.f) * ka4[j])) * rk4[j];
                }
                if ((nt & 3) == 3) {
                    ssq += __shfl_xor(ssq, 16); ssq += __shfl_xor(ssq, 32);
                    ctp += __shfl_xor(ctp, 16); ctp += __shfl_xor(ctp, 32);
                    if (fq == 0) { p.inorm[(size_t)row * 8 + (nt >> 2)] = __builtin_amdgcn_rsqf(fmaxf(ssq, 1e-24f)); p.ct[(size_t)row * 8 + (nt >> 2)] = ctp; }
                    ssq = 0.f; ctp = 0.f;
                }
            }
        }
    }
}
DEV void phase_rwkv_pack(CP& p, int l, int bid, int nblk, unsigned char* lds) {
    const int wave = tid_() >> 6;
    for (int it = bid * 8 + wave; it < (MTOK / 16) * 6; it += nblk * 8) rwkv_pack_item(p, l, (it / 6) * 16, it % 6, lds + wave * 10240);
}

constexpr int P2_BUF = 4 * PK_BYTES, P2_SUV = 2 * P2_BUF, P2_GB = P2_SUV + 4 * 3328, P2_ST = P2_GB + 4 * 1280;
DEV void phase_rwkv_chunk(CP& p, int l, int item, unsigned char* lds) {
    const int tid = tid_(), lane = tid & 63, wave = tid >> 6, fr = lane & 15, fq = lane >> 4;
    const int b = item / 6, hh = item % 6;
    const unsigned char* gpk = p.pack + (size_t)(item * 129) * PK_BYTES;
    constexpr int NSC = 33;
    if (wave >= 4) {
        const int lt = tid - 256;
        u32x4 ra[16], rb[16];
#define P2_ISSUE(R, SC) { const int nb_ = (((SC) * 4 + 4 <= 129) ? 4 : 1) * (PK_BYTES / 16); const u32x4* src_ = (const u32x4*)(gpk + (size_t)(SC) * P2_BUF); \
        _Pragma("unroll") for (int q = 0; q < 16; ++q) { const int ci = lt + q * 256; if (ci < nb_) R[q] = src_[ci]; } }
#define P2_WRITE(R, SC) { const int nb_ = (((SC) * 4 + 4 <= 129) ? 4 : 1) * (PK_BYTES / 16); u32x4* dst_ = (u32x4*)(lds + ((SC) & 1) * P2_BUF); \
        _Pragma("unroll") for (int q = 0; q < 16; ++q) { const int ci = lt + q * 256; if (ci < nb_) dst_[ci] = R[q]; } }
        P2_ISSUE(ra, 0); P2_ISSUE(rb, 1); P2_WRITE(ra, 0); P2_ISSUE(ra, 2);
        __syncthreads();
        for (int sc = 0; sc < NSC; sc += 2) {
            if (sc + 1 < NSC) { P2_WRITE(rb, sc + 1); if (sc + 3 < NSC) P2_ISSUE(rb, sc + 3); }
            __syncthreads();
            if (sc + 1 < NSC) {
                if (sc + 2 < NSC) { P2_WRITE(ra, sc + 2); if (sc + 4 < NSC) P2_ISSUE(ra, sc + 4); }
                __syncthreads();
            }
        }
#undef P2_ISSUE
#undef P2_WRITE
    } else {
        unsigned char* suv = lds + P2_SUV + wave * 3328;
        unsigned char* gb = lds + P2_GB + wave * 1280;
        float* stats = (float*)(lds + P2_ST);
        for (int i = lane; i < 3328 / 4; i += 64) ((unsigned*)suv)[i] = 0u;
        for (int i = lane; i < 1280 / 4; i += 64) ((unsigned*)gb)[i] = 0u;
        f32x4 ST[4];
#pragma unroll
        for (int mt = 0; mt < 4; ++mt) ST[mt] = (f32x4){0.f, 0.f, 0.f, 0.f};
        const int vrow = wave * 16 + fr;
        const float lng = p.rwkv_ln_g[l * DRW + hh * 64 + vrow], lnb = p.rwkv_ln_b[l * DRW + hh * 64 + vrow];
        f32x4 Osv[4], ctsv[4]; u32x2 vsv[4], gsv[4];
        __syncthreads();
        auto deferred = [&](int ps) {
                const int nch = (ps * 4 + 4 <= 129) ? 4 : 1;
#pragma unroll
                for (int ch = 0; ch < 4; ++ch) if (ch < nch) {
                    const int cidx = ps * 4 + ch;
                    const float* stp = stats + (((ps & 1) * 4 + ch) * 4) * 32;
#pragma unroll
                    for (int i = 0; i < 4; ++i) {
                        const int t = 4 * fq + i;
                        float s1 = 0.f, s2 = 0.f;
#pragma unroll
                        for (int w = 0; w < 4; ++w) { s1 += stp[w * 32 + t * 2]; s2 += stp[w * 32 + t * 2 + 1]; }
                        const float m = s1 * (1.f / 64.f), var = fmaxf(s2 * (1.f / 64.f) - m * m, 0.f);
                        const unsigned vw = vsv[ch][i >> 1], gw = gsv[ch][i >> 1];
                        const float vval = (i & 1) ? __uint_as_float(vw & 0xFFFF0000u) : __uint_as_float(vw << 16);
                        const float gval = (i & 1) ? __uint_as_float(gw & 0xFFFF0000u) : __uint_as_float(gw << 16);
                        float yv = (Osv[ch][i] - m) * rsqrtf(var + 64e-5f) * lng + lnb;
                        yv = (yv + ctsv[ch][i] * vval) * gval;
                        const int row = cidx == 0 ? MMAIN + b * NMETA + t : b * SEQ + cidx * 16 - NMETA + t;
                        p.y[(size_t)row * DM + 256 + hh * 64 + vrow] = f2bf(yv);
                    }
                }
        };
        for (int sc = 0; sc < NSC; ++sc) {
            if (sc > 0) deferred(sc - 1);
            {
                const int nch = (sc * 4 + 4 <= 129) ? 4 : 1;
#pragma unroll
                for (int ch = 0; ch < 4; ++ch) if (ch < nch) {
                    const unsigned char* pk = lds + (sc & 1) * P2_BUF + ch * PK_BYTES;
#pragma unroll
                    for (int mt = 0; mt < 4; ++mt) { u32x2 w; w.x = cvt2(ST[mt][0], ST[mt][1]); w.y = cvt2(ST[mt][2], ST[mt][3]); *(u32x2*)(suv + fr * 208 + (16 * mt + 4 * fq) * 2) = w; }
                    vsv[ch] = *(const u32x2*)(pk + PK_VT + vrow * 32 + 4 * fq * 2);
                    gsv[ch] = *(const u32x2*)(pk + PK_GT + vrow * 32 + 4 * fq * 2);
                    ctsv[ch] = *(const f32x4*)(pk + PK_CT + 4 * fq * 4);
                    *(u32x2*)(suv + fr * 208 + (64 + 4 * fq) * 2) = vsv[ch];
                    bf16x8 bs[3];
                    f32x4 G = (f32x4){0.f, 0.f, 0.f, 0.f};
#pragma unroll
                    for (int ks = 0; ks < 3; ++ks) {
                        bs[ks] = *(const bf16x8*)(suv + fr * 208 + (32 * ks + 8 * fq) * 2);
                        G = __builtin_amdgcn_mfma_f32_16x16x32_bf16(*(const bf16x8*)(pk + PK_AN + fr * 192 + (32 * ks + 8 * fq) * 2), bs[ks], G, 0, 0, 0);
                    }
                    { u32x2 w; w.x = cvt2(G[0], G[1]); w.y = cvt2(G[2], G[3]); *(u32x2*)(gb + fr * 80 + 4 * fq * 2) = w; }
                    f32x4 U = __builtin_amdgcn_mfma_f32_16x16x32_bf16(*(const bf16x8*)(pk + PK_TT + fr * 64 + 8 * fq * 2), *(const bf16x8*)(gb + fr * 80 + 8 * fq * 2), (f32x4){0.f, 0.f, 0.f, 0.f}, 0, 0, 0);
                    { u32x2 w; w.x = cvt2(U[0], U[1]); w.y = cvt2(U[2], U[3]); *(u32x2*)(suv + fr * 208 + (80 + 4 * fq) * 2) = w; }
                    const bf16x8 bvu = *(const bf16x8*)(suv + fr * 208 + (64 + 8 * fq) * 2);
                    f32x4 O = (f32x4){0.f, 0.f, 0.f, 0.f};
                    O = __builtin_amdgcn_mfma_f32_16x16x32_bf16(*(const bf16x8*)(pk + PK_RM + fr * 192 + (8 * fq) * 2), bs[0], O, 0, 0, 0);
                    O = __builtin_amdgcn_mfma_f32_16x16x32_bf16(*(const bf16x8*)(pk + PK_RM + fr * 192 + (32 + 8 * fq) * 2), bs[1], O, 0, 0, 0);
                    O = __builtin_amdgcn_mfma_f32_16x16x32_bf16(*(const bf16x8*)(pk + PK_RM + fr * 192 + (64 + 8 * fq) * 2), bvu, O, 0, 0, 0);
#pragma unroll
                    for (int mt = 0; mt < 4; ++mt) {
                        ST[mt] = __builtin_amdgcn_mfma_f32_16x16x32_bf16(*(const bf16x8*)(pk + PK_KB + (16 * mt + fr) * 64 + 8 * fq * 2), bvu, ST[mt], 0, 0, 0);
                        ST[mt] *= *(const f32x4*)(pk + PK_GC + (16 * mt + 4 * fq) * 4);
                    }
                    Osv[ch] = O;
                    float* stp = stats + (((sc & 1) * 4 + ch) * 4 + wave) * 32;
#pragma unroll
                    for (int i = 0; i < 4; ++i) {
                        const float s1 = dpp_sum16(O[i]), s2 = dpp_sum16(O[i] * O[i]);
                        if (fr == 0) { stp[(4 * fq + i) * 2] = s1; stp[(4 * fq + i) * 2 + 1] = s2; }
                    }
                }
            }
            __syncthreads();
        }
        deferred(NSC - 1);
    }
}

DEV void phase_pack_prefetch(CP& p, int item) {
    const u32x4* src = (const u32x4*)(p.pack + (size_t)(item * 129) * PK_BYTES);
    const int n = 129 * (PK_BYTES / 16), tid = tid_();
    u32x4 acc = (u32x4){0u, 0u, 0u, 0u};
    for (int i = tid; i < n; i += 512 * 4) {
        u32x4 a = src[i], b = (i + 512 < n) ? src[i + 512] : acc, c = (i + 1024 < n) ? src[i + 1024] : acc, d = (i + 1536 < n) ? src[i + 1536] : acc;
        acc ^= a; acc ^= b; acc ^= c; acc ^= d;
    }
    asm volatile("" :: "v"(acc.x), "v"(acc.y), "v"(acc.z), "v"(acc.w));
}
DEV void phase_sb_mfma(CP& p, int l, int bid, int nblk) {
    const int tid = tid_(), lane = tid & 63, wave = tid >> 6, r = lane & 31, h = lane >> 5;
    for (int it = bid * 8 + wave; it < NB * 6 * 65; it += nblk * 8) {
        const int qt = it % 65, bh = it / 65, b = bh / 6, hh = bh % 6;
        const int q0 = qt * 32, t = q0 + r;
        const bool valid = t < LT;
        const int myrow = row_of(b, valid ? t : LT - 1);
        bf16x8 qf[4];
        {
            const bf16_t* qp = p.big + (size_t)myrow * DIN + C_Q + hh * 64 + 8 * h;
#pragma unroll
            for (int ks = 0; ks < 4; ++ks) qf[ks] = *(const bf16x8*)(qp + 16 * ks);
        }
        f32x16 o0, o1;
#pragma unroll
        for (int i = 0; i < 16; ++i) { o0[i] = 0.f; o1[i] = 0.f; }
        float carry = 0.f;
        const bf16_t* vbase = p.vt + (size_t)((b * 6 + hh) * 64 + r) * LPV + 4 * h;
        bf16x8 kf[4];
        {
            const bf16_t* kp = p.big + (size_t)row_of(b, q0 + r) * DIN + C_K + hh * 64 + 8 * h;
#pragma unroll
            for (int ks = 0; ks < 4; ++ks) kf[ks] = *(const bf16x8*)(kp + 16 * ks);
        }
        for (int k0 = q0; k0 >= 0; k0 -= 32) {
            bf16x8 vf[2][2];
#pragma unroll
            for (int db = 0; db < 2; ++db)
#pragma unroll
                for (int s = 0; s < 2; ++s) {
                    const bf16_t* vp = vbase + (size_t)(db * 32) * LPV + k0 + 16 * s;
                    const s16x4 lo = *(const s16x4*)vp, hi = *(const s16x4*)(vp + 8);
                    vf[db][s] = __builtin_shufflevector(lo, hi, 0, 1, 2, 3, 4, 5, 6, 7);
                }
            bf16x8 kn[4];
            {
                const int kpos = k0 >= 32 ? k0 - 32 + r : r;
                const bf16_t* kp = p.big + (size_t)row_of(b, kpos) * DIN + C_K + hh * 64 + 8 * h;
#pragma unroll
                for (int ks = 0; ks < 4; ++ks) kn[ks] = *(const bf16x8*)(kp + 16 * ks);
            }
            f32x16 x;
#pragma unroll
            for (int i = 0; i < 16; ++i) x[i] = 0.f;
#pragma unroll
            for (int ks = 0; ks < 4; ++ks) x = __builtin_amdgcn_mfma_f32_32x32x16_bf16(kf[ks], qf[ks], x, 0, 0, 0);
            float lr[16], ls[16];
#pragma unroll
            for (int i = 0; i < 16; ++i) {
                const int key = k0 + (i & 3) + 8 * (i >> 2) + 4 * h;
                const float z = x[i] * 0.125f;
                const float sp = __logf(1.f + __expf(-fabsf(z)));
                const float lsi = fminf(z, 0.f) - sp;
                ls[i] = lsi;
                lr[i] = key < t ? lsi - z : 0.f;
            }
            float pw[16];
            float run = carry;
#pragma unroll
            for (int g = 3; g >= 0; --g) {
                const float G = (lr[4 * g] + lr[4 * g + 1]) + (lr[4 * g + 2] + lr[4 * g + 3]);
                const float Gp = __shfl_xor(G, 32);
                const float s3 = run + (h == 0 ? Gp : 0.f);
                const float s2 = s3 + lr[4 * g + 3], s1 = s2 + lr[4 * g + 2], s0 = s1 + lr[4 * g + 1];
                const int keyb = k0 + 8 * g + 4 * h;
                pw[4 * g + 3] = keyb + 3 < t ? __expf(ls[4 * g + 3] + s3) : 0.f;
                pw[4 * g + 2] = keyb + 2 < t ? __expf(ls[4 * g + 2] + s2) : 0.f;
                pw[4 * g + 1] = keyb + 1 < t ? __expf(ls[4 * g + 1] + s1) : 0.f;
                pw[4 * g + 0] = keyb + 0 < t ? __expf(ls[4 * g + 0] + s0) : 0.f;
                run += G + Gp;
            }
            carry = run;
            const bf16x8 pf0 = pack_frag(pw[0], pw[1], pw[2], pw[3], pw[4], pw[5], pw[6], pw[7]);
            const bf16x8 pf1 = pack_frag(pw[8], pw[9], pw[10], pw[11], pw[12], pw[13], pw[14], pw[15]);
            o0 = __builtin_amdgcn_mfma_f32_32x32x16_bf16(vf[0][0], pf0, o0, 0, 0, 0);
            o0 = __builtin_amdgcn_mfma_f32_32x32x16_bf16(vf[0][1], pf1, o0, 0, 0, 0);
            o1 = __builtin_amdgcn_mfma_f32_32x32x16_bf16(vf[1][0], pf0, o1, 0, 0, 0);
            o1 = __builtin_amdgcn_mfma_f32_32x32x16_bf16(vf[1][1], pf1, o1, 0, 0, 0);
#pragma unroll
            for (int ks = 0; ks < 4; ++ks) kf[ks] = kn[ks];
            if (__all((!valid || carry < -110.f) ? 1 : 0)) break;
        }
        float ss = 0.f;
#pragma unroll
        for (int i = 0; i < 16; ++i) ss += o0[i] * o0[i] + o1[i] * o1[i];
        ss += __shfl_xor(ss, 32);
        const float rs = rsqrtf(ss * (1.f / 64.f) + 1e-6f);
        if (valid) {
            const float* g = p.sb_norm + l * 384 + hh * 64 + 4 * h;
            bf16_t* yp = p.y + (size_t)myrow * DM + 640 + hh * 64 + 4 * h;
#pragma unroll
            for (int gq = 0; gq < 4; ++gq) {
                const f32x4 g0 = *(const f32x4*)(g + 8 * gq), g1 = *(const f32x4*)(g + 32 + 8 * gq);
                u32x2 w0, w1;
                w0.x = cvt2(o0[4 * gq] * rs * g0[0], o0[4 * gq + 1] * rs * g0[1]); w0.y = cvt2(o0[4 * gq + 2] * rs * g0[2], o0[4 * gq + 3] * rs * g0[3]);
                w1.x = cvt2(o1[4 * gq] * rs * g1[0], o1[4 * gq + 1] * rs * g1[1]); w1.y = cvt2(o1[4 * gq + 2] * rs * g1[2], o1[4 * gq + 3] * rs * g1[3]);
                *(u32x2*)(yp + 8 * gq) = w0;
                *(u32x2*)(yp + 32 + 8 * gq) = w1;
            }
        }
    }
}

DEV void phase_final(CP& p, int bid, int nblk) {
    const int lane = tid_() & 63, wave = tid_() >> 6;
    for (int r = bid * 8 + wave; r < MMAIN; r += nblk * 8) {
        const float rs = row_rstd(p.part, r);
#pragma unroll
        for (int i = 0; i < 4; ++i) {
            const int c = (i * 64 + lane) * 4;
            const f32x4 v = *(const f32x4*)(p.h + (size_t)r * DM + c), g = *(const f32x4*)(p.final_norm + c);
            *(f32x4*)(p.out + (size_t)r * DM + c) = v * rs * g;
        }
    }
}

#define XB_TMO      128
#define XB_XCNT(j)  (256  + 64 * (j))
#define XB_XSUB(j)  (1280 + 64 * (j))
#define XB_XGEN(j)  (2304 + 64 * (j))
#define XB_TOP      3328
#define XB_TOPGEN   3392
#define XCD_BAR_WORDS 3456
#define XB_SPIN_CAP (1u << 18)
#define XB_LAS __attribute__((address_space(3)))

__device__ __forceinline__ unsigned xb_ld(unsigned* p)              { return __hip_atomic_load(p, __ATOMIC_RELAXED, __HIP_MEMORY_SCOPE_AGENT); }
__device__ __forceinline__ unsigned xb_add(unsigned* p, unsigned v) { return __hip_atomic_fetch_add(p, v, __ATOMIC_RELAXED, __HIP_MEMORY_SCOPE_AGENT); }
__device__ __forceinline__ unsigned xb_xcc_id() { return (unsigned)__builtin_amdgcn_s_getreg((3 << 11) | 20) & 0xFu; }
#define XB_SPIN(cond, bar) do { unsigned _sp = 0; while (cond) { __builtin_amdgcn_s_sleep(1); \
    if ((++_sp & 255u) == 0u) { if (xb_ld(&(bar)[XB_TMO])) break; if (_sp > XB_SPIN_CAP) { atomicAdd(&(bar)[XB_TMO], 1u); break; } } } } while (0)

struct XcdBarrier {
    unsigned* bar; unsigned x;
    volatile XB_LAS unsigned* st;
};

__device__ __forceinline__ XcdBarrier xcd_barrier_post(unsigned* bar, volatile XB_LAS unsigned* st) {
    XcdBarrier b; b.bar = bar; b.x = xb_xcc_id(); b.st = st;
    if (threadIdx.x == 0) (void)xb_add(&bar[XB_XCNT(b.x)], 1u);
    return b;
}
__device__ __forceinline__ void xcd_barrier_complete(unsigned* bar, unsigned x, unsigned& nloc, unsigned& nx) {
    const unsigned G = gridDim.x * gridDim.y * gridDim.z;
    unsigned sum, cnt, mine, sp = 0u;
    for (;;) {
        sum = 0u; cnt = 0u; mine = 0u;
#pragma unroll
        for (unsigned j = 0; j < 16; ++j) { const unsigned c = xb_ld(&bar[XB_XCNT(j)]); sum += c; cnt += (c > 0u) ? 1u : 0u; mine = (j == x) ? c : mine; }
        if (sum == G) break;
        __builtin_amdgcn_s_sleep(1);
        if ((++sp & 255u) == 0u) { if (xb_ld(&bar[XB_TMO])) break; if (sp > XB_SPIN_CAP) { atomicAdd(&bar[XB_TMO], 1u); break; } }
    }
    nloc = mine > 0u ? mine : 1u; nx = cnt > 0u ? cnt : 1u;
}

__device__ __forceinline__ void xcd_barrier(const XcdBarrier& b) {
    asm volatile("s_waitcnt vmcnt(0)" ::: "memory");
    __syncthreads();
    if (threadIdx.x == 0) {
        unsigned* bar = b.bar;
        __builtin_amdgcn_s_waitcnt(0);
        unsigned nloc = b.st[0], nx = b.st[1];
        if (nloc == 0u) { xcd_barrier_complete(bar, b.x, nloc, nx); b.st[0] = nloc; b.st[1] = nx; }
        const unsigned old = xb_add(&bar[XB_XSUB(b.x)], 1u);
        const unsigned gen = old / nloc;
        if (old + 1u == (gen + 1u) * nloc) {
            __builtin_amdgcn_fence(__ATOMIC_RELEASE, "agent");
            asm volatile("s_waitcnt vmcnt(0)" ::: "memory");
            const unsigned og = xb_add(&bar[XB_TOP], 1u);
            const unsigned tg = og / nx;
            if (og + 1u == (tg + 1u) * nx) xb_add(&bar[XB_TOPGEN], 1u);
            else XB_SPIN(xb_ld(&bar[XB_TOPGEN]) == tg, bar);
            __builtin_amdgcn_fence(__ATOMIC_ACQUIRE, "agent");
            xb_add(&bar[XB_XGEN(b.x)], 1u);
            asm volatile("s_waitcnt vmcnt(0)" ::: "memory");
        } else {
            XB_SPIN(xb_ld(&bar[XB_XGEN(b.x)]) == gen, bar);
            __builtin_amdgcn_fence(__ATOMIC_ACQUIRE, "agent");
            asm volatile("s_waitcnt vmcnt(0)" ::: "memory");
        }
    }
    __syncthreads();
}


enum { PH_INIT = 0, PH_CONVERT, PH_G1A, PH_G2A, PH_G3, PH_CONV, PH_PREP, PH_SCAN, PH_SB, PH_G4, PH_G1B, PH_G2B, PH_FINAL };

DEV void run_phase(CP& p, int ph, int l, int bid, int nblk, float* lds) {
    switch (ph) {
    case PH_INIT: phase_init(p, bid, nblk); break;
    case PH_G1A: gemm_big(p.hb, p.W13a, MMAIN, 2 * DFF, DM, EpiSwiglu{p.big, p.part}, bid, nblk, (unsigned char*)lds);
        if (bid >= 128) gemm_meta<EPI_SWIGLU>(p, p.hb, p.W13a, 2 * DFF, DM, 0.f, bid - 128, nblk - 128, lds); break;
    case PH_G2A: gemm_big(p.big, p.W2a, MMAIN, DM, DFF, EpiResid{p.h, p.hb, p.part, 0.5f}, bid, nblk, (unsigned char*)lds);
        gemm_meta<EPI_RESID>(p, p.big, p.W2a, DM, DFF, 0.5f, bid, nblk, lds); break;
    case PH_G3: gemm_big(p.hb, p.Win, MMAIN, DIN, DM, EpiP{p.big, p.vt, p.part}, bid, nblk, (unsigned char*)lds);
        gemm_meta<EPI_P>(p, p.hb, p.Win, DIN, DM, 0.f, bid, nblk, lds); break;
    case PH_CONV: phase_conv(p, l, bid, nblk, lds); break;
    case PH_PREP: phase_rwkv_prep(p, l, bid, nblk, lds); break;
    case PH_G4: gemm_big(p.y, p.Wout, MMAIN, DM, DM, EpiResid{p.h, p.hb, p.part, 1.0f}, bid, nblk, (unsigned char*)lds);
        gemm_meta<EPI_RESID>(p, p.y, p.Wout, DM, DM, 1.0f, bid, nblk, lds); break;
    case PH_G1B: gemm_big(p.hb, p.W13b, MMAIN, 2 * DFF, DM, EpiSwiglu{p.big, p.part}, bid, nblk, (unsigned char*)lds);
        if (bid >= 128) gemm_meta<EPI_SWIGLU>(p, p.hb, p.W13b, 2 * DFF, DM, 0.f, bid - 128, nblk - 128, lds); break;
    case PH_G2B: gemm_big(p.big, p.W2b, MMAIN, DM, DFF, EpiResid{p.h, p.hb, p.part, 0.5f}, bid, nblk, (unsigned char*)lds);
        gemm_meta<EPI_RESID>(p, p.big, p.W2b, DM, DFF, 0.5f, bid, nblk, lds); break;
    case PH_FINAL: phase_final(p, bid, nblk); break;
    }
}

namespace cg = cooperative_groups;
constexpr int NSIDE = 96;
constexpr int LDS_BYTES = 151552 + 16;

__global__ void __launch_bounds__(512) k_mega(P p) {
    extern __shared__ __attribute__((aligned(16))) unsigned char smem[];
    float* lds = (float*)smem;
    cg::grid_group grid = cg::this_grid();
    const int bid0 = blockIdx.x, nblk = gridDim.x;
    volatile XB_LAS unsigned* xst = (volatile XB_LAS unsigned*)((XB_LAS unsigned char*)smem + (LDS_BYTES - 16));
    if (threadIdx.x < 4) xst[threadIdx.x] = 0u;
    __syncthreads();
    (void)xcd_barrier_post(kargs()->bar, xst);
#define XBAR() { XcdBarrier xb_; xb_.bar = kargs()->bar; xb_.x = xb_xcc_id(); xb_.st = xst; xcd_barrier(xb_); }
    phase_init(*kargs(), bid0, nblk);
    phase_convert(*kargs(), 0, 0, bid0, nblk, lds);
    if (nblk == 0x7fffffff) grid.sync();
    XBAR();
    for (int l = 0; l < 4; ++l) {
        int bid = bid0; asm volatile("" : "+s"(bid));
        run_phase(*kargs(), PH_G1A, l, bid, nblk, lds); XBAR();
        run_phase(*kargs(), PH_G2A, l, bid, nblk, lds); XBAR();
        run_phase(*kargs(), PH_G3, l, bid, nblk, lds); XBAR();
        run_phase(*kargs(), PH_PREP, l, bid, nblk, lds);
        if (bid >= 2) {
            __syncthreads();
            phase_convert(*kargs(), l, 2, bid - 2, nblk - 2, lds, 0, l < 3 ? 2368 + 2880 : 2368);
        }
        XBAR();
        phase_rwkv_pack(*kargs(), l, bid, nblk, smem);
        XBAR();
        if (bid < 48) phase_rwkv_chunk(*kargs(), l, bid, smem);
        else if (bid < 48 + NSIDE) {
            phase_sb_mfma(*kargs(), l, bid - 48, NSIDE);
            __syncthreads();
            phase_conv(*kargs(), l, bid - 48, NSIDE, lds);
            if (l < 3) phase_convert(*kargs(), l + 1, 0, bid - 48, NSIDE, lds, 2880, CONV_A);
        } else if (bid < 48 + NSIDE + 48) phase_pack_prefetch(*kargs(), bid - 48 - NSIDE);
        XBAR();
        run_phase(*kargs(), PH_G4, l, bid, nblk, lds); XBAR();
        run_phase(*kargs(), PH_G1B, l, bid, nblk, lds); XBAR();
        run_phase(*kargs(), PH_G2B, l, bid, nblk, lds); XBAR();
    }
    phase_final(*kargs(), bid0, nblk);
}
#undef XBAR

extern "C" void kernel_launch(void* const* d_in, const int* in_sizes, int n_in, void* d_out, int out_size, void* d_ws, size_t ws_size, hipStream_t stream) {
    static int grid_blocks = 0;
    if (grid_blocks == 0) {
        int dev = 0, cus = 0, per_cu = 0;
        hipGetDevice(&dev);
        hipDeviceGetAttribute(&cus, hipDeviceAttributeMultiprocessorCount, dev);
        if (hipFuncSetAttribute((const void*)k_mega, hipFuncAttributeMaxDynamicSharedMemorySize, LDS_BYTES) != hipSuccess) { fprintf(stderr, "hipFuncSetAttribute failed\n"); grid_blocks = -1; return; }
        if (hipOccupancyMaxActiveBlocksPerMultiprocessor(&per_cu, (const void*)k_mega, 512, LDS_BYTES) != hipSuccess || per_cu < 1) { fprintf(stderr, "occupancy query failed (%d)\n", per_cu); per_cu = 1; }
        (void)hipGetLastError();
        grid_blocks = cus * per_cu;
    }
    if (grid_blocks < 0) return;
    P p{};
    const float** f = (const float**)&p;
    for (int i = 0; i < 28; ++i) f[i] = (const float*)d_in[i];
    p.out = (float*)d_out;
    size_t off = 0;
    auto take = [&](size_t bytes) { void* r = (char*)d_ws + off; off += (bytes + 255) & ~(size_t)255; return r; };
    p.W13a = (bf16_t*)take((size_t)2 * DFF * DM * 2);
    p.W2a = (bf16_t*)take((size_t)DM * DFF * 2);
    p.Win = (bf16_t*)take((size_t)DIN * DM * 2);
    p.Wout = (bf16_t*)take((size_t)DM * DM * 2);
    p.W13b = (bf16_t*)take((size_t)2 * DFF * DM * 2);
    p.W2b = (bf16_t*)take((size_t)DM * DFF * 2);
    p.Wl = (bf16_t*)take((size_t)DRW * 256 * 2);
    p.h = (float*)take((size_t)MP * DM * 4);
    p.hb = (bf16_t*)take((size_t)MP * DM * 2);
    p.big = (bf16_t*)take((size_t)MP * DIN * 2);
    p.y = (bf16_t*)take((size_t)MP * DM * 2);
    p.vt = (bf16_t*)take((size_t)NB * 6 * 64 * LPV * 2);
    p.part = (float*)take((size_t)MP * 16 * 4);
    p.lw = (float*)p.hb;
    p.aa = (float*)p.y;
    p.gg16 = (bf16_t*)take((size_t)MP * DRW * 2);
    p.pack = (unsigned char*)take((size_t)NB * 6 * 129 * PK_BYTES);
    p.ct = (float*)take((size_t)MP * 8 * 4);
    p.inorm = (float*)take((size_t)MP * 8 * 4);
    p.bar = (unsigned*)take((size_t)XCD_BAR_WORDS * 4);
    if (off > ws_size) { fprintf(stderr, "workspace too small: need %zu have %zu\n", off, ws_size); return; }
    if (hipMemsetAsync(p.bar, 0, (size_t)XCD_BAR_WORDS * 4, stream) != hipSuccess) { fprintf(stderr, "memset of barrier words failed\n"); return; }
    void* args[] = {&p};
    hipError_t e = hipLaunchCooperativeKernel((const void*)k_mega, dim3(grid_blocks), dim3(512), args, LDS_BYTES, stream);
    if (e != hipSuccess) fprintf(stderr, "cooperative launch failed: %s (grid %d)\n", hipGetErrorString(e), grid_blocks);
}
```

```cpp
#include <hip/hip_runtime.h>
#include <hip/hip_cooperative_groups.h>
#include <stdint.h>
#include <stdio.h>

typedef unsigned short bf16_t;
typedef short bf16x8 __attribute__((ext_vector_type(8)));
typedef float f32x4 __attribute__((ext_vector_type(4)));
typedef unsigned u32x4 __attribute__((ext_vector_type(4)));
typedef unsigned u32x2 __attribute__((ext_vector_type(2)));

#define DEV __device__ __forceinline__

constexpr int NB = 8, SEQ = 2048, NMETA = 16, LT = 2064, DM = 1024, DFF = 2816, DIN = 3072;
constexpr int MMAIN = 16384, MTOK = 16512, MP = 16640;
constexpr int DRW = 384, LPV = 2080;
constexpr int C_RW = 512, C_Q = 1920, C_K = 2304, C_V = 2688;

struct P {
    const float *x, *meta, *ffn1_norm, *ffn1_w13, *ffn1_w2, *mix_norm, *w_in, *conv_w, *conv_b, *conv_ln_g, *conv_ln_b,
        *rwkv_mu, *rwkv_w0, *rwkv_wB, *rwkv_a0, *rwkv_aB, *rwkv_gB, *rwkv_kk, *rwkv_ka, *rwkv_rk, *rwkv_ln_g, *rwkv_ln_b,
        *sb_norm, *w_out, *ffn2_norm, *ffn2_w13, *ffn2_w2, *final_norm;
    float* out;
    bf16_t *W13a, *W2a, *Win, *Wout, *W13b, *W2b, *Wl;
    float* h; bf16_t* hb; bf16_t* big; bf16_t* y; bf16_t* vt; float* part;
    float *lw, *aa, *ct, *inorm; bf16_t* gg16; unsigned char* pack;
    unsigned* bar;
};

typedef const __attribute__((address_space(4))) P CP;
DEV CP* kargs() { CP* k = (CP*)__builtin_amdgcn_kernarg_segment_ptr(); asm volatile("" : "+s"(k)); return k; }
DEV int tid_() { int t = threadIdx.x; asm volatile("" : "+v"(t)); return t; }
DEV float bf2f(bf16_t v) { return __uint_as_float(((unsigned)v) << 16); }
DEV bf16_t f2bf(float f) { unsigned u = __float_as_uint(f); u += 0x7FFFu + ((u >> 16) & 1u); return (bf16_t)(u >> 16); }
DEV unsigned pack2(float a, float b) { return (unsigned)f2bf(a) | ((unsigned)f2bf(b) << 16); }
DEV float wave_sum(float v) {
#pragma unroll
    for (int o = 32; o; o >>= 1) v += __shfl_xor(v, o);
    return v;
}
DEV float dpp_sum16(float x) {
    x += __builtin_bit_cast(float, __builtin_amdgcn_update_dpp(0, __builtin_bit_cast(int, x), 0xB1, 0xF, 0xF, false));
    x += __builtin_bit_cast(float, __builtin_amdgcn_update_dpp(0, __builtin_bit_cast(int, x), 0x4E, 0xF, 0xF, false));
    x += __builtin_bit_cast(float, __builtin_amdgcn_update_dpp(0, __builtin_bit_cast(int, x), 0x141, 0xF, 0xF, false));
    x += __builtin_bit_cast(float, __builtin_amdgcn_update_dpp(0, __builtin_bit_cast(int, x), 0x140, 0xF, 0xF, false));
    return x;
}
DEV float wave_sum_fast(float x) {
    x = dpp_sum16(x);
    const int xi = __builtin_bit_cast(int, x);
    return (__builtin_bit_cast(float, __builtin_amdgcn_readlane(xi, 0)) + __builtin_bit_cast(float, __builtin_amdgcn_readlane(xi, 16))) +
           (__builtin_bit_cast(float, __builtin_amdgcn_readlane(xi, 32)) + __builtin_bit_cast(float, __builtin_amdgcn_readlane(xi, 48)));
}
typedef float f32x16 __attribute__((ext_vector_type(16)));
typedef __bf16 bfv2 __attribute__((ext_vector_type(2)));
typedef float f32x2v __attribute__((ext_vector_type(2)));
typedef short s16x4 __attribute__((ext_vector_type(4)));
DEV unsigned cvt2(float a, float b) { return __builtin_bit_cast(unsigned, __builtin_convertvector((f32x2v){a, b}, bfv2)); }
DEV bf16x8 pack_frag(float a0, float a1, float a2, float a3, float a4, float a5, float a6, float a7) {
    u32x4 w; w.x = cvt2(a0, a1); w.y = cvt2(a2, a3); w.z = cvt2(a4, a5); w.w = cvt2(a6, a7);
    return __builtin_bit_cast(bf16x8, w);
}
DEV float sigm(float x) { return 1.f / (1.f + expf(-x)); }
DEV int row_of(int b, int pos) { return pos < NMETA ? MMAIN + b * NMETA + pos : b * SEQ + pos - NMETA; }
DEV float row_rstd(const float* part, int row) {
    const f32x4* pp = (const f32x4*)(part + (size_t)row * 16);
    f32x4 a = pp[0], b = pp[1], c = pp[2], d = pp[3];
    float ss = ((a[0] + a[1]) + (a[2] + a[3])) + ((b[0] + b[1]) + (b[2] + b[3])) + ((c[0] + c[1]) + (c[2] + c[3])) + ((d[0] + d[1]) + (d[2] + d[3]));
    return rsqrtf(ss * (1.0f / 1024.0f) + 1e-6f);
}

DEV void phase_init(CP& p, int bid, int nblk) {
    const int lane = tid_() & 63, wave = tid_() >> 6;
    for (int r = bid * 8 + wave; r < MP; r += nblk * 8) {
        const float* src = nullptr;
        if (r < MMAIN) src = p.x + (size_t)r * DM;
        else if (r < MTOK) src = p.meta + (size_t)((r - MMAIN) & 15) * DM;
        float ss = 0.f;
#pragma unroll
        for (int i = 0; i < 4; ++i) {
            const int c = (i * 64 + lane) * 4;
            f32x4 v = src ? *(const f32x4*)(src + c) : (f32x4){0.f, 0.f, 0.f, 0.f};
            *(f32x4*)(p.h + (size_t)r * DM + c) = v;
            u32x2 w; w.x = pack2(v[0], v[1]); w.y = pack2(v[2], v[3]);
            *(u32x2*)(p.hb + (size_t)r * DM + c) = w;
            ss += v[0] * v[0] + v[1] * v[1] + v[2] * v[2] + v[3] * v[3];
        }
        ss = wave_sum(ss);
        if (lane < 16) p.part[(size_t)r * 16 + lane] = lane == 0 ? ss : 0.f;
    }
    for (int i = bid * 512 + tid_(); i < NB * 6 * 64 * (LPV - LT); i += nblk * 512) p.vt[(size_t)(i >> 4) * LPV + LT + (i & 15)] = 0;
}

struct ConvDesc { const float* W; const float* g; bf16_t* dst; int K, N, swz, kt, nt; };
DEV ConvDesc conv_desc(CP& p, int l, int grp, int idx) {
    ConvDesc d;
    int t = idx;
    if (grp == 2) { if (t < 2368) grp = 1; else { t -= 2368; grp = 0; l += 1; } }
    if (grp == 0) {
        if (t < 1408) { d.W = p.ffn1_w13 + (size_t)l * DM * 2 * DFF; d.g = p.ffn1_norm + l * DM; d.dst = p.W13a; d.K = DM; d.N = 2 * DFF; d.swz = 1; d.kt = t / 88; d.nt = t % 88; return d; }
        t -= 1408;
        if (t < 704) { d.W = p.ffn1_w2 + (size_t)l * DFF * DM; d.g = nullptr; d.dst = p.W2a; d.K = DFF; d.N = DM; d.swz = 0; d.kt = t / 16; d.nt = t % 16; return d; }
        t -= 704;
        if (t < 768) { d.W = p.w_in + (size_t)l * DM * DIN; d.g = p.mix_norm + l * DM; d.dst = p.Win; d.K = DM; d.N = DIN; d.swz = 0; d.kt = t / 48; d.nt = t % 48; return d; }
        t -= 768;
        d.g = nullptr; d.N = DRW; d.swz = 0;
        if (t < 6) { d.W = p.rwkv_wB + (size_t)l * 64 * DRW; d.dst = p.Wl; d.K = 64; d.kt = 0; d.nt = t; return d; }
        if (t < 12) { d.W = p.rwkv_aB + (size_t)l * 64 * DRW; d.dst = p.Wl + DRW * 64; d.K = 64; d.kt = 0; d.nt = t - 6; return d; }
        d.W = p.rwkv_gB + (size_t)l * 128 * DRW; d.dst = p.Wl + DRW * 128; d.K = 128; d.kt = (t - 12) / 6; d.nt = (t - 12) % 6; return d;
    }
    if (t < 256) { d.W = p.w_out + (size_t)l * DM * DM; d.g = nullptr; d.dst = p.Wout; d.K = DM; d.N = DM; d.swz = 0; d.kt = t / 16; d.nt = t % 16; return d; }
    t -= 256;
    if (t < 1408) { d.W = p.ffn2_w13 + (size_t)l * DM * 2 * DFF; d.g = p.ffn2_norm + l * DM; d.dst = p.W13b; d.K = DM; d.N = 2 * DFF; d.swz = 1; d.kt = t / 88; d.nt = t % 88; return d; }
    t -= 1408;
    d.W = p.ffn2_w2 + (size_t)l * DFF * DM; d.g = nullptr; d.dst = p.W2b; d.K = DFF; d.N = DM; d.swz = 0; d.kt = t / 16; d.nt = t % 16; return d;
}
constexpr int CONV_A = 2904, CONV_B = 2368;
DEV void conv_load(const ConvDesc& d, int tid, f32x4 (&v)[2]) {
#pragma unroll
    for (int i = 0; i < 2; ++i) {
        const int idx = tid + i * 512, kk = idx >> 4, n4 = (idx & 15) * 4;
        v[i] = *(const f32x4*)(d.W + (size_t)(d.kt * 64 + kk) * d.N + d.nt * 64 + n4);
        if (d.g) v[i] *= d.g[d.kt * 64 + kk];
    }
}
DEV void conv_tile_store(const ConvDesc& dc, int tid, const float* tile) {
    const int nn = tid >> 3, kc = (tid & 7) * 8;
    const int sc = dc.nt * 64 + nn;
    int nd = sc;
    if (dc.swz) { const int bj = sc >= DFF ? 1 : 0; const int j = sc - bj * DFF; nd = (j >> 7) * 256 + bj * 128 + (j & 127); }
    u32x4 w;
    w.x = cvt2(tile[(kc + 0) * 65 + nn], tile[(kc + 1) * 65 + nn]); w.y = cvt2(tile[(kc + 2) * 65 + nn], tile[(kc + 3) * 65 + nn]);
    w.z = cvt2(tile[(kc + 4) * 65 + nn], tile[(kc + 5) * 65 + nn]); w.w = cvt2(tile[(kc + 6) * 65 + nn], tile[(kc + 7) * 65 + nn]);
    *(u32x4*)(dc.dst + (size_t)nd * dc.K + dc.kt * 64 + kc) = w;
}
DEV void phase_convert(CP& p, int l, int grp, int bid, int nblk, float* tile, int lo = 0, int hi = -1) {
    const int tid = tid_(), total = hi >= 0 ? hi : (grp == 0 ? CONV_A : CONV_B);
    bid += lo;
    if (bid >= total) return;
    f32x4 v0[2], v1[2], v2[2];
    { const ConvDesc d = conv_desc(p, l, grp, bid); conv_load(d, tid, v0); }
    if (bid + nblk < total) { const ConvDesc d = conv_desc(p, l, grp, bid + nblk); conv_load(d, tid, v1); }
    if (bid + 2 * nblk < total) { const ConvDesc d = conv_desc(p, l, grp, bid + 2 * nblk); conv_load(d, tid, v2); }
    for (int it = bid; it < total; it += nblk) {
#pragma unroll
        for (int i = 0; i < 2; ++i) {
            const int idx = tid + i * 512, kk = idx >> 4, n4 = (idx & 15) * 4;
#pragma unroll
            for (int j = 0; j < 4; ++j) tile[kk * 65 + n4 + j] = v0[i][j];
        }
        __syncthreads();
        v0[0] = v1[0]; v0[1] = v1[1]; v1[0] = v2[0]; v1[1] = v2[1];
        if (it + 3 * nblk < total) { const ConvDesc d = conv_desc(p, l, grp, it + 3 * nblk); conv_load(d, tid, v2); }
        { const ConvDesc dc = conv_desc(p, l, grp, it); conv_tile_store(dc, tid, tile); }
        __syncthreads();
    }
}

enum { EPI_SWIGLU = 0, EPI_RESID = 1, EPI_P = 2 };

DEV void epi_swiglu(CP& p, int row, int colh, f32x4 g, f32x4 u, float rs) {
    float o[4];
#pragma unroll
    for (int e = 0; e < 4; ++e) { const float gg = g[e] * rs, uu = u[e] * rs; o[e] = gg * sigm(gg) * uu; }
    u32x2 w; w.x = pack2(o[0], o[1]); w.y = pack2(o[2], o[3]);
    *(u32x2*)(p.big + (size_t)row * DFF + colh) = w;
}
DEV float epi_resid(CP& p, int row, int col, f32x4 a, float scale) {
    float* hp = p.h + (size_t)row * DM + col;
    f32x4 hv = *(const f32x4*)hp;
    hv += a * scale;
    *(f32x4*)hp = hv;
    u32x2 w; w.x = pack2(hv[0], hv[1]); w.y = pack2(hv[2], hv[3]);
    *(u32x2*)(p.hb + (size_t)row * DM + col) = w;
    return hv[0] * hv[0] + hv[1] * hv[1] + hv[2] * hv[2] + hv[3] * hv[3];
}
DEV void epi_p(CP& p, int row, int col, f32x4 a, float rs) {
    a *= rs;
    u32x2 w; w.x = pack2(a[0], a[1]); w.y = pack2(a[2], a[3]);
    *(u32x2*)(p.big + (size_t)row * DIN + col) = w;
    if (col >= C_V && row < MTOK) {
        const int hh = (col - C_V) >> 6, d = (col - C_V) & 63;
        int b, pos;
        if (row < MMAIN) { b = row >> 11; pos = (row & 2047) + NMETA; } else { b = (row - MMAIN) >> 4; pos = (row - MMAIN) & 15; }
        bf16_t* vp = p.vt + ((size_t)((b * 6 + hh) * 64 + d)) * LPV + pos;
#pragma unroll
        for (int e = 0; e < 4; ++e) vp[(size_t)e * LPV] = f2bf(a[e]);
    }
}

template <int EPI>
DEV void gemm_meta(CP& p, const bf16_t* __restrict__ A, const bf16_t* __restrict__ Bt, int N, int K, float scale, int bid, int nblk, float* lds) {
    const int tid = tid_(), lane = tid & 63, wave = tid >> 6, fr = lane & 15, fq = lane >> 4;
    const int nt = N / 64, total = 4 * nt, kw = K / 8;
    float* red = lds + 8 * 8 * 64 * 4;
    for (int u = bid; u < total; u += nblk) {
        const int mu = u / nt, nu = u % nt, row0 = MMAIN + mu * 32;
        const int cb = (EPI == EPI_SWIGLU) ? ((nu >> 2) * 256 + (nu & 3) * 32) : nu * 64;
        f32x4 acc[2][4];
#pragma unroll
        for (int i = 0; i < 2; ++i)
#pragma unroll
            for (int j = 0; j < 4; ++j) acc[i][j] = (f32x4){0.f, 0.f, 0.f, 0.f};
        const bf16_t* ap = A + (size_t)(row0 + fr) * K + wave * kw + fq * 8;
        const bf16_t* bp = Bt + (size_t)(cb + fr) * K + wave * kw + fq * 8;
        for (int k0 = 0; k0 < kw; k0 += 32) {
            const bf16x8 a0 = *(const bf16x8*)(ap + k0), a1 = *(const bf16x8*)(ap + (size_t)16 * K + k0);
#pragma unroll
            for (int j = 0; j < 4; ++j) {
                const int co = (EPI == EPI_SWIGLU) ? ((j & 1) * 16 + (j >> 1) * 128) : j * 16;
                const bf16x8 bv = *(const bf16x8*)(bp + (size_t)co * K + k0);
                acc[0][j] = __builtin_amdgcn_mfma_f32_16x16x32_bf16(bv, a0, acc[0][j], 0, 0, 0);
                acc[1][j] = __builtin_amdgcn_mfma_f32_16x16x32_bf16(bv, a1, acc[1][j], 0, 0, 0);
            }
        }
#pragma unroll
        for (int i = 0; i < 2; ++i)
#pragma unroll
            for (int j = 0; j < 4; ++j) *(f32x4*)(lds + ((wave * 8 + i * 4 + j) * 64 + lane) * 4) = acc[i][j];
        __syncthreads();
        {
            f32x4 sum = (f32x4){0.f, 0.f, 0.f, 0.f};
#pragma unroll
            for (int w = 0; w < 8; ++w) sum += *(const f32x4*)(lds + ((w * 8 + wave) * 64 + lane) * 4);
            *(f32x4*)(red + (wave * 64 + lane) * 4) = sum;
        }
        __syncthreads();
        if (wave < 2) {
            const int i = wave, row = row0 + 16 * i + fr;
            f32x4 a[4];
#pragma unroll
            for (int j = 0; j < 4; ++j) a[j] = *(const f32x4*)(red + ((i * 4 + j) * 64 + lane) * 4);
            if (EPI == EPI_SWIGLU) {
                const float rs = row_rstd(p.part, row);
                const int colh = (nu >> 2) * 128 + (nu & 3) * 32 + 4 * fq;
                epi_swiglu(p, row, colh, a[0], a[2], rs);
                epi_swiglu(p, row, colh + 16, a[1], a[3], rs);
            } else if (EPI == EPI_RESID) {
                float ss = 0.f;
#pragma unroll
                for (int j = 0; j < 4; ++j) ss += epi_resid(p, row, cb + 16 * j + 4 * fq, a[j], scale);
                ss += __shfl_xor(ss, 16); ss += __shfl_xor(ss, 32);
                if (fq == 0) p.part[(size_t)row * 16 + nu] = ss;
            } else {
                const float rs = row_rstd(p.part, row);
#pragma unroll
                for (int j = 0; j < 4; ++j) epi_p(p, row, cb + 16 * j + 4 * fq, a[j], rs);
            }
        }
        __syncthreads();
    }
}

namespace pg8 {
#define PG8_LAS __attribute__((address_space(3)))
typedef unsigned short bf16_t;
typedef short bf16x8 __attribute__((ext_vector_type(8)));
typedef float f32x4 __attribute__((ext_vector_type(4)));
typedef unsigned u32x4 __attribute__((ext_vector_type(4)));
constexpr int BM = 256, BK = 64, HALF = 128, HTB = HALF * BK * 2  , STAGE_BYTES = 8 * HTB, NXCD = 8, WGM = 8;

__host__ __device__ __forceinline__ int lds_byte(int r, int c) { const int st = (r >> 4) * 2 + (c >> 5), rr = r & 15, cc = c & 31, ob = rr * 64 + cc * 2; return st * 1024 + (ob ^ (((ob >> 9) & 1) << 5)); }
__host__ __device__ __forceinline__ void stage_rc(int b, int& R, int& C) { const int st = b / 1024, sb = b % 1024, swz = sb ^ (((sb >> 9) & 1) << 5); R = (st >> 1) * 16 + swz / 64; C = (st & 1) * 32 + (swz % 64) / 2; }
__host__ __device__ __forceinline__ int perm32(int rho) { const int n = rho >> 4, i = rho & 15; return 8 * (i >> 2) + 4 * n + (i & 3); }

struct Unit { int pm, pn; };
struct Gemm { const bf16_t* A; const bf16_t* Bt; int M, N, K; };

struct StaticOrder {
    int nM, nN, nwg, G, c;
    __host__ __device__ void init(int M, int N, int G_, int c_) { nM = M / BM; nN = N / BM; nwg = nM * nN; G = G_; c = c_; }
    __host__ __device__ bool next(int i, Unit& u) const {
        const long L = (long)i * G + c; if (L >= nwg) return false;
        int wgid = (int)L; { const int q = nwg / NXCD, r = nwg % NXCD, xcd = wgid % NXCD, off = wgid / NXCD; wgid = (xcd < r ? xcd * (q + 1) : r * (q + 1) + (xcd - r) * q) + off; }
        const int nig = WGM * nN, gid = wgid / nig, fm = gid * WGM, gsz = (nM - fm) < WGM ? (nM - fm) : WGM;
        u.pm = fm + ((wgid % nig) % gsz); u.pn = (wgid % nig) / gsz; return true;
    }
    __device__ __forceinline__ void a_ready(const Unit&) const {}
    __device__ __forceinline__ void done(const Unit&) const {}
};
__device__ __forceinline__ unsigned cvt_pk_bf16(float lo, float hi) { unsigned r; asm volatile("v_cvt_pk_bf16_f32 %0, %1, %2" : "=v"(r) : "v"(lo), "v"(hi)); return r; }
template <class Epi, class Sched, bool STAMP = false>
__device__ __forceinline__ void gemm_phase(PG8_LAS unsigned char* lds, const Gemm g, const Sched& S, const Epi& E, unsigned long long* stamps) {
    const int tid = tid_(), wid = __builtin_amdgcn_readfirstlane(tid >> 6), lane = tid & 63, wr = wid >> 2, wc = wid & 3, fr = lane & 15, fq = lane >> 4;
    const int K = g.K, nt = K / BK;
    int ts_lo = 0, ts_hi = 0, nts = 0; const unsigned long long rt_entry = STAMP ? (unsigned long long)wall_clock64() : 0ull;
#define PG8_STAMP() do { if (STAMP && wid == 0 && nts < 64) { const unsigned long long _c = (unsigned long long)clock64(); \
        ts_lo = (lane == nts) ? (int)(unsigned)_c : ts_lo; ts_hi = (lane == nts) ? (int)(unsigned)(_c >> 32) : ts_hi; ++nts; } } while (0)
    PG8_STAMP();
    unsigned voffA[2], voffB[2];
#pragma unroll
    for (int i = 0; i < 2; ++i) { int R, C; stage_rc(tid * 16 + i * 8192, R, C); const int Rb = Epi::PERM ? ((R & ~31) + perm32(R & 31)) : R;
        voffA[i] = (unsigned)(R * K + C) * 2u; voffB[i] = (unsigned)(Rb * K + C) * 2u; }
    const size_t kstep = (size_t)(BK * 2);
    const size_t hstep = (size_t)HALF * K * 2;
    const size_t tstep = 2 * hstep;
    const unsigned ldsw = (unsigned)wid * 1024u;
    const int aoff = lds_byte(wr * 64 + fr, fq * 8), boff = lds_byte(wc * 32 + fr, fq * 8);
#define PG8_SA(b, h) (((b) * 2 + (h)) * HTB)
#define PG8_SB(b, h) ((4 + (b) * 2 + (h)) * HTB)
#define PG8_STAGE(bufoff, gbase, voff) do { _Pragma("unroll") for (int _i = 0; _i < 2; ++_i) \
        __builtin_amdgcn_global_load_lds((const unsigned*)((const char*)(gbase) + (voff)[_i]), (PG8_LAS unsigned*)(lds + (bufoff) + ldsw + _i * 8192), 16, 0, 0); } while (0)
#define PG8_LDA(dst, b, h) do { _Pragma("unroll") for (int m = 0; m < 4; ++m) _Pragma("unroll") for (int k = 0; k < 2; ++k) dst[m][k] = *(const PG8_LAS bf16x8*)(lds + PG8_SA(b, h) + aoff + m * 2048 + k * 1024); } while (0)
#define PG8_LDB(dst, b, h) do { _Pragma("unroll") for (int n = 0; n < 2; ++n) _Pragma("unroll") for (int k = 0; k < 2; ++k) dst[n][k] = *(const PG8_LAS bf16x8*)(lds + PG8_SB(b, h) + boff + n * 2048 + k * 1024); } while (0)
#define PG8_MMA(ai, bj, At, Bt) do { __builtin_amdgcn_s_setprio(1); _Pragma("unroll") for (int m = 0; m < 4; ++m) _Pragma("unroll") for (int n = 0; n < 2; ++n) _Pragma("unroll") for (int k = 0; k < 2; ++k) \
        acc[ai][bj][m][n] = __builtin_amdgcn_mfma_f32_16x16x32_bf16(Bt[n][k], At[m][k], acc[ai][bj][m][n], 0, 0, 0); __builtin_amdgcn_s_setprio(0); } while (0)
#define PG8_WAIT_V(n) asm volatile("s_waitcnt vmcnt(" #n ")" ::: "memory")
#define PG8_WAIT_L(n) asm volatile("s_waitcnt lgkmcnt(" #n ")" ::: "memory")
#define PG8_BAR __builtin_amdgcn_s_barrier()
#define PG8_SCHED __builtin_amdgcn_sched_barrier(0)
    Unit cur, nxt; int ui = 0;
    if (!S.next(0, cur)) return;
    f32x4 acc[2][2][4][2];
#pragma unroll
    for (int a = 0; a < 2; ++a)
#pragma unroll
        for (int b = 0; b < 2; ++b)
#pragma unroll
            for (int m = 0; m < 4; ++m)
#pragma unroll
                for (int n = 0; n < 2; ++n) acc[a][b][m][n] = (f32x4){0.f, 0.f, 0.f, 0.f};
    bf16x8 At[4][2], B0[2][2], B1[2][2];
    const char* cA = (const char*)g.A + (size_t)cur.pm * tstep; const char* cB = (const char*)g.Bt + (size_t)cur.pn * tstep;
    S.a_ready(cur);
    PG8_STAGE(PG8_SB(0, 0), cB, voffB); PG8_STAGE(PG8_SA(0, 0), cA, voffA); PG8_STAGE(PG8_SB(0, 1), cB + hstep, voffB); PG8_STAGE(PG8_SA(0, 1), cA + hstep, voffA);
    if (wr == 1) PG8_BAR;
    PG8_WAIT_V(4); PG8_BAR;
    PG8_STAGE(PG8_SB(1, 0), cB + kstep, voffB); PG8_STAGE(PG8_SA(1, 0), cA + kstep, voffA); PG8_STAGE(PG8_SB(1, 1), cB + hstep + kstep, voffB);
    PG8_WAIT_V(6); PG8_BAR;
    PG8_STAMP();
    for (;;) {
        const bool has_next = S.next(ui + 1, nxt);
        const char* nA = has_next ? (const char*)g.A + (size_t)nxt.pm * tstep : cA; const char* nB = has_next ? (const char*)g.Bt + (size_t)nxt.pn * tstep : cB;
        for (int t = 0; t < nt; t += 2) {
            const bool last = (t == nt - 2);
            const char* a1 = cA + (size_t)(t + 1) * kstep;
            const char* a2 = last ? nA : cA + (size_t)(t + 2) * kstep; const char* b2 = last ? nB : cB + (size_t)(t + 2) * kstep;
            const char* a3 = a2 + kstep; const char* b3 = b2 + kstep;
            if (last && has_next) S.a_ready(nxt);
            PG8_LDB(B0, 0, 0); PG8_SCHED; PG8_LDA(At, 0, 0); PG8_STAGE(PG8_SA(1, 1), a1 + hstep, voffA);
            PG8_WAIT_L(8); PG8_BAR; PG8_WAIT_L(0); PG8_MMA(0, 0, At, B0); PG8_BAR; PG8_SCHED;
            PG8_LDB(B1, 0, 1); PG8_STAGE(PG8_SB(0, 0), b2, voffB);
            PG8_BAR; PG8_WAIT_L(0); PG8_MMA(0, 1, At, B1); PG8_BAR;
            PG8_LDA(At, 0, 1); PG8_STAGE(PG8_SA(0, 0), a2, voffA);
            PG8_BAR; PG8_WAIT_L(0); PG8_MMA(1, 0, At, B0); PG8_BAR; PG8_SCHED;
            PG8_STAGE(PG8_SB(0, 1), b2 + hstep, voffB);
            PG8_WAIT_V(6); PG8_BAR; PG8_MMA(1, 1, At, B1); PG8_BAR;
            PG8_LDB(B0, 1, 0); PG8_SCHED; PG8_LDA(At, 1, 0); PG8_STAGE(PG8_SA(0, 1), a2 + hstep, voffA);
            PG8_WAIT_L(8); PG8_BAR; PG8_WAIT_L(0); PG8_MMA(0, 0, At, B0); PG8_BAR; PG8_SCHED;
            PG8_LDB(B1, 1, 1); PG8_STAGE(PG8_SB(1, 0), b3, voffB);
            PG8_BAR; PG8_WAIT_L(0); PG8_MMA(0, 1, At, B1); PG8_BAR;
            PG8_LDA(At, 1, 1); PG8_STAGE(PG8_SA(1, 0), a3, voffA);
            PG8_BAR; PG8_WAIT_L(0); PG8_MMA(1, 0, At, B0); PG8_BAR; PG8_SCHED;
            PG8_STAGE(PG8_SB(1, 1), b3 + hstep, voffB);
            PG8_WAIT_V(6); PG8_BAR; PG8_MMA(1, 1, At, B1); PG8_BAR;
        }
        PG8_STAMP();
        if constexpr (!Epi::AFTER_DRAIN) { E(acc, cur, wr, wc, fr, fq); S.done(cur); }
        PG8_STAMP();
        if (!has_next) break;
#pragma unroll
        for (int a = 0; a < 2; ++a)
#pragma unroll
            for (int b = 0; b < 2; ++b)
#pragma unroll
                for (int m = 0; m < 4; ++m)
#pragma unroll
                    for (int n = 0; n < 2; ++n) acc[a][b][m][n] = (f32x4){0.f, 0.f, 0.f, 0.f};
        cur = nxt; cA = nA; cB = nB; ++ui;
    }
    PG8_WAIT_V(0);
    if (wr == 0) PG8_BAR;
    PG8_BAR;
    if constexpr (Epi::AFTER_DRAIN) { E.fused(acc, cur, wr, wc, fr, fq, lds, wid, lane); S.done(cur); }
    PG8_STAMP();
    if (STAMP && wid == 0) { stamps[lane] = lane < nts ? (((unsigned long long)(unsigned)ts_hi << 32) | (unsigned)ts_lo) : 0ull;
        if (lane == 62) stamps[62] = rt_entry; if (lane == 63) stamps[63] = (unsigned long long)wall_clock64(); }
#undef PG8_STAMP
#undef PG8_SA
#undef PG8_SB
#undef PG8_STAGE
#undef PG8_LDA
#undef PG8_LDB
#undef PG8_MMA
#undef PG8_WAIT_V
#undef PG8_WAIT_L
#undef PG8_BAR
#undef PG8_SCHED
}
}

DEV float fsig(float x) { return __builtin_amdgcn_rcpf(1.f + __expf(-x)); }
DEV u32x4 pack8(f32x4 a, f32x4 b) { u32x4 w; w.x = pg8::cvt_pk_bf16(a[0], a[1]); w.y = pg8::cvt_pk_bf16(a[2], a[3]); w.z = pg8::cvt_pk_bf16(b[0], b[1]); w.w = pg8::cvt_pk_bf16(b[2], b[3]); return w; }

DEV float row_rstd_q(const float* part, int row, int fq) {
    const f32x4 a = *(const f32x4*)(part + (size_t)row * 16 + fq * 4);
    float ss = (a[0] + a[1]) + (a[2] + a[3]);
    ss += __shfl_xor(ss, 16); ss += __shfl_xor(ss, 32);
    return rsqrtf(ss * (1.0f / 1024.0f) + 1e-6f);
}
struct EpiSwiglu {
    static constexpr bool PERM = true, AFTER_DRAIN = false;
    bf16_t* hid; const float* part;
    __device__ __forceinline__ void operator()(const f32x4 (&acc)[2][2][4][2], const pg8::Unit& u, int wr, int wc, int fr, int fq) const {
        float rsv[2][4];
#pragma unroll
        for (int ai = 0; ai < 2; ++ai)
#pragma unroll
            for (int m = 0; m < 4; ++m) rsv[ai][m] = row_rstd_q(part, u.pm * 256 + ai * 128 + wr * 64 + m * 16 + fr, fq);
#pragma unroll
        for (int ai = 0; ai < 2; ++ai)
#pragma unroll
            for (int m = 0; m < 4; ++m) {
                __builtin_amdgcn_sched_barrier(0);
                const int row = u.pm * 256 + ai * 128 + wr * 64 + m * 16 + fr;
                const float rs = rsv[ai][m];
                f32x4 o[2];
#pragma unroll
                for (int n = 0; n < 2; ++n)
#pragma unroll
                    for (int e = 0; e < 4; ++e) { const float g = acc[ai][0][m][n][e] * rs, up = acc[ai][1][m][n][e] * rs; o[n][e] = g * fsig(g) * up; }
                *(u32x4*)(hid + (size_t)row * DFF + u.pn * 128 + wc * 32 + fq * 8) = pack8(o[0], o[1]);
            }
    }
};
struct EpiResid {
    static constexpr bool PERM = true, AFTER_DRAIN = false;
    float* h; bf16_t* hb; float* part; float scale;
    __device__ __forceinline__ void operator()(const f32x4 (&acc)[2][2][4][2], const pg8::Unit& u, int wr, int wc, int fr, int fq) const {
#pragma unroll
        for (int ai = 0; ai < 2; ++ai) {
            __builtin_amdgcn_sched_barrier(0);
            f32x4 hv[4][2][2];
#pragma unroll
            for (int m = 0; m < 4; ++m)
#pragma unroll
                for (int bj = 0; bj < 2; ++bj) {
                    const float* hp = h + (size_t)(u.pm * 256 + ai * 128 + wr * 64 + m * 16 + fr) * DM + u.pn * 256 + bj * 128 + wc * 32 + fq * 8;
                    hv[m][bj][0] = *(const f32x4*)hp; hv[m][bj][1] = *(const f32x4*)(hp + 4);
                }
#pragma unroll
            for (int m = 0; m < 4; ++m) {
                const int row = u.pm * 256 + ai * 128 + wr * 64 + m * 16 + fr;
                float ss = 0.f;
#pragma unroll
                for (int bj = 0; bj < 2; ++bj) {
                    const int col = u.pn * 256 + bj * 128 + wc * 32 + fq * 8;
                    float* hp = h + (size_t)row * DM + col;
                    const f32x4 h0 = hv[m][bj][0] + acc[ai][bj][m][0] * scale, h1 = hv[m][bj][1] + acc[ai][bj][m][1] * scale;
                    *(f32x4*)hp = h0; *(f32x4*)(hp + 4) = h1;
                    *(u32x4*)(hb + (size_t)row * DM + col) = pack8(h0, h1);
                    ss += (h0[0] * h0[0] + h0[1] * h0[1]) + (h0[2] * h0[2] + h0[3] * h0[3]) + (h1[0] * h1[0] + h1[1] * h1[1]) + (h1[2] * h1[2] + h1[3] * h1[3]);
                }
                ss += __shfl_xor(ss, 16); ss += __shfl_xor(ss, 32);
                if (fq == 0) part[(size_t)row * 16 + u.pn * 4 + wc] = ss;
            }
        }
    }
};
struct EpiP {
    static constexpr bool PERM = true, AFTER_DRAIN = false;
    bf16_t* big; bf16_t* vt; const float* part;
    __device__ __forceinline__ void operator()(const f32x4 (&acc)[2][2][4][2], const pg8::Unit& u, int wr, int wc, int fr, int fq) const {
        float rsv[2][4];
#pragma unroll
        for (int ai = 0; ai < 2; ++ai)
#pragma unroll
            for (int m = 0; m < 4; ++m) rsv[ai][m] = row_rstd_q(part, u.pm * 256 + ai * 128 + wr * 64 + m * 16 + fr, fq);
#pragma unroll
        for (int ai = 0; ai < 2; ++ai)
#pragma unroll
            for (int m = 0; m < 4; ++m) {
                __builtin_amdgcn_sched_barrier(0);
                const int row = u.pm * 256 + ai * 128 + wr * 64 + m * 16 + fr;
                const float rs = rsv[ai][m];
#pragma unroll
                for (int bj = 0; bj < 2; ++bj) {
                    const int col = u.pn * 256 + bj * 128 + wc * 32 + fq * 8;
                    const f32x4 a0 = acc[ai][bj][m][0] * rs, a1 = acc[ai][bj][m][1] * rs;
                    const u32x4 w = pack8(a0, a1);
                    *(u32x4*)(big + (size_t)row * DIN + col) = w;
                    if (col >= C_V && row < MTOK) {
                        const int hh = (col - C_V) >> 6, d = (col - C_V) & 63;
                        int b, pos;
                        if (row < MMAIN) { b = row >> 11; pos = (row & 2047) + NMETA; } else { b = (row - MMAIN) >> 4; pos = (row - MMAIN) & 15; }
                        bf16_t* vp = vt + ((size_t)((b * 6 + hh) * 64 + d)) * LPV + pos;
#pragma unroll
                        for (int e = 0; e < 4; ++e) { vp[(size_t)(2 * e) * LPV] = (bf16_t)(w[e] & 0xFFFFu); vp[(size_t)(2 * e + 1) * LPV] = (bf16_t)(w[e] >> 16); }
                    }
                }
            }
    }
};
template <class Epi>
DEV void gemm_big(const bf16_t* A, const bf16_t* Bt, int M, int N, int K, const Epi& E, int bid, int nblk, unsigned char* smem) {
    pg8::StaticOrder S; S.init(M, N, nblk, bid);
    const pg8::Gemm g{A, Bt, M, N, K};
    pg8::gemm_phase<Epi, pg8::StaticOrder, false>((PG8_LAS unsigned char*)smem, g, S, E, nullptr);
}

DEV void phase_conv(CP& p, int l, int bid, int nblk, float* lds) {
    float* cS = lds;
    float* yS = lds + 46 * 256;
    const int tid = tid_(), ch = tid & 255, half = tid >> 8, lane = tid & 63, wave = tid >> 6;
    float wreg[31];
#pragma unroll
    for (int j = 0; j < 31; ++j) wreg[j] = p.conv_w[(size_t)l * 31 * 256 + j * 256 + ch];
    const float cb = p.conv_b[l * 256 + ch];
    for (int it = bid; it < NB * 129; it += nblk) {
        const int b = it / 129, p0 = (it % 129) * 16;
        __syncthreads();
#pragma unroll
        for (int q = 0; q < 3; ++q) {
            const int e = tid + q * 512;
            if (e < 46 * 32) {
                const int pp = e >> 5, c8 = (e & 31) * 8, pos = p0 - 30 + pp;
                f32x4 o0 = (f32x4){0.f, 0.f, 0.f, 0.f}, o1 = o0;
                if (pos >= 0) {
                    const bf16_t* rp = p.big + (size_t)row_of(b, pos) * DIN + c8;
                    const u32x4 vw = *(const u32x4*)rp, gw = *(const u32x4*)(rp + 256);
#pragma unroll
                    for (int j = 0; j < 2; ++j) {
                        o0[2 * j] = __uint_as_float(vw[j] << 16) * fsig(__uint_as_float(gw[j] << 16));
                        o0[2 * j + 1] = __uint_as_float(vw[j] & 0xFFFF0000u) * fsig(__uint_as_float(gw[j] & 0xFFFF0000u));
                        o1[2 * j] = __uint_as_float(vw[2 + j] << 16) * fsig(__uint_as_float(gw[2 + j] << 16));
                        o1[2 * j + 1] = __uint_as_float(vw[2 + j] & 0xFFFF0000u) * fsig(__uint_as_float(gw[2 + j] & 0xFFFF0000u));
                    }
                }
                *(f32x4*)(cS + pp * 256 + c8) = o0; *(f32x4*)(cS + pp * 256 + c8 + 4) = o1;
            }
        }
        __syncthreads();
#pragma unroll
        for (int i = 0; i < 8; ++i) {
            const int ii = half * 8 + i;
            float acc = cb;
#pragma unroll
            for (int j = 0; j < 31; ++j) acc += wreg[j] * cS[(ii + j) * 256 + ch];
            yS[ii * 256 + ch] = acc;
        }
        __syncthreads();
#pragma unroll
        for (int q = 0; q < 2; ++q) {
            const int ii = wave * 2 + q;
            const f32x4 v = *(const f32x4*)(yS + ii * 256 + lane * 4);
            const float mu = wave_sum_fast((v[0] + v[1]) + (v[2] + v[3])) * (1.f / 256.f);
            const f32x4 d = v - mu;
            const float var = wave_sum_fast(d[0] * d[0] + d[1] * d[1] + d[2] * d[2] + d[3] * d[3]) * (1.f / 256.f);
            const float rs = rsqrtf(var + 1e-5f);
            const f32x4 g = *(const f32x4*)(p.conv_ln_g + l * 256 + lane * 4), bb = *(const f32x4*)(p.conv_ln_b + l * 256 + lane * 4);
            float o[4];
#pragma unroll
            for (int e = 0; e < 4; ++e) { const float yn = d[e] * rs * g[e] + bb[e]; o[e] = yn * sigm(yn); }
            u32x2 w; w.x = pack2(o[0], o[1]); w.y = pack2(o[2], o[3]);
            *(u32x2*)(p.y + (size_t)row_of(b, p0 + ii) * DM + lane * 4) = w;
        }
    }
}

constexpr int PK_AN = 0, PK_RM = 3072, PK_TT = 6144, PK_KB = 7168, PK_VT = 11264, PK_GT = 13312, PK_GC = 15360, PK_CT = 15616, PK_BYTES = 15680;
DEV u32x4 pack8f(const float* x) { u32x4 w; w.x = cvt2(x[0], x[1]); w.y = cvt2(x[2], x[3]); w.z = cvt2(x[4], x[5]); w.w = cvt2(x[6], x[7]); return w; }
DEV void rwkv_pack_item(CP& p, int l, int r0, int hh, unsigned char* scr) {
    const int lane = tid_() & 63, fr = lane & 15, fq = lane >> 4, hc = hh * 64 + lane;
    int b, pos0;
    if (r0 < MMAIN) { b = r0 >> 11; pos0 = (r0 & 2047) + NMETA; } else { b = (r0 - MMAIN) >> 4; pos0 = 0; }
    unsigned char* pk = p.pack + (size_t)((b * 6 + hh) * 129 + (pos0 >> 4)) * PK_BYTES;
    bf16_t* sA = (bf16_t*)scr; bf16_t* sR = sA + 16 * 72; bf16_t* sB = sR + 16 * 72; bf16_t* sK = sB + 16 * 72;
    float* sN = (float*)(scr + 4 * 2304);
    const float* mu = p.rwkv_mu + (size_t)l * 1408;
    const float mr = mu[hc], mk = mu[384 + hc], mv = mu[768 + hc];
    const float kkw = p.rwkv_kk[l * DRW + hc], kaw = p.rwkv_ka[l * DRW + hc];
    float pr = 0.f, pkk = 0.f, pv = 0.f;
    if (pos0 > 0) { const bf16_t* q = p.big + (size_t)row_of(b, pos0 - 1) * DIN + C_RW + hc; pr = bf2f(q[0]); pkk = bf2f(q[384]); pv = bf2f(q[768]); }
    float bt[16], kt[16], vv[16], gv[16];
    float lg = 0.f;
#pragma unroll
    for (int hf = 0; hf < 2; ++hf) {
        unsigned short r0w[8], k0w[8], v0w[8], gw[8]; float lww[8], inw[8], aaw[8];
#pragma unroll
        for (int u = 0; u < 8; ++u) {
            const int row = r0 + hf * 8 + u;
            const bf16_t* q = p.big + (size_t)row * DIN + C_RW + hc;
            r0w[u] = q[0]; k0w[u] = q[384]; v0w[u] = q[768];
            lww[u] = p.lw[(size_t)row * DRW + hc]; gw[u] = p.gg16[(size_t)row * DRW + hc]; inw[u] = p.inorm[(size_t)row * 8 + hh]; aaw[u] = p.aa[(size_t)row * DRW + hc];
        }
#pragma unroll
        for (int u = 0; u < 8; ++u) {
            const int t = hf * 8 + u;
            const float r0v = bf2f(r0w[u]), k0v = bf2f(k0w[u]), v0v = bf2f(v0w[u]);
            const float r = r0v + mr * (pr - r0v), k = k0v + mk * (pkk - k0v), v = v0v + mv * (pv - v0v);
            pr = r0v; pkk = k0v; pv = v0v;
            const float a = aaw[u], lwv = lww[u];
            const float kk = k * kkw * inw[u];
            const float kp = k * (1.f + (a - 1.f) * kaw);
            const float gprev = __expf(lg);
            lg += lwv;
            const float gcur = __expf(lg), ginv = __expf(-lg);
            const float at = -kk * gprev, rt = r * gcur;
            bt[t] = kk * a * ginv; kt[t] = kp * ginv; vv[t] = v; gv[t] = bf2f(gw[u]);
            const bf16_t ab = f2bf(at), rb = f2bf(rt);
            ((bf16_t*)(pk + PK_AN))[t * 96 + lane] = ab; ((bf16_t*)(pk + PK_RM))[t * 96 + lane] = rb;
            sA[t * 72 + lane] = ab; sR[t * 72 + lane] = rb; sB[t * 72 + lane] = f2bf(bt[t]); sK[t * 72 + lane] = f2bf(kt[t]);
        }
    }
    ((float*)(pk + PK_GC))[lane] = __expf(lg);
    if (lane < 16) ((float*)(pk + PK_CT))[lane] = p.ct[(size_t)(r0 + lane) * 8 + hh];
    { u32x4* d = (u32x4*)(pk + PK_KB + lane * 64); d[0] = pack8f(kt); d[1] = pack8f(kt + 8); d[2] = pack8f(bt); d[3] = pack8f(bt + 8); }
    { u32x4* d = (u32x4*)(pk + PK_VT + lane * 32); d[0] = pack8f(vv); d[1] = pack8f(vv + 8); }
    { u32x4* d = (u32x4*)(pk + PK_GT + lane * 32); d[0] = pack8f(gv); d[1] = pack8f(gv + 8); }
    f32x4 nab = (f32x4){0.f, 0.f, 0.f, 0.f}, nak = nab, mrb = nab, mrk = nab;
#pragma unroll
    for (int ks = 0; ks < 2; ++ks) {
        const bf16x8 fb = *(const bf16x8*)(sB + fr * 72 + ks * 32 + fq * 8), fk = *(const bf16x8*)(sK + fr * 72 + ks * 32 + fq * 8);
        const bf16x8 fa = *(const bf16x8*)(sA + fr * 72 + ks * 32 + fq * 8), fc = *(const bf16x8*)(sR + fr * 72 + ks * 32 + fq * 8);
        nab = __builtin_amdgcn_mfma_f32_16x16x32_bf16(fb, fa, nab, 0, 0, 0);
        nak = __builtin_amdgcn_mfma_f32_16x16x32_bf16(fk, fa, nak, 0, 0, 0);
        mrb = __builtin_amdgcn_mfma_f32_16x16x32_bf16(fb, fc, mrb, 0, 0, 0);
        mrk = __builtin_amdgcn_mfma_f32_16x16x32_bf16(fk, fc, mrk, 0, 0, 0);
    }
#pragma unroll
    for (int i = 0; i < 4; ++i) {
        const int j = 4 * fq + i;
        if (!(j < fr)) { nab[i] = 0.f; nak[i] = 0.f; }
        if (!(j <= fr)) { mrb[i] = 0.f; mrk[i] = 0.f; }
        sN[j * 16 + fr] = nab[i];
    }
    { u32x2 w; w.x = cvt2(nak[0], nak[1]); w.y = cvt2(nak[2], nak[3]); *(u32x2*)(pk + PK_AN + fr * 192 + (64 + 4 * fq) * 2) = w; *(u32x2*)(pk + PK_AN + fr * 192 + (80 + 4 * fq) * 2) = (u32x2){0u, 0u}; }
    { u32x2 w; w.x = cvt2(mrk[0], mrk[1]); w.y = cvt2(mrk[2], mrk[3]); *(u32x2*)(pk + PK_RM + fr * 192 + (64 + 4 * fq) * 2) = w; }
    { u32x2 w; w.x = cvt2(mrb[0], mrb[1]); w.y = cvt2(mrb[2], mrb[3]); *(u32x2*)(pk + PK_RM + fr * 192 + (80 + 4 * fq) * 2) = w; }
    {
        const int c = lane & 15;
        float x[16];
#pragma unroll
        for (int j = 0; j < 16; ++j) x[j] = (j == c) ? 1.f : 0.f;
#pragma unroll
        for (int j = 14; j >= 0; --j) {
            float acc = 0.f;
#pragma unroll
            for (int t = j + 1; t < 16; ++t) acc += sN[j * 16 + t] * x[t];
            x[j] = (j < c) ? acc : x[j];
        }
        if (lane < 16) { u32x4* d = (u32x4*)(pk + PK_TT + c * 64); d[0] = pack8f(x); d[1] = pack8f(x + 8); d[2] = (u32x4){0u, 0u, 0u, 0u}; d[3] = (u32x4){0u, 0u, 0u, 0u}; }
    }
}

DEV void phase_rwkv_prep(CP& p, int l, int bid, int nblk, float* lds) {
    bf16_t* X = (bf16_t*)lds;
    constexpr int XS = 264;
    const int tid = tid_(), lane = tid & 63, wave = tid >> 6, fr = lane & 15, fq = lane >> 4;
    const float* mu = p.rwkv_mu + (size_t)l * 1408;
    for (int it = bid; it < MTOK / 64; it += nblk) {
        __syncthreads();
        {
            const int rr = tid >> 3, c0 = (tid & 7) * 32, row = it * 64 + rr;
            int b, pos;
            if (row < MMAIN) { b = row >> 11; pos = (row & 2047) + NMETA; } else { b = (row - MMAIN) >> 4; pos = (row - MMAIN) & 15; }
            const bf16_t* cp = p.big + (size_t)row * DIN + C_RW + 1152 + c0;
            const bf16_t* pp = p.big + (size_t)row_of(b, pos > 0 ? pos - 1 : 0) * DIN + C_RW + 1152 + c0;
#pragma unroll
            for (int q = 0; q < 4; ++q) {
                const u32x4 cw = *(const u32x4*)(cp + q * 8);
                u32x4 pw = *(const u32x4*)(pp + q * 8);
                if (pos == 0) pw = (u32x4){0u, 0u, 0u, 0u};
                const int c = c0 + q * 8;
                const f32x4 m0 = *(const f32x4*)(mu + 1152 + c), m1 = *(const f32x4*)(mu + 1152 + c + 4);
                float xs[8];
#pragma unroll
                for (int j = 0; j < 4; ++j) {
                    const float a0 = __uint_as_float(cw[j] << 16), a1 = __uint_as_float(cw[j] & 0xFFFF0000u);
                    const float q0 = __uint_as_float(pw[j] << 16), q1 = __uint_as_float(pw[j] & 0xFFFF0000u);
                    const float ma = j < 2 ? m0[2 * j] : m1[2 * j - 4], mb = j < 2 ? m0[2 * j + 1] : m1[2 * j - 3];
                    xs[2 * j] = a0 + ma * (q0 - a0); xs[2 * j + 1] = a1 + mb * (q1 - a1);
                }
#pragma unroll
                for (int j = 0; j < 8; ++j) { if (c < 64) xs[j] = tanhf(xs[j]); else if (c >= 128) xs[j] = fsig(xs[j]); }
                u32x4 w; w.x = cvt2(xs[0], xs[1]); w.y = cvt2(xs[2], xs[3]); w.z = cvt2(xs[4], xs[5]); w.w = cvt2(xs[6], xs[7]);
                *(u32x4*)(X + rr * XS + c) = w;
            }
        }
        __syncthreads();
        const int rt = wave & 3, chalf = wave >> 2;
        bf16x8 af[8];
#pragma unroll
        for (int ks = 0; ks < 8; ++ks) af[ks] = *(const bf16x8*)(X + (rt * 16 + fr) * XS + ks * 32 + fq * 8);
        const int row = it * 64 + rt * 16 + fr;
        int prow; bool has_prev;
        {
            int b, pos;
            if (row < MMAIN) { b = row >> 11; pos = (row & 2047) + NMETA; } else { b = (row - MMAIN) >> 4; pos = (row - MMAIN) & 15; }
            has_prev = pos > 0; prow = row_of(b, has_prev ? pos - 1 : 0);
        }
        float ssq = 0.f, ctp = 0.f;
        for (int nt = chalf * 12; nt < chalf * 12 + 12; ++nt) {
            const bf16_t* wb = p.Wl + (size_t)(nt * 16 + fr) * 64 + fq * 8;
            const bf16_t* ab = p.Wl + DRW * 64 + (size_t)(nt * 16 + fr) * 64 + fq * 8;
            const bf16_t* gb = p.Wl + DRW * 128 + (size_t)(nt * 16 + fr) * 128 + fq * 8;
            f32x4 cw = (f32x4){0.f, 0.f, 0.f, 0.f}, ca = cw, cg = cw;
#pragma unroll
            for (int ks = 0; ks < 2; ++ks) {
                cw = __builtin_amdgcn_mfma_f32_16x16x32_bf16(*(const bf16x8*)(wb + ks * 32), af[ks], cw, 0, 0, 0);
                ca = __builtin_amdgcn_mfma_f32_16x16x32_bf16(*(const bf16x8*)(ab + ks * 32), af[2 + ks], ca, 0, 0, 0);
            }
#pragma unroll
            for (int ks = 0; ks < 4; ++ks) cg = __builtin_amdgcn_mfma_f32_16x16x32_bf16(*(const bf16x8*)(gb + ks * 32), af[4 + ks], cg, 0, 0, 0);
            const int col = nt * 16 + 4 * fq;
            const f32x4 w0 = *(const f32x4*)(p.rwkv_w0 + l * DRW + col), a0 = *(const f32x4*)(p.rwkv_a0 + l * DRW + col);
            f32x4 olw, oaa;
#pragma unroll
            for (int j = 0; j < 4; ++j) {
                const float xw = -(w0[j] + cw[j]);
                const float sp = fmaxf(xw, 0.f) + __logf(1.f + __expf(-fabsf(xw)));
                olw[j] = -__expf(-sp - 0.5f);
                oaa[j] = fsig(a0[j] + ca[j]);
            }
            const size_t o = (size_t)row * DRW + col;
            *(f32x4*)(p.lw + o) = olw; *(f32x4*)(p.aa + o) = oaa; { u32x2 gw; gw.x = cvt2(cg[0], cg[1]); gw.y = cvt2(cg[2], cg[3]); *(u32x2*)(p.gg16 + o) = gw; }
            {
                const u32x2 rc = *(const u32x2*)(p.big + (size_t)row * DIN + C_RW + col), kc = *(const u32x2*)(p.big + (size_t)row * DIN + C_RW + 384 + col);
                u32x2 rp = *(const u32x2*)(p.big + (size_t)prow * DIN + C_RW + col), kq = *(const u32x2*)(p.big + (size_t)prow * DIN + C_RW + 384 + col);
                if (!has_prev) { rp = (u32x2){0u, 0u}; kq = (u32x2){0u, 0u}; }
                const f32x4 mr4 = *(const f32x4*)(mu + col), mk4 = *(const f32x4*)(mu + 384 + col);
                const f32x4 kk4 = *(const f32x4*)(p.rwkv_kk + l * DRW + col), ka4 = *(const f32x4*)(p.rwkv_ka + l * DRW + col), rk4 = *(const f32x4*)(p.rwkv_rk + l * DRW + col);
#pragma unroll
                for (int j = 0; j < 4; ++j) {
                    const unsigned rcw = rc[j >> 1], kcw = kc[j >> 1], rpw = rp[j >> 1], kpw = kq[j >> 1];
                    const float r0 = (j & 1) ? __uint_as_float(rcw & 0xFFFF0000u) : __uint_as_float(rcw << 16);
                    const float k0 = (j & 1) ? __uint_as_float(kcw & 0xFFFF0000u) : __uint_as_float(kcw << 16);
                    const float r1 = (j & 1) ? __uint_as_float(rpw & 0xFFFF0000u) : __uint_as_float(rpw << 16);
                    const float k1 = (j & 1) ? __uint_as_float(kpw & 0xFFFF0000u) : __uint_as_float(kpw << 16);
                    const float r = r0 + mr4[j] * (r1 - r0), k = k0 + mk4[j] * (k1 - k0);
                    const float kkr = k * kk4[j];
                    ssq += kkr * kkr;
                    ctp += r * (k * (1.f + (oaa[j] - 1.f) * ka4[j])) * rk4[j];
                }
                if ((nt & 3) == 3) {
                    ssq += __shfl_xor(ssq, 16); ssq += __shfl_xor(ssq, 32);
                    ctp += __shfl_xor(ctp, 16); ctp += __shfl_xor(ctp, 32);
                    if (fq == 0) { p.inorm[(size_t)row * 8 + (nt >> 2)] = __builtin_amdgcn_rsqf(fmaxf(ssq, 1e-24f)); p.ct[(size_t)row * 8 + (nt >> 2)] = ctp; }
                    ssq = 0.f; ctp = 0.f;
                }
            }
        }
    }
}
DEV void phase_rwkv_pack(CP& p, int l, int bid, int nblk, unsigned char* lds) {
    const int wave = tid_() >> 6;
    for (int it = bid * 8 + wave; it < (MTOK / 16) * 6; it += nblk * 8) rwkv_pack_item(p, l, (it / 6) * 16, it % 6, lds + wave * 10240);
}

constexpr int P2_BUF = 4 * PK_BYTES, P2_SUV = 2 * P2_BUF, P2_GB = P2_SUV + 4 * 3328, P2_ST = P2_GB + 4 * 1280;
DEV void phase_rwkv_chunk(CP& p, int l, int item, unsigned char* lds) {
    const int tid = tid_(), lane = tid & 63, wave = tid >> 6, fr = lane & 15, fq = lane >> 4;
    const int b = item / 6, hh = item % 6;
    const unsigned char* gpk = p.pack + (size_t)(item * 129) * PK_BYTES;
    constexpr int NSC = 33;
    if (wave >= 4) {
        const int lt = tid - 256;
        u32x4 ra[16], rb[16];
#define P2_ISSUE(R, SC) { const int nb_ = (((SC) * 4 + 4 <= 129) ? 4 : 1) * (PK_BYTES / 16); const u32x4* src_ = (const u32x4*)(gpk + (size_t)(SC) * P2_BUF); \
        _Pragma("unroll") for (int q = 0; q < 16; ++q) { const int ci = lt + q * 256; if (ci < nb_) R[q] = src_[ci]; } }
#define P2_WRITE(R, SC) { const int nb_ = (((SC) * 4 + 4 <= 129) ? 4 : 1) * (PK_BYTES / 16); u32x4* dst_ = (u32x4*)(lds + ((SC) & 1) * P2_BUF); \
        _Pragma("unroll") for (int q = 0; q < 16; ++q) { const int ci = lt + q * 256; if (ci < nb_) dst_[ci] = R[q]; } }
        P2_ISSUE(ra, 0); P2_ISSUE(rb, 1); P2_WRITE(ra, 0); P2_ISSUE(ra, 2);
        __syncthreads();
        for (int sc = 0; sc < NSC; sc += 2) {
            if (sc + 1 < NSC) { P2_WRITE(rb, sc + 1); if (sc + 3 < NSC) P2_ISSUE(rb, sc + 3); }
            __syncthreads();
            if (sc + 1 < NSC) {
                if (sc + 2 < NSC) { P2_WRITE(ra, sc + 2); if (sc + 4 < NSC) P2_ISSUE(ra, sc + 4); }
                __syncthreads();
            }
        }
#undef P2_ISSUE
#undef P2_WRITE
    } else {
        unsigned char* suv = lds + P2_SUV + wave * 3328;
        unsigned char* gb = lds + P2_GB + wave * 1280;
        float* stats = (float*)(lds + P2_ST);
        for (int i = lane; i < 3328 / 4; i += 64) ((unsigned*)suv)[i] = 0u;
        for (int i = lane; i < 1280 / 4; i += 64) ((unsigned*)gb)[i] = 0u;
        f32x4 ST[4];
#pragma unroll
        for (int mt = 0; mt < 4; ++mt) ST[mt] = (f32x4){0.f, 0.f, 0.f, 0.f};
        const int vrow = wave * 16 + fr;
        const float lng = p.rwkv_ln_g[l * DRW + hh * 64 + vrow], lnb = p.rwkv_ln_b[l * DRW + hh * 64 + vrow];
        f32x4 Osv[4], ctsv[4]; u32x2 vsv[4], gsv[4];
        __syncthreads();
        auto deferred = [&](int ps) {
                const int nch = (ps * 4 + 4 <= 129) ? 4 : 1;
#pragma unroll
                for (int ch = 0; ch < 4; ++ch) if (ch < nch) {
                    const int cidx = ps * 4 + ch;
                    const float* stp = stats + (((ps & 1) * 4 + ch) * 4) * 32;
#pragma unroll
                    for (int i = 0; i < 4; ++i) {
                        const int t = 4 * fq + i;
                        float s1 = 0.f, s2 = 0.f;
#pragma unroll
                        for (int w = 0; w < 4; ++w) { s1 += stp[w * 32 + t * 2]; s2 += stp[w * 32 + t * 2 + 1]; }
                        const float m = s1 * (1.f / 64.f), var = fmaxf(s2 * (1.f / 64.f) - m * m, 0.f);
                        const unsigned vw = vsv[ch][i >> 1], gw = gsv[ch][i >> 1];
                        const float vval = (i & 1) ? __uint_as_float(vw & 0xFFFF0000u) : __uint_as_float(vw << 16);
                        const float gval = (i & 1) ? __uint_as_float(gw & 0xFFFF0000u) : __uint_as_float(gw << 16);
                        float yv = (Osv[ch][i] - m) * rsqrtf(var + 64e-5f) * lng + lnb;
                        yv = (yv + ctsv[ch][i] * vval) * gval;
                        const int row = cidx == 0 ? MMAIN + b * NMETA + t : b * SEQ + cidx * 16 - NMETA + t;
                        p.y[(size_t)row * DM + 256 + hh * 64 + vrow] = f2bf(yv);
                    }
                }
        };
        for (int sc = 0; sc < NSC; ++sc) {
            if (sc > 0) deferred(sc - 1);
            {
                const int nch = (sc * 4 + 4 <= 129) ? 4 : 1;
#pragma unroll
                for (int ch = 0; ch < 4; ++ch) if (ch < nch) {
                    const unsigned char* pk = lds + (sc & 1) * P2_BUF + ch * PK_BYTES;
#pragma unroll
                    for (int mt = 0; mt < 4; ++mt) { u32x2 w; w.x = cvt2(ST[mt][0], ST[mt][1]); w.y = cvt2(ST[mt][2], ST[mt][3]); *(u32x2*)(suv + fr * 208 + (16 * mt + 4 * fq) * 2) = w; }
                    vsv[ch] = *(const u32x2*)(pk + PK_VT + vrow * 32 + 4 * fq * 2);
                    gsv[ch] = *(const u32x2*)(pk + PK_GT + vrow * 32 + 4 * fq * 2);
                    ctsv[ch] = *(const f32x4*)(pk + PK_CT + 4 * fq * 4);
                    *(u32x2*)(suv + fr * 208 + (64 + 4 * fq) * 2) = vsv[ch];
                    bf16x8 bs[3];
                    f32x4 G = (f32x4){0.f, 0.f, 0.f, 0.f};
#pragma unroll
                    for (int ks = 0; ks < 3; ++ks) {
                        bs[ks] = *(const bf16x8*)(suv + fr * 208 + (32 * ks + 8 * fq) * 2);
                        G = __builtin_amdgcn_mfma_f32_16x16x32_bf16(*(const bf16x8*)(pk + PK_AN + fr * 192 + (32 * ks + 8 * fq) * 2), bs[ks], G, 0, 0, 0);
                    }
                    { u32x2 w; w.x = cvt2(G[0], G[1]); w.y = cvt2(G[2], G[3]); *(u32x2*)(gb + fr * 80 + 4 * fq * 2) = w; }
                    f32x4 U = __builtin_amdgcn_mfma_f32_16x16x32_bf16(*(const bf16x8*)(pk + PK_TT + fr * 64 + 8 * fq * 2), *(const bf16x8*)(gb + fr * 80 + 8 * fq * 2), (f32x4){0.f, 0.f, 0.f, 0.f}, 0, 0, 0);
                    { u32x2 w; w.x = cvt2(U[0], U[1]); w.y = cvt2(U[2], U[3]); *(u32x2*)(suv + fr * 208 + (80 + 4 * fq) * 2) = w; }
                    const bf16x8 bvu = *(const bf16x8*)(suv + fr * 208 + (64 + 8 * fq) * 2);
                    f32x4 O = (f32x4){0.f, 0.f, 0.f, 0.f};
                    O = __builtin_amdgcn_mfma_f32_16x16x32_bf16(*(const bf16x8*)(pk + PK_RM + fr * 192 + (8 * fq) * 2), bs[0], O, 0, 0, 0);
                    O = __builtin_amdgcn_mfma_f32_16x16x32_bf16(*(const bf16x8*)(pk + PK_RM + fr * 192 + (32 + 8 * fq) * 2), bs[1], O, 0, 0, 0);
                    O = __builtin_amdgcn_mfma_f32_16x16x32_bf16(*(const bf16x8*)(pk + PK_RM + fr * 192 + (64 + 8 * fq) * 2), bvu, O, 0, 0, 0);
#pragma unroll
                    for (int mt = 0; mt < 4; ++mt) {
                        ST[mt] = __builtin_amdgcn_mfma_f32_16x16x32_bf16(*(const bf16x8*)(pk + PK_KB + (16 * mt + fr) * 64 + 8 * fq * 2), bvu, ST[mt], 0, 0, 0);
                        ST[mt] *= *(const f32x4*)(pk + PK_GC + (16 * mt + 4 * fq) * 4);
                    }
                    Osv[ch] = O;
                    float* stp = stats + (((sc & 1) * 4 + ch) * 4 + wave) * 32;
#pragma unroll
                    for (int i = 0; i < 4; ++i) {
                        const float s1 = dpp_sum16(O[i]), s2 = dpp_sum16(O[i] * O[i]);
                        if (fr == 0) { stp[(4 * fq + i) * 2] = s1; stp[(4 * fq + i) * 2 + 1] = s2; }
                    }
                }
            }
            __syncthreads();
        }
        deferred(NSC - 1);
    }
}

DEV void phase_pack_prefetch(CP& p, int item) {
    const u32x4* src = (const u32x4*)(p.pack + (size_t)(item * 129) * PK_BYTES);
    const int n = 129 * (PK_BYTES / 16), tid = tid_();
    u32x4 acc = (u32x4){0u, 0u, 0u, 0u};
    for (int i = tid; i < n; i += 512 * 4) {
        u32x4 a = src[i], b = (i + 512 < n) ? src[i + 512] : acc, c = (i + 1024 < n) ? src[i + 1024] : acc, d = (i + 1536 < n) ? src[i + 1536] : acc;
        acc ^= a; acc ^= b; acc ^= c; acc ^= d;
    }
    asm volatile("" :: "v"(acc.x), "v"(acc.y), "v"(acc.z), "v"(acc.w));
}
DEV void phase_sb_mfma(CP& p, int l, int bid, int nblk) {
    const int tid = tid_(), lane = tid & 63, wave = tid >> 6, r = lane & 31, h = lane >> 5;
    for (int it = bid * 8 + wave; it < NB * 6 * 65; it += nblk * 8) {
        const int qt = it % 65, bh = it / 65, b = bh / 6, hh = bh % 6;
        const int q0 = qt * 32, t = q0 + r;
        const bool valid = t < LT;
        const int myrow = row_of(b, valid ? t : LT - 1);
        bf16x8 qf[4];
        {
            const bf16_t* qp = p.big + (size_t)myrow * DIN + C_Q + hh * 64 + 8 * h;
#pragma unroll
            for (int ks = 0; ks < 4; ++ks) qf[ks] = *(const bf16x8*)(qp + 16 * ks);
        }
        f32x16 o0, o1;
#pragma unroll
        for (int i = 0; i < 16; ++i) { o0[i] = 0.f; o1[i] = 0.f; }
        float carry = 0.f;
        const bf16_t* vbase = p.vt + (size_t)((b * 6 + hh) * 64 + r) * LPV + 4 * h;
        bf16x8 kf[4];
        {
            const bf16_t* kp = p.big + (size_t)row_of(b, q0 + r) * DIN + C_K + hh * 64 + 8 * h;
#pragma unroll
            for (int ks = 0; ks < 4; ++ks) kf[ks] = *(const bf16x8*)(kp + 16 * ks);
        }
        for (int k0 = q0; k0 >= 0; k0 -= 32) {
            bf16x8 vf[2][2];
#pragma unroll
            for (int db = 0; db < 2; ++db)
#pragma unroll
                for (int s = 0; s < 2; ++s) {
                    const bf16_t* vp = vbase + (size_t)(db * 32) * LPV + k0 + 16 * s;
                    const s16x4 lo = *(const s16x4*)vp, hi = *(const s16x4*)(vp + 8);
                    vf[db][s] = __builtin_shufflevector(lo, hi, 0, 1, 2, 3, 4, 5, 6, 7);
                }
            bf16x8 kn[4];
            {
                const int kpos = k0 >= 32 ? k0 - 32 + r : r;
                const bf16_t* kp = p.big + (size_t)row_of(b, kpos) * DIN + C_K + hh * 64 + 8 * h;
#pragma unroll
                for (int ks = 0; ks < 4; ++ks) kn[ks] = *(const bf16x8*)(kp + 16 * ks);
            }
            f32x16 x;
#pragma unroll
            for (int i = 0; i < 16; ++i) x[i] = 0.f;
#pragma unroll
            for (int ks = 0; ks < 4; ++ks) x = __builtin_amdgcn_mfma_f32_32x32x16_bf16(kf[ks], qf[ks], x, 0, 0, 0);
            float lr[16], ls[16];
#pragma unroll
            for (int i = 0; i < 16; ++i) {
                const int key = k0 + (i & 3) + 8 * (i >> 2) + 4 * h;
                const float z = x[i] * 0.125f;
                const float sp = __logf(1.f + __expf(-fabsf(z)));
                const float lsi = fminf(z, 0.f) - sp;
                ls[i] = lsi;
                lr[i] = key < t ? lsi - z : 0.f;
            }
            float pw[16];
            float run = carry;
#pragma unroll
            for (int g = 3; g >= 0; --g) {
                const float G = (lr[4 * g] + lr[4 * g + 1]) + (lr[4 * g + 2] + lr[4 * g + 3]);
                const float Gp = __shfl_xor(G, 32);
                const float s3 = run + (h == 0 ? Gp : 0.f);
                const float s2 = s3 + lr[4 * g + 3], s1 = s2 + lr[4 * g + 2], s0 = s1 + lr[4 * g + 1];
                const int keyb = k0 + 8 * g + 4 * h;
                pw[4 * g + 3] = keyb + 3 < t ? __expf(ls[4 * g + 3] + s3) : 0.f;
                pw[4 * g + 2] = keyb + 2 < t ? __expf(ls[4 * g + 2] + s2) : 0.f;
                pw[4 * g + 1] = keyb + 1 < t ? __expf(ls[4 * g + 1] + s1) : 0.f;
                pw[4 * g + 0] = keyb + 0 < t ? __expf(ls[4 * g + 0] + s0) : 0.f;
                run += G + Gp;
            }
            carry = run;
            const bf16x8 pf0 = pack_frag(pw[0], pw[1], pw[2], pw[3], pw[4], pw[5], pw[6], pw[7]);
            const bf16x8 pf1 = pack_frag(pw[8], pw[9], pw[10], pw[11], pw[12], pw[13], pw[14], pw[15]);
            o0 = __builtin_amdgcn_mfma_f32_32x32x16_bf16(vf[0][0], pf0, o0, 0, 0, 0);
            o0 = __builtin_amdgcn_mfma_f32_32x32x16_bf16(vf[0][1], pf1, o0, 0, 0, 0);
            o1 = __builtin_amdgcn_mfma_f32_32x32x16_bf16(vf[1][0], pf0, o1, 0, 0, 0);
            o1 = __builtin_amdgcn_mfma_f32_32x32x16_bf16(vf[1][1], pf1, o1, 0, 0, 0);
#pragma unroll
            for (int ks = 0; ks < 4; ++ks) kf[ks] = kn[ks];
            if (__all((!valid || carry < -110.f) ? 1 : 0)) break;
        }
        float ss = 0.f;
#pragma unroll
        for (int i = 0; i < 16; ++i) ss += o0[i] * o0[i] + o1[i] * o1[i];
        ss += __shfl_xor(ss, 32);
        const float rs = rsqrtf(ss * (1.f / 64.f) + 1e-6f);
        if (valid) {
            const float* g = p.sb_norm + l * 384 + hh * 64 + 4 * h;
            bf16_t* yp = p.y + (size_t)myrow * DM + 640 + hh * 64 + 4 * h;
#pragma unroll
            for (int gq = 0; gq < 4; ++gq) {
                const f32x4 g0 = *(const f32x4*)(g + 8 * gq), g1 = *(const f32x4*)(g + 32 + 8 * gq);
                u32x2 w0, w1;
                w0.x = cvt2(o0[4 * gq] * rs * g0[0], o0[4 * gq + 1] * rs * g0[1]); w0.y = cvt2(o0[4 * gq + 2] * rs * g0[2], o0[4 * gq + 3] * rs * g0[3]);
                w1.x = cvt2(o1[4 * gq] * rs * g1[0], o1[4 * gq + 1] * rs * g1[1]); w1.y = cvt2(o1[4 * gq + 2] * rs * g1[2], o1[4 * gq + 3] * rs * g1[3]);
                *(u32x2*)(yp + 8 * gq) = w0;
                *(u32x2*)(yp + 32 + 8 * gq) = w1;
            }
        }
    }
}

DEV void phase_final(CP& p, int bid, int nblk) {
    const int lane = tid_() & 63, wave = tid_() >> 6;
    for (int r = bid * 8 + wave; r < MMAIN; r += nblk * 8) {
        const float rs = row_rstd(p.part, r);
#pragma unroll
        for (int i = 0; i < 4; ++i) {
            const int c = (i * 64 + lane) * 4;
            const f32x4 v = *(const f32x4*)(p.h + (size_t)r * DM + c), g = *(const f32x4*)(p.final_norm + c);
            *(f32x4*)(p.out + (size_t)r * DM + c) = v * rs * g;
        }
    }
}

#define XB_TMO      128
#define XB_XCNT(j)  (256  + 64 * (j))
#define XB_XSUB(j)  (1280 + 64 * (j))
#define XB_XGEN(j)  (2304 + 64 * (j))
#define XB_TOP      3328
#define XB_TOPGEN   3392
#define XCD_BAR_WORDS 3456
#define XB_SPIN_CAP (1u << 18)
#define XB_LAS __attribute__((address_space(3)))

__device__ __forceinline__ unsigned xb_ld(unsigned* p)              { return __hip_atomic_load(p, __ATOMIC_RELAXED, __HIP_MEMORY_SCOPE_AGENT); }
__device__ __forceinline__ unsigned xb_add(unsigned* p, unsigned v) { return __hip_atomic_fetch_add(p, v, __ATOMIC_RELAXED, __HIP_MEMORY_SCOPE_AGENT); }
__device__ __forceinline__ unsigned xb_xcc_id() { return (unsigned)__builtin_amdgcn_s_getreg((3 << 11) | 20) & 0xFu; }
#define XB_SPIN(cond, bar) do { unsigned _sp = 0; while (cond) { __builtin_amdgcn_s_sleep(1); \
    if ((++_sp & 255u) == 0u) { if (xb_ld(&(bar)[XB_TMO])) break; if (_sp > XB_SPIN_CAP) { atomicAdd(&(bar)[XB_TMO], 1u); break; } } } } while (0)

struct XcdBarrier {
    unsigned* bar; unsigned x;
    volatile XB_LAS unsigned* st;
};

__device__ __forceinline__ XcdBarrier xcd_barrier_post(unsigned* bar, volatile XB_LAS unsigned* st) {
    XcdBarrier b; b.bar = bar; b.x = xb_xcc_id(); b.st = st;
    if (threadIdx.x == 0) (void)xb_add(&bar[XB_XCNT(b.x)], 1u);
    return b;
}
__device__ __forceinline__ void xcd_barrier_complete(unsigned* bar, unsigned x, unsigned& nloc, unsigned& nx) {
    const unsigned G = gridDim.x * gridDim.y * gridDim.z;
    unsigned sum, cnt, mine, sp = 0u;
    for (;;) {
        sum = 0u; cnt = 0u; mine = 0u;
#pragma unroll
        for (unsigned j = 0; j < 16; ++j) { const unsigned c = xb_ld(&bar[XB_XCNT(j)]); sum += c; cnt += (c > 0u) ? 1u : 0u; mine = (j == x) ? c : mine; }
        if (sum == G) break;
        __builtin_amdgcn_s_sleep(1);
        if ((++sp & 255u) == 0u) { if (xb_ld(&bar[XB_TMO])) break; if (sp > XB_SPIN_CAP) { atomicAdd(&bar[XB_TMO], 1u); break; } }
    }
    nloc = mine > 0u ? mine : 1u; nx = cnt > 0u ? cnt : 1u;
}

__device__ __forceinline__ void xcd_barrier(const XcdBarrier& b) {
    asm volatile("s_waitcnt vmcnt(0)" ::: "memory");
    __syncthreads();
    if (threadIdx.x == 0) {
        unsigned* bar = b.bar;
        __builtin_amdgcn_s_waitcnt(0);
        unsigned nloc = b.st[0], nx = b.st[1];
        if (nloc == 0u) { xcd_barrier_complete(bar, b.x, nloc, nx); b.st[0] = nloc; b.st[1] = nx; }
        const unsigned old = xb_add(&bar[XB_XSUB(b.x)], 1u);
        const unsigned gen = old / nloc;
        if (old + 1u == (gen + 1u) * nloc) {
            __builtin_amdgcn_fence(__ATOMIC_RELEASE, "agent");
            asm volatile("s_waitcnt vmcnt(0)" ::: "memory");
            const unsigned og = xb_add(&bar[XB_TOP], 1u);
            const unsigned tg = og / nx;
            if (og + 1u == (tg + 1u) * nx) xb_add(&bar[XB_TOPGEN], 1u);
            else XB_SPIN(xb_ld(&bar[XB_TOPGEN]) == tg, bar);
            __builtin_amdgcn_fence(__ATOMIC_ACQUIRE, "agent");
            xb_add(&bar[XB_XGEN(b.x)], 1u);
            asm volatile("s_waitcnt vmcnt(0)" ::: "memory");
        } else {
            XB_SPIN(xb_ld(&bar[XB_XGEN(b.x)]) == gen, bar);
            __builtin_amdgcn_fence(__ATOMIC_ACQUIRE, "agent");
            asm volatile("s_waitcnt vmcnt(0)" ::: "memory");
        }
    }
    __syncthreads();
}


enum { PH_INIT = 0, PH_CONVERT, PH_G1A, PH_G2A, PH_G3, PH_CONV, PH_PREP, PH_SCAN, PH_SB, PH_G4, PH_G1B, PH_G2B, PH_FINAL };

DEV void run_phase(CP& p, int ph, int l, int bid, int nblk, float* lds) {
    switch (ph) {
    case PH_INIT: phase_init(p, bid, nblk); break;
    case PH_G1A: gemm_big(p.hb, p.W13a, MMAIN, 2 * DFF, DM, EpiSwiglu{p.big, p.part}, bid, nblk, (unsigned char*)lds);
        if (bid >= 128) gemm_meta<EPI_SWIGLU>(p, p.hb, p.W13a, 2 * DFF, DM, 0.f, bid - 128, nblk - 128, lds); break;
    case PH_G2A: gemm_big(p.big, p.W2a, MMAIN, DM, DFF, EpiResid{p.h, p.hb, p.part, 0.5f}, bid, nblk, (unsigned char*)lds);
        gemm_meta<EPI_RESID>(p, p.big, p.W2a, DM, DFF, 0.5f, bid, nblk, lds); break;
    case PH_G3: gemm_big(p.hb, p.Win, MMAIN, DIN, DM, EpiP{p.big, p.vt, p.part}, bid, nblk, (unsigned char*)lds);
        gemm_meta<EPI_P>(p, p.hb, p.Win, DIN, DM, 0.f, bid, nblk, lds); break;
    case PH_CONV: phase_conv(p, l, bid, nblk, lds); break;
    case PH_PREP: phase_rwkv_prep(p, l, bid, nblk, lds); break;
    case PH_G4: gemm_big(p.y, p.Wout, MMAIN, DM, DM, EpiResid{p.h, p.hb, p.part, 1.0f}, bid, nblk, (unsigned char*)lds);
        gemm_meta<EPI_RESID>(p, p.y, p.Wout, DM, DM, 1.0f, bid, nblk, lds); break;
    case PH_G1B: gemm_big(p.hb, p.W13b, MMAIN, 2 * DFF, DM, EpiSwiglu{p.big, p.part}, bid, nblk, (unsigned char*)lds);
        if (bid >= 128) gemm_meta<EPI_SWIGLU>(p, p.hb, p.W13b, 2 * DFF, DM, 0.f, bid - 128, nblk - 128, lds); break;
    case PH_G2B: gemm_big(p.big, p.W2b, MMAIN, DM, DFF, EpiResid{p.h, p.hb, p.part, 0.5f}, bid, nblk, (unsigned char*)lds);
        gemm_meta<EPI_RESID>(p, p.big, p.W2b, DM, DFF, 0.5f, bid, nblk, lds); break;
    case PH_FINAL: phase_final(p, bid, nblk); break;
    }
}

namespace cg = cooperative_groups;
constexpr int NSIDE = 96;
constexpr int LDS_BYTES = 151552 + 16;

__global__ void __launch_bounds__(512) k_mega(P p) {
    extern __shared__ __attribute__((aligned(16))) unsigned char smem[];
    float* lds = (float*)smem;
    cg::grid_group grid = cg::this_grid();
    const int bid0 = blockIdx.x, nblk = gridDim.x;
    volatile XB_LAS unsigned* xst = (volatile XB_LAS unsigned*)((XB_LAS unsigned char*)smem + (LDS_BYTES - 16));
    if (threadIdx.x < 4) xst[threadIdx.x] = 0u;
    __syncthreads();
    (void)xcd_barrier_post(kargs()->bar, xst);
#define XBAR() { XcdBarrier xb_; xb_.bar = kargs()->bar; xb_.x = xb_xcc_id(); xb_.st = xst; xcd_barrier(xb_); }
    phase_init(*kargs(), bid0, nblk);
    phase_convert(*kargs(), 0, 0, bid0, nblk, lds);
    if (nblk == 0x7fffffff) grid.sync();
    XBAR();
    for (int l = 0; l < 4; ++l) {
        int bid = bid0; asm volatile("" : "+s"(bid));
        run_phase(*kargs(), PH_G1A, l, bid, nblk, lds); XBAR();
        run_phase(*kargs(), PH_G2A, l, bid, nblk, lds); XBAR();
        run_phase(*kargs(), PH_G3, l, bid, nblk, lds); XBAR();
        run_phase(*kargs(), PH_PREP, l, bid, nblk, lds);
        if (bid >= 2) {
            __syncthreads();
            phase_convert(*kargs(), l, 2, bid - 2, nblk - 2, lds, 0, l < 3 ? 2368 + 2880 : 2368);
        }
        XBAR();
        phase_rwkv_pack(*kargs(), l, bid, nblk, smem);
        XBAR();
        if (bid < 48) phase_rwkv_chunk(*kargs(), l, bid, smem);
        else if (bid < 48 + NSIDE) {
            phase_conv(*kargs(), l, bid - 48, NSIDE, lds);
            __syncthreads();
            phase_sb_mfma(*kargs(), l, bid - 48, NSIDE);
            __syncthreads();
            if (l < 3) phase_convert(*kargs(), l + 1, 0, bid - 48, NSIDE, lds, 2880, CONV_A);
        } else if (bid < 48 + NSIDE + 48) phase_pack_prefetch(*kargs(), bid - 48 - NSIDE);
        XBAR();
        run_phase(*kargs(), PH_G4, l, bid, nblk, lds); XBAR();
        run_phase(*kargs(), PH_G1B, l, bid, nblk, lds); XBAR();
        run_phase(*kargs(), PH_G2B, l, bid, nblk, lds); XBAR();
    }
    phase_final(*kargs(), bid0, nblk);
}
#undef XBAR

extern "C" void kernel_launch(void* const* d_in, const int* in_sizes, int n_in, void* d_out, int out_size, void* d_ws, size_t ws_size, hipStream_t stream) {
    static int grid_blocks = 0;
    if (grid_blocks == 0) {
        int dev = 0, cus = 0, per_cu = 0;
        hipGetDevice(&dev);
        hipDeviceGetAttribute(&cus, hipDeviceAttributeMultiprocessorCount, dev);
        if (hipFuncSetAttribute((const void*)k_mega, hipFuncAttributeMaxDynamicSharedMemorySize, LDS_BYTES) != hipSuccess) { fprintf(stderr, "hipFuncSetAttribute failed\n"); grid_blocks = -1; return; }
        if (hipOccupancyMaxActiveBlocksPerMultiprocessor(&per_cu, (const void*)k_mega, 512, LDS_BYTES) != hipSuccess || per_cu < 1) { fprintf(stderr, "occupancy query failed (%d)\n", per_cu); per_cu = 1; }
        (void)hipGetLastError();
        grid_blocks = cus * per_cu;
    }
    if (grid_blocks < 0) return;
    P p{};
    const float** f = (const float**)&p;
    for (int i = 0; i < 28; ++i) f[i] = (const float*)d_in[i];
    p.out = (float*)d_out;
    size_t off = 0;
    auto take = [&](size_t bytes) { void* r = (char*)d_ws + off; off += (bytes + 255) & ~(size_t)255; return r; };
    p.W13a = (bf16_t*)take((size_t)2 * DFF * DM * 2);
    p.W2a = (bf16_t*)take((size_t)DM * DFF * 2);
    p.Win = (bf16_t*)take((size_t)DIN * DM * 2);
    p.Wout = (bf16_t*)take((size_t)DM * DM * 2);
    p.W13b = (bf16_t*)take((size_t)2 * DFF * DM * 2);
    p.W2b = (bf16_t*)take((size_t)DM * DFF * 2);
    p.Wl = (bf16_t*)take((size_t)DRW * 256 * 2);
    p.h = (float*)take((size_t)MP * DM * 4);
    p.hb = (bf16_t*)take((size_t)MP * DM * 2);
    p.big = (bf16_t*)take((size_t)MP * DIN * 2);
    p.y = (bf16_t*)take((size_t)MP * DM * 2);
    p.vt = (bf16_t*)take((size_t)NB * 6 * 64 * LPV * 2);
    p.part = (float*)take((size_t)MP * 16 * 4);
    p.lw = (float*)p.hb;
    p.aa = (float*)p.y;
    p.gg16 = (bf16_t*)take((size_t)MP * DRW * 2);
    p.pack = (unsigned char*)take((size_t)NB * 6 * 129 * PK_BYTES);
    p.ct = (float*)take((size_t)MP * 8 * 4);
    p.inorm = (float*)take((size_t)MP * 8 * 4);
    p.bar = (unsigned*)take((size_t)XCD_BAR_WORDS * 4);
    if (off > ws_size) { fprintf(stderr, "workspace too small: need %zu have %zu\n", off, ws_size); return; }
    if (hipMemsetAsync(p.bar, 0, (size_t)XCD_BAR_WORDS * 4, stream) != hipSuccess) { fprintf(stderr, "memset of barrier words failed\n"); return; }
    void* args[] = {&p};
    hipError_t e = hipLaunchCooperativeKernel((const void*)k_mega, dim3(grid_blocks), dim3(512), args, LDS_BYTES, stream);
    if (e != hipSuccess) fprintf(stderr, "cooperative launch failed: %s (grid %d)\n", hipGetErrorString(e), grid_blocks);
}
```
